# Optimizing an MI355X kernel written in HIP

```python
import math
import numpy as np
import jax
import jax.numpy as jnp
from jax import lax

D_MODEL = 2048
BATCH = 1
SEQ = 8192
DEPTH = 1

HEAD_DIM = 128
N_HEADS = D_MODEL // HEAD_DIM
N_HEADS_DIL = (3 * N_HEADS) // 8
N_HEADS_NSA = N_HEADS - N_HEADS_DIL
NSA_KV_GROUPS = 2
NSA_GROUP = N_HEADS_NSA // NSA_KV_GROUPS
N_NSA_BRANCHES = 3
DIL_PAIRS = ((128, 1), (512, 4), (2048, 16))
CMP_BLOCK = 32
CMP_STRIDE = 16
CMP_HIDDEN = 256
SEL_BLOCK = 64
N_SELECT = 16
NSA_WINDOW = 512
D_FF = 5632
ROPE_THETA = 10000.0
QBLK = 128
LN_EPS = 1e-5
NEG = -1e30
FORCE_BONUS = 1e4

D_DIL = N_HEADS_DIL * HEAD_DIM
D_NSA = N_HEADS_NSA * HEAD_DIM
KV_W = NSA_KV_GROUPS * HEAD_DIM
IN_COLS = 3 * D_DIL + D_NSA + 6 * KV_W + N_HEADS_NSA * N_NSA_BRANCHES

kernel_name = "hybrid_dilated_nsa_macaron_deepnorm"


def layer_norm(x, g, b):
    xf = x.astype(jnp.float32)
    mu = xf.mean(-1, keepdims=True)
    var = jnp.square(xf - mu).mean(-1, keepdims=True)
    y = (xf - mu) * lax.rsqrt(var + LN_EPS) * g.astype(jnp.float32) + b.astype(jnp.float32)
    return y.astype(x.dtype)


def swiglu(x, w1, w3, w2):
    return (jax.nn.silu(x @ w1) * (x @ w3)) @ w2


def rope_tables(pos_f):
    inv_freq = ROPE_THETA ** (-jnp.arange(0, HEAD_DIM, 2, dtype=jnp.float32) / HEAD_DIM)
    ang = pos_f.astype(jnp.float32)[..., None] * inv_freq
    return jnp.cos(ang), jnp.sin(ang)


def apply_rope(x, cos, sin):
    xf = x.astype(jnp.float32)
    x1, x2 = jnp.split(xf, 2, axis=-1)
    c, s = cos[:, :, None, :], sin[:, :, None, :]
    return jnp.concatenate([x1 * c - x2 * s, x2 * c + x1 * s], axis=-1).astype(x.dtype)


def masked_softmax(s, mask):
    s = jnp.where(mask, s.astype(jnp.float32), NEG)
    m = s.max(-1, keepdims=True)
    e = jnp.where(mask, jnp.exp(s - m), 0.0)
    return e / jnp.maximum(e.sum(-1, keepdims=True), 1e-30)


def banded_causal_attention(q, k, v, window):
    N, H, L, D = q.shape
    n_prev = -(-window // QBLK)
    nb = -(-L // QBLK)
    Lp = nb * QBLK
    qb = jnp.pad(q, ((0, 0), (0, 0), (0, Lp - L), (0, 0))).reshape(N, H, nb, QBLK, D)
    pad_kv = ((0, 0), (0, 0), (n_prev * QBLK, Lp - L), (0, 0))
    kb = jnp.pad(k, pad_kv).reshape(N, H, nb + n_prev, QBLK, D)
    vb = jnp.pad(v, pad_kv).reshape(N, H, nb + n_prev, QBLK, D)
    kband = jnp.concatenate([kb[:, :, j:j + nb] for j in range(n_prev + 1)], axis=3)
    vband = jnp.concatenate([vb[:, :, j:j + nb] for j in range(n_prev + 1)], axis=3)
    s = jnp.einsum('nhbqd,nhbkd->nhbqk', qb, kband).astype(jnp.float32) * (D ** -0.5)
    qpos = jnp.arange(nb)[:, None] * QBLK + jnp.arange(QBLK)[None, :]
    kpos = jnp.arange(nb)[:, None] * QBLK - n_prev * QBLK + jnp.arange((n_prev + 1) * QBLK)[None, :]
    dist = qpos[:, :, None] - kpos[:, None, :]
    mask = (dist >= 0) & (dist <= window) & (kpos[:, None, :] >= 0)
    s = jnp.where(mask, s, NEG)
    m = s.max(-1, keepdims=True)
    e = jnp.exp(s - m)
    l = e.sum(-1)
    o = jnp.einsum('nhbqk,nhbkd->nhbqd', e, vband) / l[..., None]
    lse = m[..., 0] + jnp.log(l)
    return o.reshape(N, H, Lp, D)[:, :, :L], lse.reshape(N, H, Lp)[:, :, :L]


def dilated_attention(q, k, v):
    B, S, H, D = q.shape
    outs, lses = [], []
    for window, dil in DIL_PAIRS:
        L = S // dil

        def to_sub(t):
            return t.reshape(B, L, dil, H, D).transpose(0, 2, 3, 1, 4).reshape(B * dil, H, L, D)

        o, lse = banded_causal_attention(to_sub(q), to_sub(k), to_sub(v), window // dil)
        outs.append(o.reshape(B, dil, H, L, D).transpose(0, 3, 1, 2, 4).reshape(B, S, H, D))
        lses.append(lse.reshape(B, dil, H, L).transpose(0, 3, 1, 2).reshape(B, S, H))
    w = jax.nn.softmax(jnp.stack(lses, 0), axis=0)
    return (w[..., None] * jnp.stack(outs, 0)).sum(0).astype(q.dtype)


def native_sparse_attention(q, kc_tok, vc_tok, ks, vs, kw, vw, gates, positions,
                            cmp_pe, cmp_w1, cmp_b1, cmp_w2, cmp_b2):
    B, S, HN, D = q.shape
    G, HG = NSA_KV_GROUPS, NSA_GROUP
    scale = D ** -0.5
    n_cmp = (S - CMP_BLOCK) // CMP_STRIDE + 1
    n_sel = S // SEL_BLOCK
    k_sel = min(N_SELECT, n_sel)
    nb = S // QBLK

    cidx = np.arange(n_cmp)[:, None] * CMP_STRIDE + np.arange(CMP_BLOCK)[None, :]

    def compress(tok, j):
        blk = tok[:, cidx] + cmp_pe[j][None, None, :, None, :]
        flat = blk.transpose(0, 1, 3, 2, 4).reshape(B, n_cmp, G, CMP_BLOCK * D)
        hdn = jax.nn.gelu(flat @ cmp_w1[j] + cmp_b1[j])
        return hdn @ cmp_w2[j] + cmp_b2[j]

    pos_c = (positions[:, cidx[:, 0]] + positions[:, cidx[:, -1]]).astype(jnp.float32) * 0.5
    cos_c, sin_c = rope_tables(pos_c)
    kc = apply_rope(compress(kc_tok, 0), cos_c, sin_c).transpose(0, 2, 1, 3)
    vc = compress(vc_tok, 1).transpose(0, 2, 1, 3)
    cmp_end = jnp.asarray(cidx[:, -1])

    c_lo, c_hi = cidx[:, 0][:, None], cidx[:, -1][:, None]
    s_lo = (np.arange(n_sel) * SEL_BLOCK)[None, :]
    overlap = jnp.asarray(((c_lo <= s_lo + SEL_BLOCK - 1) & (c_hi >= s_lo)).astype(np.float32))
    sel_start = jnp.arange(n_sel) * SEL_BLOCK

    ks_blocks = ks.transpose(0, 2, 1, 3).reshape(B, G, n_sel, SEL_BLOCK, D)
    vs_blocks = vs.transpose(0, 2, 1, 3).reshape(B, G, n_sel, SEL_BLOCK, D)
    pad_w = ((0, 0), (0, 0), (NSA_WINDOW, 0), (0, 0))
    kw_pad = jnp.pad(kw.transpose(0, 2, 1, 3), pad_w)
    vw_pad = jnp.pad(vw.transpose(0, 2, 1, 3), pad_w)
    qg = q.reshape(B, S, G, HG, D).transpose(0, 2, 3, 1, 4)
    gg = gates.reshape(B, S, G, HG, N_NSA_BRANCHES).transpose(0, 2, 3, 1, 4)
    gather_blocks = jax.vmap(jax.vmap(lambda kb, ix: kb[ix]))

    def block_fn(i):
        t0 = i * QBLK
        t = t0 + jnp.arange(QBLK)
        qb = lax.dynamic_slice_in_dim(qg, t0, QBLK, axis=3)
        gb = lax.dynamic_slice_in_dim(gg, t0, QBLK, axis=3)
        s = jnp.einsum('bghqd,bgnd->bghqn', qb, kc) * scale
        p_cmp = masked_softmax(s, cmp_end[None, :] <= t[:, None])
        o_cmp = jnp.einsum('bghqn,bgnd->bghqd', p_cmp, vc)
        imp = p_cmp.sum(2) @ overlap
        valid = sel_start[None, :] <= t[:, None]
        cur = t // SEL_BLOCK
        jj = jnp.arange(n_sel)[None, :]
        forced = (jj == 0) | (jj == cur[:, None]) | (jj == cur[:, None] - 1)
        score = jnp.where(valid, imp + jnp.where(forced, FORCE_BONUS, 0.0), NEG)
        _, sel = lax.top_k(score, k_sel)
        sel_valid = jnp.take_along_axis(jnp.broadcast_to(valid, score.shape), sel, axis=-1)
        ks_g = gather_blocks(ks_blocks, sel).reshape(B, G, QBLK, k_sel * SEL_BLOCK, D)
        vs_g = gather_blocks(vs_blocks, sel).reshape(B, G, QBLK, k_sel * SEL_BLOCK, D)
        kpos = sel[..., None] * SEL_BLOCK + jnp.arange(SEL_BLOCK)
        smask = (sel_valid[..., None] & (kpos <= t[:, None, None])).reshape(B, G, QBLK, k_sel * SEL_BLOCK)
        s = jnp.einsum('bghqd,bgqkd->bghqk', qb, ks_g) * scale
        p = masked_softmax(s, smask[:, :, None])
        o_slc = jnp.einsum('bghqk,bgqkd->bghqd', p, vs_g)
        kwb = lax.dynamic_slice_in_dim(kw_pad, t0, QBLK + NSA_WINDOW, axis=2)
        vwb = lax.dynamic_slice_in_dim(vw_pad, t0, QBLK + NSA_WINDOW, axis=2)
        kpos_w = t0 - NSA_WINDOW + jnp.arange(QBLK + NSA_WINDOW)
        dist = t[:, None] - kpos_w[None, :]
        wmask = (dist >= 0) & (dist < NSA_WINDOW) & (kpos_w[None, :] >= 0)
        s = jnp.einsum('bghqd,bgkd->bghqk', qb, kwb) * scale
        p = masked_softmax(s, wmask)
        o_win = jnp.einsum('bghqk,bgkd->bghqd', p, vwb)
        return gb[..., 0:1] * o_cmp + gb[..., 1:2] * o_slc + gb[..., 2:3] * o_win

    out = lax.map(block_fn, jnp.arange(nb))
    return out.transpose(1, 0, 4, 2, 3, 5).reshape(B, S, HN, D).astype(q.dtype)


def split_in_proj(proj):
    sizes = (D_DIL, D_DIL, D_DIL, D_NSA, KV_W, KV_W, KV_W, KV_W, KV_W, KV_W,
             N_HEADS_NSA * N_NSA_BRANCHES)
    offs = [int(o) for o in np.cumsum(sizes)[:-1]]
    return jnp.split(proj, offs, axis=-1)


def hybrid_mixer(h, cos, sin, positions, w_in, gate_b, cmp_pe, cmp_w1, cmp_b1, cmp_w2, cmp_b2, w_out):
    B, S, _ = h.shape
    proj = h @ w_in
    qa, ka, va, qn, kc, vc, ks, vs, kw, vw, g = split_in_proj(proj)

    def heads(t, n):
        return t.reshape(B, S, n, HEAD_DIM)

    out_a = dilated_attention(apply_rope(heads(qa, N_HEADS_DIL), cos, sin),
                              apply_rope(heads(ka, N_HEADS_DIL), cos, sin),
                              heads(va, N_HEADS_DIL))
    gates = jax.nn.sigmoid((g + gate_b).astype(jnp.float32)).reshape(B, S, N_HEADS_NSA, N_NSA_BRANCHES)
    out_b = native_sparse_attention(
        apply_rope(heads(qn, N_HEADS_NSA), cos, sin),
        heads(kc, NSA_KV_GROUPS), heads(vc, NSA_KV_GROUPS),
        apply_rope(heads(ks, NSA_KV_GROUPS), cos, sin), heads(vs, NSA_KV_GROUPS),
        apply_rope(heads(kw, NSA_KV_GROUPS), cos, sin), heads(vw, NSA_KV_GROUPS),
        gates, positions, cmp_pe, cmp_w1, cmp_b1, cmp_w2, cmp_b2)
    mixed = jnp.concatenate([out_a, out_b.astype(out_a.dtype)], axis=2).reshape(B, S, D_MODEL)
    return (mixed @ w_out).astype(h.dtype)


def setup_inputs(seed: int = 0) -> dict:
    key = jax.random.key(seed)
    ks = jax.random.split(key, 24)
    beta = (8.0 * DEPTH) ** -0.25
    nrm = jax.random.normal
    f32 = jnp.float32
    return {
        "x": nrm(ks[0], (BATCH, SEQ, D_MODEL), f32),
        "positions": jnp.broadcast_to(jnp.arange(SEQ, dtype=jnp.int32), (BATCH, SEQ)),
        "ln1_g": 1.0 + 0.02 * nrm(ks[1], (DEPTH, D_MODEL), f32),
        "ln1_b": 0.02 * nrm(ks[2], (DEPTH, D_MODEL), f32),
        "ffn1_w1": nrm(ks[3], (DEPTH, D_MODEL, D_FF), f32) * D_MODEL ** -0.5,
        "ffn1_w3": nrm(ks[4], (DEPTH, D_MODEL, D_FF), f32) * D_MODEL ** -0.5,
        "ffn1_w2": nrm(ks[5], (DEPTH, D_FF, D_MODEL), f32) * D_FF ** -0.5 * beta,
        "w_in": nrm(ks[6], (DEPTH, D_MODEL, IN_COLS), f32) * D_MODEL ** -0.5,
        "gate_b": 0.1 * nrm(ks[7], (DEPTH, N_HEADS_NSA * N_NSA_BRANCHES), f32),
        "cmp_pe": 0.1 * nrm(ks[8], (DEPTH, 2, CMP_BLOCK, HEAD_DIM), f32),
        "cmp_w1": nrm(ks[9], (DEPTH, 2, CMP_BLOCK * HEAD_DIM, CMP_HIDDEN), f32) * (CMP_BLOCK * HEAD_DIM) ** -0.5,
        "cmp_b1": 0.02 * nrm(ks[10], (DEPTH, 2, CMP_HIDDEN), f32),
        "cmp_w2": nrm(ks[11], (DEPTH, 2, CMP_HIDDEN, HEAD_DIM), f32) * CMP_HIDDEN ** -0.5,
        "cmp_b2": 0.02 * nrm(ks[12], (DEPTH, 2, HEAD_DIM), f32),
        "w_out": nrm(ks[13], (DEPTH, D_MODEL, D_MODEL), f32) * D_MODEL ** -0.5 * beta,
        "ln2_g": 1.0 + 0.02 * nrm(ks[14], (DEPTH, D_MODEL), f32),
        "ln2_b": 0.02 * nrm(ks[15], (DEPTH, D_MODEL), f32),
        "ffn2_w1": nrm(ks[16], (DEPTH, D_MODEL, D_FF), f32) * D_MODEL ** -0.5,
        "ffn2_w3": nrm(ks[17], (DEPTH, D_MODEL, D_FF), f32) * D_MODEL ** -0.5,
        "ffn2_w2": nrm(ks[18], (DEPTH, D_FF, D_MODEL), f32) * D_FF ** -0.5 * beta,
        "ln3_g": 1.0 + 0.02 * nrm(ks[19], (DEPTH, D_MODEL), f32),
        "ln3_b": 0.02 * nrm(ks[20], (DEPTH, D_MODEL), f32),
    }


def reference(x, positions, ln1_g, ln1_b, ffn1_w1, ffn1_w3, ffn1_w2, w_in, gate_b,
              cmp_pe, cmp_w1, cmp_b1, cmp_w2, cmp_b2, w_out, ln2_g, ln2_b,
              ffn2_w1, ffn2_w3, ffn2_w2, ln3_g, ln3_b):
    alpha = (2.0 * DEPTH) ** 0.25
    cos, sin = rope_tables(positions.astype(jnp.float32))
    h = x
    for l in range(DEPTH):
        h = layer_norm(alpha * h + 0.5 * swiglu(h, ffn1_w1[l], ffn1_w3[l], ffn1_w2[l]), ln1_g[l], ln1_b[l])
        mix = hybrid_mixer(h, cos, sin, positions, w_in[l], gate_b[l], cmp_pe[l], cmp_w1[l],
                           cmp_b1[l], cmp_w2[l], cmp_b2[l], w_out[l])
        h = layer_norm(alpha * h + mix, ln2_g[l], ln2_b[l])
        h = layer_norm(alpha * h + 0.5 * swiglu(h, ffn2_w1[l], ffn2_w3[l], ffn2_w2[l]), ln3_g[l], ln3_b[l])
    return h
```

```cpp
#include <hip/hip_runtime.h>
#include <hip/hip_cooperative_groups.h>
#include <cstdio>
#include <cstdint>
namespace cg = cooperative_groups;

#ifndef N_LAUNCH_PER_PHASE
#define N_LAUNCH_PER_PHASE 1
#endif

#define LAS __attribute__((address_space(3)))
typedef unsigned short bf16_t;
typedef short bf16x8 __attribute__((ext_vector_type(8)));
typedef float f32x4 __attribute__((ext_vector_type(4)));
typedef float f32x2 __attribute__((ext_vector_type(2)));
typedef unsigned u32x4 __attribute__((ext_vector_type(4)));
typedef unsigned u32x2 __attribute__((ext_vector_type(2)));

constexpr int S = 8192, DM = 2048, DFF = 5632, HD = 128;
constexpr int NH_DIL = 6, NH_NSA = 10, NG = 2, HG = 5;
constexpr int D_DIL = 768, D_NSA = 1280;
constexpr int IN_COLS = 5150, IN_PAD = 5376;
constexpr int NCMP = 511;
constexpr float LN_EPS = 1e-5f;
constexpr float ALPHA = 1.189207115002721f;
constexpr float QSCALE = 0.08838834764831845f * 1.4426950408889634f;
constexpr int NTHREADS = 512, NWAVES = 8;

constexpr size_t MiB = 1u << 20;
constexpr size_t OFF_CTL = 0;
constexpr size_t OFF_W13A = 1 * MiB, OFF_W2A = 45 * MiB, OFF_W13B = 67 * MiB, OFF_W2B = 111 * MiB;
constexpr size_t OFF_WIN = 133 * MiB, OFF_WOUT = 154 * MiB, OFF_CW1T = 162 * MiB, OFF_CW2T = 166 * MiB;
constexpr size_t OFF_ROPE = 167 * MiB;
constexpr size_t OFF_XB = 171 * MiB;
constexpr size_t OFF_HID = 203 * MiB;
constexpr size_t OFF_QA = 291 * MiB, OFF_KA = 303 * MiB, OFF_VA = 315 * MiB, OFF_QN = 327 * MiB;
constexpr size_t OFF_KCT = 347 * MiB, OFF_VCT = 355 * MiB;
constexpr size_t OFF_KS = 363 * MiB, OFF_VS = 367 * MiB, OFF_KW = 371 * MiB, OFF_VW = 375 * MiB;
constexpr size_t OFF_GT = 379 * MiB;
constexpr size_t OFF_KC = 380 * MiB;
constexpr size_t OFF_VC = OFF_KC + 256 * 1024;
constexpr size_t WS_END = 381 * MiB;

constexpr int LDS_BYTES = 147456;

__constant__ double INV_FREQ[64] = {
1.0, 0.8659643233600653, 0.7498942093324559, 0.6493816315762113,
0.5623413251903491, 0.4869675251658631, 0.4216965034285822, 0.3651741272548377,
0.31622776601683794, 0.27384196342643613, 0.23713737056616552, 0.2053525026457146,
0.1778279410038923, 0.1539926526059492, 0.1333521432163324, 0.11547819846894582,
0.1, 0.08659643233600653, 0.07498942093324558, 0.06493816315762113,
0.05623413251903491, 0.04869675251658631, 0.042169650342858224, 0.03651741272548377,
0.03162277660168379, 0.027384196342643614, 0.023713737056616554, 0.02053525026457146,
0.01778279410038923, 0.01539926526059492, 0.01333521432163324, 0.011547819846894581,
0.01, 0.008659643233600654, 0.007498942093324558, 0.006493816315762113,
0.005623413251903491, 0.004869675251658631, 0.004216965034285823, 0.003651741272548377,
0.0031622776601683794, 0.0027384196342643613, 0.0023713737056616554, 0.002053525026457146,
0.0017782794100389228, 0.001539926526059492, 0.001333521432163324, 0.0011547819846894581,
0.001, 0.0008659643233600654, 0.0007498942093324559, 0.0006493816315762113,
0.0005623413251903491, 0.0004869675251658631, 0.00042169650342858224, 0.0003651741272548377,
0.00031622776601683794, 0.0002738419634264361, 0.00023713737056616554, 0.0002053525026457146,
0.00017782794100389227, 0.0001539926526059492, 0.0001333521432163324, 0.00011547819846894582 };

__device__ __forceinline__ unsigned f2bf(float f) { unsigned u = __builtin_bit_cast(unsigned, f); return (u + 0x7fffu + ((u >> 16) & 1u)) >> 16; }
__device__ __forceinline__ unsigned pk2(float lo, float hi) { return f2bf(lo) | (f2bf(hi) << 16); }
__device__ __forceinline__ float bflo(unsigned u) { return __uint_as_float(u << 16); }
__device__ __forceinline__ float bfhi(unsigned u) { return __uint_as_float(u & 0xffff0000u); }
__device__ __forceinline__ float wave_sum(float v) {
#pragma unroll
    for (int o = 1; o < 64; o <<= 1) v += __shfl_xor(v, o);
    return v;
}
__device__ __forceinline__ float wave_max(float v) {
#pragma unroll
    for (int o = 1; o < 64; o <<= 1) v = fmaxf(v, __shfl_xor(v, o));
    return v;
}
__device__ __forceinline__ float fast_exp2(float x) { return __builtin_amdgcn_exp2f(x); }
__device__ __forceinline__ float fast_rcp(float x) { return __builtin_amdgcn_rcpf(x); }
__device__ __forceinline__ void rope_cs(double pos, int i, float& c, float& s) {
    const double rev = pos * INV_FREQ[i] * 0.15915494309189535;
    const double fr = rev - __builtin_rint(rev);
    const float f = (float)fr;
    c = __builtin_amdgcn_cosf(f); s = __builtin_amdgcn_sinf(f);
}

namespace pg8 {
constexpr int BM = 256, BK = 64, HALF = 128, HTB = HALF * BK * 2, STAGE_BYTES = 8 * HTB, NXCD = 8, WGM = 8;
__host__ __device__ __forceinline__ int lds_byte(int r, int c) { const int st = (r >> 4) * 2 + (c >> 5), rr = r & 15, cc = c & 31, ob = rr * 64 + cc * 2; return st * 1024 + (ob ^ (((ob >> 9) & 1) << 5)); }
__host__ __device__ __forceinline__ void stage_rc(int b, int& R, int& C) { const int st = b / 1024, sb = b % 1024, swz = sb ^ (((sb >> 9) & 1) << 5); R = (st >> 1) * 16 + swz / 64; C = (st & 1) * 32 + (swz % 64) / 2; }
__host__ __device__ __forceinline__ int perm32(int rho) { const int n = rho >> 4, i = rho & 15; return 8 * (i >> 2) + 4 * n + (i & 3); }
struct Unit { int pm, pn; };
struct Gemm { const bf16_t* A; const bf16_t* Bt; int M, N, K; };
struct StaticOrder {
    int nM, nN, nwg, G, c;
    __host__ __device__ void init(int M, int N, int G_, int c_) { nM = M / BM; nN = N / BM; nwg = nM * nN; G = G_; c = c_; }
    __host__ __device__ bool next(int i, Unit& u) const {
        const long L = (long)i * G + c; if (L >= nwg) return false;
        int wgid = (int)L; { const int q = nwg / NXCD, r = nwg % NXCD, xcd = wgid % NXCD, off = wgid / NXCD; wgid = (xcd < r ? xcd * (q + 1) : r * (q + 1) + (xcd - r) * q) + off; }
        const int nig = WGM * nN, gid = wgid / nig, fm = gid * WGM, gsz = (nM - fm) < WGM ? (nM - fm) : WGM;
        u.pm = fm + ((wgid % nig) % gsz); u.pn = (wgid % nig) / gsz; return true;
    }
    __device__ __forceinline__ void a_ready(const Unit&) const {}
    __device__ __forceinline__ void done(const Unit&) const {}
};
__device__ __forceinline__ unsigned cvt_pk_bf16(float lo, float hi) { unsigned r; asm volatile("v_cvt_pk_bf16_f32 %0, %1, %2" : "=v"(r) : "v"(lo), "v"(hi)); return r; }

template <class Epi, class Sched, bool ALIGN_EPI = false, bool SP2 = false>
__device__ __forceinline__ void gemm_phase(LAS unsigned char* lds, const Gemm g, const Sched& S, const Epi& E) {
    const int tid = threadIdx.x, wid = __builtin_amdgcn_readfirstlane(tid >> 6), lane = tid & 63, wr = wid >> 2, wc = wid & 3, fr = lane & 15, fq = lane >> 4;
    const int K = g.K, nt = K / BK;
    unsigned voffA[2], voffB[2];
#pragma unroll
    for (int i = 0; i < 2; ++i) { int R, C; stage_rc(tid * 16 + i * 8192, R, C); const int Rb = Epi::PERM ? ((R & ~31) + perm32(R & 31)) : R;
        voffA[i] = (unsigned)(R * K + C) * 2u; voffB[i] = (unsigned)(Rb * K + C) * 2u; }
    const size_t kstep = (size_t)(BK * 2);
    const size_t hstep = (size_t)HALF * K * 2;
    const size_t tstep = 2 * hstep;
    const unsigned ldsw = (unsigned)wid * 1024u;
    const int aoff = lds_byte(wr * 64 + fr, fq * 8), boff = lds_byte(wc * 32 + fr, fq * 8);
#define PG8_SA(b, h) (((b) * 2 + (h)) * HTB)
#define PG8_SB(b, h) ((4 + (b) * 2 + (h)) * HTB)
#define PG8_STAGE(bufoff, gbase, voff) do { _Pragma("unroll") for (int _i = 0; _i < 2; ++_i) \
        __builtin_amdgcn_global_load_lds((const unsigned*)((const char*)(gbase) + (voff)[_i]), (LAS unsigned*)(lds + (bufoff) + ldsw + _i * 8192), 16, 0, 0); } while (0)
#define PG8_LDA(dst, b, h) do { _Pragma("unroll") for (int m = 0; m < 4; ++m) _Pragma("unroll") for (int k = 0; k < 2; ++k) dst[m][k] = *(const LAS bf16x8*)(lds + PG8_SA(b, h) + aoff + m * 2048 + k * 1024); } while (0)
#define PG8_LDB(dst, b, h) do { _Pragma("unroll") for (int n = 0; n < 2; ++n) _Pragma("unroll") for (int k = 0; k < 2; ++k) dst[n][k] = *(const LAS bf16x8*)(lds + PG8_SB(b, h) + boff + n * 2048 + k * 1024); } while (0)
#define PG8_MMA(ai, bj, At, Bt) do { __builtin_amdgcn_s_setprio(1); _Pragma("unroll") for (int m = 0; m < 4; ++m) _Pragma("unroll") for (int n = 0; n < 2; ++n) _Pragma("unroll") for (int k = 0; k < 2; ++k) \
        acc[ai][bj][m][n] = __builtin_amdgcn_mfma_f32_16x16x32_bf16(Bt[n][k], At[m][k], acc[ai][bj][m][n], 0, 0, 0); __builtin_amdgcn_s_setprio(0); } while (0)
#define PG8_WAIT_V(n) asm volatile("s_waitcnt vmcnt(" #n ")" ::: "memory")
#define PG8_WAIT_L(n) asm volatile("s_waitcnt lgkmcnt(" #n ")" ::: "memory")
#define PG8_BAR __builtin_amdgcn_s_barrier()
#define PG8_SCHED __builtin_amdgcn_sched_barrier(0)
    Unit cur, nxt; int ui = 0;
    if (!S.next(0, cur)) return;
    f32x4 acc[2][2][4][2];
#pragma unroll
    for (int a = 0; a < 2; ++a)
#pragma unroll
        for (int b = 0; b < 2; ++b)
#pragma unroll
            for (int m = 0; m < 4; ++m)
#pragma unroll
                for (int n = 0; n < 2; ++n) acc[a][b][m][n] = (f32x4){0.f, 0.f, 0.f, 0.f};
    bf16x8 At[4][2], B0[2][2], B1[2][2];
    const char* cA = (const char*)g.A + (size_t)cur.pm * tstep; const char* cB = (const char*)g.Bt + (size_t)cur.pn * tstep;
    S.a_ready(cur);
    if constexpr (SP2) {
        PG8_STAGE(PG8_SB(0, 0), cB, voffB); PG8_STAGE(PG8_SB(0, 1), cB + hstep, voffB); PG8_STAGE(PG8_SA(0, 0), cA, voffA); PG8_STAGE(PG8_SA(0, 1), cA + hstep, voffA);
        if (wr == 1) PG8_BAR;
        PG8_WAIT_V(2); PG8_BAR;
        PG8_STAGE(PG8_SB(1, 0), cB + kstep, voffB); PG8_STAGE(PG8_SA(1, 0), cA + kstep, voffA); PG8_STAGE(PG8_SB(1, 1), cB + hstep + kstep, voffB);
        PG8_WAIT_V(6); PG8_BAR;
    } else {
        PG8_STAGE(PG8_SB(0, 0), cB, voffB); PG8_STAGE(PG8_SA(0, 0), cA, voffA); PG8_STAGE(PG8_SB(0, 1), cB + hstep, voffB); PG8_STAGE(PG8_SA(0, 1), cA + hstep, voffA);
        if (wr == 1) PG8_BAR;
        PG8_WAIT_V(4); PG8_BAR;
        PG8_STAGE(PG8_SB(1, 0), cB + kstep, voffB); PG8_STAGE(PG8_SA(1, 0), cA + kstep, voffA); PG8_STAGE(PG8_SB(1, 1), cB + hstep + kstep, voffB);
        PG8_WAIT_V(6); PG8_BAR;
    }
    for (;;) {
        const bool has_next = S.next(ui + 1, nxt);
        const char* nA = has_next ? (const char*)g.A + (size_t)nxt.pm * tstep : cA; const char* nB = has_next ? (const char*)g.Bt + (size_t)nxt.pn * tstep : cB;
        for (int t = 0; t < nt; t += 2) {
            const bool last = (t == nt - 2);
            const char* a1 = cA + (size_t)(t + 1) * kstep;
            const char* a2 = last ? nA : cA + (size_t)(t + 2) * kstep; const char* b2 = last ? nB : cB + (size_t)(t + 2) * kstep;
            const char* a3 = a2 + kstep; const char* b3 = b2 + kstep;
            if (last && has_next) S.a_ready(nxt);
            if constexpr (SP2) {
            PG8_LDB(B0, 0, 0); PG8_LDB(B1, 0, 1); PG8_SCHED; PG8_LDA(At, 0, 0); PG8_STAGE(PG8_SA(1, 1), a1 + hstep, voffA);
            PG8_WAIT_V(8); PG8_WAIT_L(0); PG8_BAR; PG8_MMA(0, 0, At, B0); PG8_MMA(0, 1, At, B1); PG8_BAR; PG8_SCHED;
            PG8_LDA(At, 0, 1); PG8_STAGE(PG8_SB(0, 0), b2, voffB); PG8_STAGE(PG8_SB(0, 1), b2 + hstep, voffB); PG8_STAGE(PG8_SA(0, 0), a2, voffA);
            PG8_WAIT_V(8); PG8_WAIT_L(0); PG8_BAR; PG8_MMA(1, 0, At, B0); PG8_MMA(1, 1, At, B1); PG8_BAR; PG8_SCHED;
            PG8_LDB(B0, 1, 0); PG8_LDB(B1, 1, 1); PG8_SCHED; PG8_LDA(At, 1, 0); PG8_STAGE(PG8_SA(0, 1), a2 + hstep, voffA);
            PG8_WAIT_V(8); PG8_WAIT_L(0); PG8_BAR; PG8_MMA(0, 0, At, B0); PG8_MMA(0, 1, At, B1); PG8_BAR; PG8_SCHED;
            PG8_LDA(At, 1, 1); PG8_STAGE(PG8_SB(1, 0), b3, voffB); PG8_STAGE(PG8_SB(1, 1), b3 + hstep, voffB); PG8_STAGE(PG8_SA(1, 0), a3, voffA);
            PG8_WAIT_V(8); PG8_WAIT_L(0); PG8_BAR; PG8_MMA(1, 0, At, B0); PG8_MMA(1, 1, At, B1); PG8_BAR; PG8_SCHED;
            } else {
            PG8_LDB(B0, 0, 0); PG8_SCHED; PG8_LDA(At, 0, 0); PG8_STAGE(PG8_SA(1, 1), a1 + hstep, voffA);
            PG8_WAIT_L(8); PG8_BAR; PG8_WAIT_L(0); PG8_MMA(0, 0, At, B0); PG8_BAR; PG8_SCHED;
            PG8_LDB(B1, 0, 1); PG8_STAGE(PG8_SB(0, 0), b2, voffB);
            PG8_BAR; PG8_WAIT_L(0); PG8_MMA(0, 1, At, B1); PG8_BAR;
            PG8_LDA(At, 0, 1); PG8_STAGE(PG8_SA(0, 0), a2, voffA);
            PG8_BAR; PG8_WAIT_L(0); PG8_MMA(1, 0, At, B0); PG8_BAR; PG8_SCHED;
            PG8_STAGE(PG8_SB(0, 1), b2 + hstep, voffB);
            PG8_WAIT_V(6); PG8_BAR; PG8_MMA(1, 1, At, B1); PG8_BAR;
            PG8_LDB(B0, 1, 0); PG8_SCHED; PG8_LDA(At, 1, 0); PG8_STAGE(PG8_SA(0, 1), a2 + hstep, voffA);
            PG8_WAIT_L(8); PG8_BAR; PG8_WAIT_L(0); PG8_MMA(0, 0, At, B0); PG8_BAR; PG8_SCHED;
            PG8_LDB(B1, 1, 1); PG8_STAGE(PG8_SB(1, 0), b3, voffB);
            PG8_BAR; PG8_WAIT_L(0); PG8_MMA(0, 1, At, B1); PG8_BAR;
            PG8_LDA(At, 1, 1); PG8_STAGE(PG8_SA(1, 0), a3, voffA);
            PG8_BAR; PG8_WAIT_L(0); PG8_MMA(1, 0, At, B0); PG8_BAR; PG8_SCHED;
            PG8_STAGE(PG8_SB(1, 1), b3 + hstep, voffB);
            PG8_WAIT_V(6); PG8_BAR; PG8_MMA(1, 1, At, B1); PG8_BAR;
            }
        }
        if constexpr (ALIGN_EPI) { if (wr == 0) PG8_BAR; }
        E(acc, cur, wr, wc, fr, fq);
        if (!has_next) break;
#pragma unroll
        for (int a = 0; a < 2; ++a)
#pragma unroll
            for (int b = 0; b < 2; ++b)
#pragma unroll
                for (int m = 0; m < 4; ++m)
#pragma unroll
                    for (int n = 0; n < 2; ++n) acc[a][b][m][n] = (f32x4){0.f, 0.f, 0.f, 0.f};
        cur = nxt; cA = nA; cB = nB; ++ui;
        if constexpr (ALIGN_EPI) { if (wr == 1) PG8_BAR; }
    }
    PG8_WAIT_V(0);
    if constexpr (!ALIGN_EPI) { if (wr == 0) PG8_BAR; }
    PG8_BAR;
#undef PG8_SA
#undef PG8_SB
#undef PG8_STAGE
#undef PG8_LDA
#undef PG8_LDB
#undef PG8_MMA
#undef PG8_WAIT_V
#undef PG8_WAIT_L
#undef PG8_BAR
#undef PG8_SCHED
}

struct EpiSwiglu {
    static constexpr bool PERM = true;
    bf16_t* H;
    __device__ __forceinline__ void operator()(const f32x4 (&acc)[2][2][4][2], const Unit& u, int wr, int wc, int fr, int fq) const {
        const int row0 = u.pm * BM + wr * 64 + fr, col0 = u.pn * HALF + wc * 32 + 8 * fq;
#pragma unroll
        for (int ai = 0; ai < 2; ++ai)
#pragma unroll
            for (int m = 0; m < 4; ++m) {
                bf16_t* rowp = H + (size_t)(row0 + ai * HALF + m * 16) * DFF + col0;
                float o[8];
#pragma unroll
                for (int n = 0; n < 2; ++n)
#pragma unroll
                    for (int j = 0; j < 4; ++j) { const float a = acc[ai][0][m][n][j], b = acc[ai][1][m][n][j];
                        const float sg = fast_rcp(1.0f + fast_exp2(-1.4426950408889634f * a)); o[n * 4 + j] = a * sg * b; }
                u32x4 w; w.x = cvt_pk_bf16(o[0], o[1]); w.y = cvt_pk_bf16(o[2], o[3]); w.z = cvt_pk_bf16(o[4], o[5]); w.w = cvt_pk_bf16(o[6], o[7]);
                *(u32x4*)rowp = w;
            }
    }
};
struct EpiResid {
    static constexpr bool PERM = false;
    const float* resid; float* out; float alpha, beta;
    __device__ __forceinline__ void operator()(const f32x4 (&acc)[2][2][4][2], const Unit& u, int wr, int wc, int fr, int fq) const {
        const int col0 = u.pn * BM + wc * 32 + 4 * fq;
#pragma unroll
        for (int ai = 0; ai < 2; ++ai)
#pragma unroll
            for (int m = 0; m < 4; ++m) { const size_t off = (size_t)(u.pm * BM + ai * HALF + wr * 64 + m * 16 + fr) * DM + col0;
#pragma unroll
                for (int bj = 0; bj < 2; ++bj)
#pragma unroll
                    for (int n = 0; n < 2; ++n) { const size_t c = off + bj * HALF + n * 16; const f32x4 r = *(const f32x4*)(resid + c);
                        *(f32x4*)(out + c) = r * alpha + acc[ai][bj][m][n] * beta; } }
    }
};
struct EpiInProj {
    static constexpr bool PERM = false;
    bf16_t *QA, *KA, *VA, *QN, *KS, *VS, *KW, *VW; float *KCT, *VCT, *GT; const float *cosT, *sinT, *gateb;
    __device__ __forceinline__ void operator()(const f32x4 (&acc)[2][2][4][2], const Unit& u, int wr, int wc, int fr, int fq) const {
        const int pn = u.pn;
        const int d0 = 16 * wc + 4 * fq;
        if (pn == 20) {
#pragma unroll
            for (int ai = 0; ai < 2; ++ai)
#pragma unroll
                for (int m = 0; m < 4; ++m) { const int row = u.pm * BM + ai * HALF + wr * 64 + m * 16 + fr;
#pragma unroll
                    for (int j = 0; j < 4; ++j) { const int gc = d0 + j; if (gc < 30) { const float v = acc[ai][0][m][0][j] + gateb[gc]; GT[(size_t)row * 32 + gc] = fast_rcp(1.0f + fast_exp2(-1.4426950408889634f * v)); } } }
            return;
        }
        bool rope = false, isf32 = false; float sc = 1.f; bf16_t* bb = nullptr; float* fb = nullptr; int pitch = 128; size_t bjs = (size_t)S * 128; int colbase = 0;
        if (pn < 3)       { rope = true; sc = QSCALE; bb = QA; pitch = D_DIL; bjs = 128; colbase = 256 * pn; }
        else if (pn < 6)  { rope = true; bb = KA; pitch = D_DIL; bjs = 128; colbase = 256 * (pn - 3); }
        else if (pn < 9)  { bb = VA; pitch = D_DIL; bjs = 128; colbase = 256 * (pn - 6); }
        else if (pn < 14) { rope = true; sc = QSCALE; bb = QN; pitch = D_NSA; bjs = 128; colbase = 256 * (pn - 9); }
        else if (pn == 14) { isf32 = true; fb = KCT; }
        else if (pn == 15) { isf32 = true; fb = VCT; }
        else if (pn == 16) { rope = true; bb = KS; }
        else if (pn == 17) { bb = VS; }
        else if (pn == 18) { rope = true; bb = KW; }
        else               { bb = VW; }
#pragma unroll
        for (int ai = 0; ai < 2; ++ai)
#pragma unroll
            for (int m = 0; m < 4; ++m) {
                const int row = u.pm * BM + ai * HALF + wr * 64 + m * 16 + fr;
                f32x4 cs = (f32x4){1.f, 1.f, 1.f, 1.f}, sn = (f32x4){0.f, 0.f, 0.f, 0.f};
                if (rope) { cs = *(const f32x4*)(cosT + (size_t)row * 64 + d0); sn = *(const f32x4*)(sinT + (size_t)row * 64 + d0); }
#pragma unroll
                for (int bj = 0; bj < 2; ++bj) {
                    const f32x4 x1 = acc[ai][bj][m][0], x2 = acc[ai][bj][m][1];
                    const f32x4 o1 = (x1 * cs - x2 * sn) * sc, o2 = (x2 * cs + x1 * sn) * sc;
                    const size_t off = (size_t)row * pitch + bj * bjs + colbase + d0;
                    if (isf32) { *(f32x4*)(fb + off) = o1; *(f32x4*)(fb + off + 64) = o2; }
                    else { u32x2 w1, w2; w1.x = cvt_pk_bf16(o1[0], o1[1]); w1.y = cvt_pk_bf16(o1[2], o1[3]); w2.x = cvt_pk_bf16(o2[0], o2[1]); w2.y = cvt_pk_bf16(o2[2], o2[3]);
                        *(u32x2*)(bb + off) = w1; *(u32x2*)(bb + off + 64) = w2; }
                }
            }
    }
};
}

struct Params {
    const float* x; const int* pos;
    const float *ln1g, *ln1b, *f1w1, *f1w3, *f1w2, *win, *gateb, *cpe, *cw1, *cb1, *cw2, *cb2, *wout, *ln2g, *ln2b, *f2w1, *f2w3, *f2w2, *ln3g, *ln3b;
    float* out; unsigned char* ws; int ph_lo, ph_hi;
};

template <class SrcFn>
__device__ __forceinline__ void tr_item(int K, int k0, bf16_t* WT, int drow0, const SrcFn& src, LAS float* scr, int lane) {
    const float* sp = src(drow0 + (lane & 31));
    const int N = src.pitch;
#pragma unroll 8
    for (int i = 0; i < 32; ++i) { const int kk = 2 * i + (lane >> 5); scr[kk * 33 + (lane & 31)] = sp ? sp[(size_t)(k0 + kk) * N] : 0.f; }
    asm volatile("s_waitcnt lgkmcnt(0)" ::: "memory");
    const int c = lane & 7;
#pragma unroll
    for (int j = 0; j < 4; ++j) { const int n = (lane >> 3) + 8 * j; const LAS float* s = scr + (8 * c) * 33 + n;
        u32x4 o; o.x = pk2(s[0 * 33], s[1 * 33]); o.y = pk2(s[2 * 33], s[3 * 33]); o.z = pk2(s[4 * 33], s[5 * 33]); o.w = pk2(s[6 * 33], s[7 * 33]);
        *(u32x4*)(WT + (size_t)(drow0 + n) * K + k0 + 8 * c) = o; }
    asm volatile("s_waitcnt lgkmcnt(0)" ::: "memory");
}
struct SrcPlain { const float* W; int pitch; __device__ __forceinline__ const float* operator()(int r) const { return W + r; } };
struct SrcW13 { const float* W; int pitch; __device__ __forceinline__ const float* operator()(int r) const { const int pn = r >> 8, i = r & 127; return W + 128 * pn + i; } };
struct SrcWin { const float* W; int pitch; __device__ __forceinline__ const float* operator()(int r) const {
    const int p = r & 127, wc = (p >> 5) & 3, n = (p >> 4) & 1, d = 64 * n + 16 * wc + (p & 15); const int col = (r & ~127) + d; return col < IN_COLS ? W + col : nullptr; } };

__device__ __forceinline__ void p0_prologue(const Params& p, LAS unsigned char* lds) {
    const int tid = threadIdx.x, lane = tid & 63, wave = __builtin_amdgcn_readfirstlane(tid >> 6);
    LAS float* scr = (LAS float*)(lds + wave * 16384);
    const int gw = blockIdx.x * NWAVES + wave, NGW = gridDim.x * NWAVES;
    unsigned char* ws = p.ws;
    constexpr int I13 = (DM / 64) * (2 * DFF / 32), I2 = (DFF / 64) * (DM / 32), IIN = (DM / 64) * (IN_PAD / 32), IOUT = (DM / 64) * (DM / 32);
    constexpr int NITEMS = 2 * I13 + 2 * I2 + IIN + IOUT;
    for (int it = gw; it < NITEMS; it += NGW) {
        int r = it;
        if (r < I13) { const int nb = 2 * DFF / 32; const int dr = 32 * (r % nb); const float* W = p.f1w1; if ((dr >> 7) & 1) W = p.f1w3; SrcW13 s{W, DFF}; tr_item(DM, 64 * (r / nb), (bf16_t*)(ws + OFF_W13A), dr, s, scr, lane); continue; } r -= I13;
        if (r < I2)  { const int nb = DM / 32; SrcPlain s{p.f1w2, DM}; tr_item(DFF, 64 * (r / nb), (bf16_t*)(ws + OFF_W2A), 32 * (r % nb), s, scr, lane); continue; } r -= I2;
        if (r < I13) { const int nb = 2 * DFF / 32; const int dr = 32 * (r % nb); const float* W = p.f2w1; if ((dr >> 7) & 1) W = p.f2w3; SrcW13 s{W, DFF}; tr_item(DM, 64 * (r / nb), (bf16_t*)(ws + OFF_W13B), dr, s, scr, lane); continue; } r -= I13;
        if (r < I2)  { const int nb = DM / 32; SrcPlain s{p.f2w2, DM}; tr_item(DFF, 64 * (r / nb), (bf16_t*)(ws + OFF_W2B), 32 * (r % nb), s, scr, lane); continue; } r -= I2;
        if (r < IIN) { const int nb = IN_PAD / 32; SrcWin s{p.win, IN_COLS}; tr_item(DM, 64 * (r / nb), (bf16_t*)(ws + OFF_WIN), 32 * (r % nb), s, scr, lane); continue; } r -= IIN;
        { const int nb = DM / 32; SrcPlain s{p.wout, DM}; tr_item(DM, 64 * (r / nb), (bf16_t*)(ws + OFF_WOUT), 32 * (r % nb), s, scr, lane); }
    }
    {
        const size_t n8 = (size_t)S * DM / 8, gt = (size_t)blockIdx.x * NTHREADS + tid, GT_ = (size_t)gridDim.x * NTHREADS;
        bf16_t* XB = (bf16_t*)(ws + OFF_XB);
        for (size_t i = gt; i < n8; i += GT_) { const f32x4 a = *(const f32x4*)(p.x + i * 8), b = *(const f32x4*)(p.x + i * 8 + 4);
            u32x4 o; o.x = pk2(a[0], a[1]); o.y = pk2(a[2], a[3]); o.z = pk2(b[0], b[1]); o.w = pk2(b[2], b[3]); *(u32x4*)(XB + i * 8) = o; }
    }
    {
        float* cosT = (float*)(ws + OFF_ROPE); float* sinT = cosT + (size_t)S * 64;
        const int gt = blockIdx.x * NTHREADS + tid, GT_ = gridDim.x * NTHREADS;
        for (int i = gt; i < S * 64; i += GT_) { float c, s; rope_cs((double)p.pos[i >> 6], i & 63, c, s); cosT[i] = c; sinT[i] = s; }
    }
}

__device__ __forceinline__ void ln_phase(const float* in, float* outf, bf16_t* outb, const float* g, const float* b) {
    const int tid = threadIdx.x, lane = tid & 63, wave = __builtin_amdgcn_readfirstlane(tid >> 6);
    const int gw = blockIdx.x * NWAVES + wave, NGW = gridDim.x * NWAVES;
    for (int row = gw; row < S; row += NGW) {
        const f32x4* xr = (const f32x4*)(in + (size_t)row * DM) + lane;
        f32x4 v[8]; float s = 0.f;
#pragma unroll
        for (int j = 0; j < 8; ++j) { v[j] = xr[64 * j]; s += (v[j][0] + v[j][1]) + (v[j][2] + v[j][3]); }
        const float mean = wave_sum(s) * (1.f / DM); float s2 = 0.f;
#pragma unroll
        for (int j = 0; j < 8; ++j) { v[j] = v[j] - mean; s2 += (v[j][0] * v[j][0] + v[j][1] * v[j][1]) + (v[j][2] * v[j][2] + v[j][3] * v[j][3]); }
        const float rstd = 1.0f / sqrtf(wave_sum(s2) * (1.f / DM) + LN_EPS);
#pragma unroll
        for (int j = 0; j < 8; ++j) {
            const f32x4 gg = *((const f32x4*)g + lane + 64 * j), bb = *((const f32x4*)b + lane + 64 * j);
            const f32x4 o = v[j] * rstd * gg + bb;
            *((f32x4*)(outf + (size_t)row * DM) + lane + 64 * j) = o;
            if (outb) { u32x2 w; w.x = pk2(o[0], o[1]); w.y = pk2(o[2], o[3]); *((u32x2*)(outb + (size_t)row * DM) + lane + 64 * j) = w; }
        }
    }
}

__device__ __forceinline__ float dot128(const LAS bf16_t* q, const bf16_t* k) {
    float a0 = 0.f, a1 = 0.f;
#pragma unroll
    for (int c = 0; c < 16; ++c) { const u32x4 qv = *(const LAS u32x4*)(q + 8 * c); const u32x4 kv = *(const u32x4*)(k + 8 * c);
#pragma unroll
        for (int e = 0; e < 4; ++e) { a0 += bflo(qv[e]) * bflo(kv[e]); a1 += bfhi(qv[e]) * bfhi(kv[e]); } }
    return a0 + a1;
}
__device__ __forceinline__ float gelu_tanh(float x) {
    const float u = 0.7978845608028654f * (x + 0.044715f * x * x * x);
    const float e = __expf(2.f * u);
    const float th = 1.f - 2.f / (e + 1.f);
    return 0.5f * x * (1.f + th);
}

__device__ __forceinline__ void compress_naive(const Params& p, LAS unsigned char* lds) {
    const int tid = threadIdx.x;
    LAS float* A = (LAS float*)lds; LAS float* part = A + 4096; LAS float* hdn = part + 512; LAS float* outv = hdn + 256;
    unsigned char* ws = p.ws;
    bf16_t* KC = (bf16_t*)(ws + OFF_KC); bf16_t* VC = (bf16_t*)(ws + OFF_VC);
    for (int u = blockIdx.x; u < 2 * NG * 512; u += gridDim.x) {
        const int n = u & 511, g = (u >> 9) & 1, j = u >> 10;
        bf16_t* dst = (j ? VC : KC) + ((size_t)g * 512 + n) * 128;
        if (n >= NCMP) { if (tid < 128) dst[tid] = 0; continue; }
        const float* tok = (const float*)(ws + (j ? OFF_VCT : OFF_KCT)) + ((size_t)g * S + 16 * n) * 128;
        const float* pe = p.cpe + (size_t)j * 32 * 128;
        for (int i = tid; i < 4096; i += NTHREADS) A[i] = tok[i] + pe[i];
        __syncthreads();
        { const int h = tid & 255, half = tid >> 8; const float* w = p.cw1 + ((size_t)j * 4096 + 2048 * half) * 256 + h; const LAS float* a = A + 2048 * half;
          float acc = 0.f;
#pragma unroll 8
          for (int k = 0; k < 2048; ++k) acc += a[k] * w[(size_t)k * 256];
          part[tid] = acc; }
        __syncthreads();
        if (tid < 256) hdn[tid] = gelu_tanh(part[tid] + part[tid + 256] + p.cb1[j * 256 + tid]);
        __syncthreads();
        if (tid < 128) { const float* w = p.cw2 + (size_t)j * 256 * 128 + tid; float acc = p.cb2[j * 128 + tid];
#pragma unroll 8
            for (int h = 0; h < 256; ++h) acc += hdn[h] * w[(size_t)h * 128];
            outv[tid] = acc; }
        __syncthreads();
        if (j == 0) { if (tid < 64) { const double pc = 0.5 * ((double)p.pos[16 * n] + (double)p.pos[16 * n + 31]); float c, s; rope_cs(pc, tid, c, s);
                const float x1 = outv[tid], x2 = outv[tid + 64]; dst[tid] = (bf16_t)f2bf(x1 * c - x2 * s); dst[tid + 64] = (bf16_t)f2bf(x2 * c + x1 * s); } }
        else { if (tid < 128) dst[tid] = (bf16_t)f2bf(outv[tid]); }
        __syncthreads();
    }
}

__device__ __forceinline__ void dilated_naive(const Params& p, LAS unsigned char* lds) {
    const int tid = threadIdx.x, lane = tid & 63, wave = __builtin_amdgcn_readfirstlane(tid >> 6);
    LAS bf16_t* qs = (LAS bf16_t*)(lds + 32768) + wave * 128;
    unsigned char* ws = p.ws;
    const bf16_t* QA = (const bf16_t*)(ws + OFF_QA); const bf16_t* KA = (const bf16_t*)(ws + OFF_KA); const bf16_t* VA = (const bf16_t*)(ws + OFF_VA);
    bf16_t* MX = (bf16_t*)(ws + OFF_XB);
    const int gw = blockIdx.x * NWAVES + wave, NGW = gridDim.x * NWAVES;
    for (int u = gw; u < S * NH_DIL; u += NGW) {
        const int t = u / NH_DIL, h = u % NH_DIL;
        *(LAS unsigned*)(qs + 2 * lane) = *(const unsigned*)(QA + (size_t)t * D_DIL + h * 128 + 2 * lane);
        asm volatile("s_waitcnt lgkmcnt(0)" ::: "memory");
        float sc[3][3]; float m = -INFINITY;
#pragma unroll
        for (int c = 0; c < 3; ++c) { const int dil = c == 0 ? 1 : (c == 1 ? 4 : 16);
#pragma unroll
            for (int it = 0; it < 3; ++it) { const int k = lane + 64 * it; const int tk = t - dil * k; const bool valid = (k <= 128) && (tk >= 0);
                float s = -INFINITY; if (valid) s = dot128(qs, KA + (size_t)tk * D_DIL + h * 128); sc[c][it] = s; m = fmaxf(m, s); } }
        m = wave_max(m);
        float l = 0.f;
#pragma unroll
        for (int c = 0; c < 3; ++c)
#pragma unroll
            for (int it = 0; it < 3; ++it) { const float e = fast_exp2(sc[c][it] - m); sc[c][it] = e; l += e; }
        l = wave_sum(l);
        float o0 = 0.f, o1 = 0.f;
#pragma unroll
        for (int c = 0; c < 3; ++c) { const int dil = c == 0 ? 1 : (c == 1 ? 4 : 16);
#pragma unroll
            for (int it = 0; it < 3; ++it) { int cnt = 129 - 64 * it; cnt = cnt > 64 ? 64 : cnt; const int kmax = t / dil - 64 * it + 1; cnt = cnt < kmax ? cnt : kmax;
                for (int kk = 0; kk < cnt; ++kk) { const float pk = __uint_as_float(__builtin_amdgcn_readlane(__float_as_uint(sc[c][it]), kk));
                    const unsigned v = *(const unsigned*)(VA + (size_t)(t - dil * (kk + 64 * it)) * D_DIL + h * 128 + 2 * lane); o0 += pk * bflo(v); o1 += pk * bfhi(v); } } }
        const float inv = 1.f / l;
        *(unsigned*)(MX + (size_t)t * DM + h * 128 + 2 * lane) = pk2(o0 * inv, o1 * inv);
    }
}

__device__ __forceinline__ void nsa_naive(const Params& p, LAS unsigned char* lds) {
    const int tid = threadIdx.x, lane = tid & 63, wave = __builtin_amdgcn_readfirstlane(tid >> 6);
    LAS bf16_t* qsh = (LAS bf16_t*)lds;
    LAS float* Pc = (LAS float*)(lds + 2048);
    LAS int* sel = (LAS int*)(lds + 2048 + 10240);
    unsigned char* ws = p.ws;
    const bf16_t* QN = (const bf16_t*)(ws + OFF_QN);
    const bf16_t* KC = (const bf16_t*)(ws + OFF_KC); const bf16_t* VC = (const bf16_t*)(ws + OFF_VC);
    const bf16_t* KS = (const bf16_t*)(ws + OFF_KS); const bf16_t* VS = (const bf16_t*)(ws + OFF_VS);
    const bf16_t* KW = (const bf16_t*)(ws + OFF_KW); const bf16_t* VW = (const bf16_t*)(ws + OFF_VW);
    const float* GT = (const float*)(ws + OFF_GT);
    bf16_t* MX = (bf16_t*)(ws + OFF_XB);
    for (int u = blockIdx.x; u < S * NG; u += gridDim.x) {
        const int t = u >> 1, g = u & 1;
        const int h = HG * g + wave;
        LAS bf16_t* qs = qsh + wave * 128;
        float oc0 = 0.f, oc1 = 0.f;
        if (wave < HG) {
            *(LAS unsigned*)(qs + 2 * lane) = *(const unsigned*)(QN + (size_t)t * D_NSA + h * 128 + 2 * lane);
            asm volatile("s_waitcnt lgkmcnt(0)" ::: "memory");
            const int ncnt = (t >= 31) ? (t - 31) / 16 + 1 : 0;
            float s[8]; float m = -INFINITY;
#pragma unroll
            for (int it = 0; it < 8; ++it) { const int n = lane + 64 * it; float v = -INFINITY; if (n < ncnt) v = dot128(qs, KC + ((size_t)g * 512 + n) * 128); s[it] = v; m = fmaxf(m, v); }
            m = wave_max(m);
            float l = 0.f;
#pragma unroll
            for (int it = 0; it < 8; ++it) { const int n = lane + 64 * it; const float e = (n < ncnt) ? fast_exp2(s[it] - m) : 0.f; s[it] = e; l += e; }
            l = wave_sum(l);
            const float inv = l > 0.f ? 1.f / l : 0.f;
#pragma unroll
            for (int it = 0; it < 8; ++it) { s[it] *= inv; Pc[wave * 512 + lane + 64 * it] = s[it]; }
#pragma unroll
            for (int it = 0; it < 8; ++it) { int cnt = ncnt - 64 * it; cnt = cnt > 64 ? 64 : cnt;
                for (int kk = 0; kk < cnt; ++kk) { const float pk = __uint_as_float(__builtin_amdgcn_readlane(__float_as_uint(s[it]), kk));
                    const unsigned v = *(const unsigned*)(VC + ((size_t)g * 512 + 64 * it + kk) * 128 + 2 * lane); oc0 += pk * bflo(v); oc1 += pk * bfhi(v); } }
        }
        __syncthreads();
        if (wave == 0) {
            const int cur = t >> 6;
            float sc0, sc1;
            { const int jj = lane; float imp = 0.f;
              for (int n = 4 * jj - 1; n <= 4 * jj + 3; ++n) if (n >= 0 && n < NCMP) { for (int w = 0; w < HG; ++w) imp += Pc[w * 512 + n]; }
              const bool forced = (jj == 0) || (jj == cur) || (jj == cur - 1);
              sc0 = (jj <= cur) ? imp + (forced ? 1e4f : 0.f) : -1e30f; }
            { const int jj = lane + 64; float imp = 0.f;
              for (int n = 4 * jj - 1; n <= 4 * jj + 3; ++n) if (n >= 0 && n < NCMP) { for (int w = 0; w < HG; ++w) imp += Pc[w * 512 + n]; }
              const bool forced = (jj == 0) || (jj == cur) || (jj == cur - 1);
              sc1 = (jj <= cur) ? imp + (forced ? 1e4f : 0.f) : -1e30f; }
            for (int r = 0; r < 16; ++r) {
                const float mx = wave_max(fmaxf(sc0, sc1));
                const unsigned long long b0 = __ballot(sc0 == mx);
                int idx;
                if (b0) idx = __builtin_ctzll(b0); else { const unsigned long long b1 = __ballot(sc1 == mx); idx = 64 + __builtin_ctzll(b1); }
                if (lane == 0) sel[r] = (mx > -1e29f) ? idx : -1;
                if (idx < 64) { if (lane == idx) sc0 = -INFINITY; } else { if (lane == idx - 64) sc1 = -INFINITY; }
            }
        }
        __syncthreads();
        if (wave < HG) {
            float ss[16]; float m = -INFINITY;
#pragma unroll
            for (int r = 0; r < 16; ++r) { const int j = __builtin_amdgcn_readfirstlane(sel[r]); float v = -INFINITY;
                if (j >= 0) { const int kp = 64 * j + lane; if (kp <= t) v = dot128(qs, KS + ((size_t)g * S + kp) * 128); }
                ss[r] = v; m = fmaxf(m, v); }
            m = wave_max(m);
            float l = 0.f;
#pragma unroll
            for (int r = 0; r < 16; ++r) { const float e = fast_exp2(ss[r] - m); ss[r] = e; l += e; }
            l = wave_sum(l);
            float os0 = 0.f, os1 = 0.f;
#pragma unroll
            for (int r = 0; r < 16; ++r) { const int j = __builtin_amdgcn_readfirstlane(sel[r]); if (j >= 0) { int cnt = t - 64 * j + 1; cnt = cnt > 64 ? 64 : cnt;
                for (int kk = 0; kk < cnt; ++kk) { const float pk = __uint_as_float(__builtin_amdgcn_readlane(__float_as_uint(ss[r]), kk));
                    const unsigned v = *(const unsigned*)(VS + ((size_t)g * S + 64 * j + kk) * 128 + 2 * lane); os0 += pk * bflo(v); os1 += pk * bfhi(v); } } }
            const float invs = 1.f / l;
            float sw[8]; float mw = -INFINITY;
#pragma unroll
            for (int it = 0; it < 8; ++it) { const int kp = t - 511 + lane + 64 * it; float v = -INFINITY; if (kp >= 0) v = dot128(qs, KW + ((size_t)g * S + kp) * 128); sw[it] = v; mw = fmaxf(mw, v); }
            mw = wave_max(mw);
            float lw = 0.f;
#pragma unroll
            for (int it = 0; it < 8; ++it) { const float e = fast_exp2(sw[it] - mw); sw[it] = e; lw += e; }
            lw = wave_sum(lw);
            float ow0 = 0.f, ow1 = 0.f;
#pragma unroll
            for (int it = 0; it < 8; ++it) { const int kp0 = t - 511 + 64 * it; int k0 = kp0 < 0 ? -kp0 : 0; k0 = k0 > 64 ? 64 : k0;
                for (int kk = k0; kk < 64; ++kk) { const float pk = __uint_as_float(__builtin_amdgcn_readlane(__float_as_uint(sw[it]), kk));
                    const unsigned v = *(const unsigned*)(VW + ((size_t)g * S + kp0 + kk) * 128 + 2 * lane); ow0 += pk * bflo(v); ow1 += pk * bfhi(v); } }
            const float invw = 1.f / lw;
            const float g0 = GT[(size_t)t * 32 + h * 3 + 0], g1 = GT[(size_t)t * 32 + h * 3 + 1], g2 = GT[(size_t)t * 32 + h * 3 + 2];
            const float r0 = g0 * oc0 + g1 * os0 * invs + g2 * ow0 * invw, r1 = g0 * oc1 + g1 * os1 * invs + g2 * ow1 * invw;
            *(unsigned*)(MX + (size_t)t * DM + D_DIL + h * 128 + 2 * lane) = pk2(r0, r1);
        }
        __syncthreads();
    }
}

constexpr int N_PHASES = 12;
__global__ void __launch_bounds__(NTHREADS, 2) fwd_kernel(Params p) {
    extern __shared__ __attribute__((aligned(16))) unsigned char lds_raw[];
    LAS unsigned char* lds = (LAS unsigned char*)lds_raw;
    cg::grid_group grid = cg::this_grid();
    unsigned char* ws = p.ws;
    bf16_t* XB = (bf16_t*)(ws + OFF_XB); bf16_t* HID = (bf16_t*)(ws + OFF_HID);
    const int lo = p.ph_lo, hi = p.ph_hi;
#define IN(k) (lo <= (k) && (k) < hi)
#define SEAM(k) do { if (IN(k) && IN((k) + 1)) grid.sync(); } while (0)
    if (IN(0)) { p0_prologue(p, lds); }
    SEAM(0);
    if (IN(1)) { pg8::Gemm g{XB, (const bf16_t*)(ws + OFF_W13A), S, 2 * DFF, DM}; pg8::StaticOrder so; so.init(S, 2 * DFF, gridDim.x, blockIdx.x);
        pg8::EpiSwiglu E{HID}; pg8::gemm_phase<pg8::EpiSwiglu, pg8::StaticOrder, true, true>(lds, g, so, E); }
    SEAM(1);
    if (IN(2)) { pg8::Gemm g{HID, (const bf16_t*)(ws + OFF_W2A), S, DM, DFF}; pg8::StaticOrder so; so.init(S, DM, gridDim.x, blockIdx.x);
        pg8::EpiResid E{p.x, p.out, ALPHA, 0.5f}; pg8::gemm_phase<pg8::EpiResid, pg8::StaticOrder, true, true>(lds, g, so, E); }
    SEAM(2);
    if (IN(3)) { ln_phase(p.out, p.out, XB, p.ln1g, p.ln1b); }
    SEAM(3);
    if (IN(4)) { pg8::Gemm g{XB, (const bf16_t*)(ws + OFF_WIN), S, IN_PAD, DM}; pg8::StaticOrder so; so.init(S, IN_PAD, gridDim.x, blockIdx.x);
        pg8::EpiInProj E{(bf16_t*)(ws + OFF_QA), (bf16_t*)(ws + OFF_KA), (bf16_t*)(ws + OFF_VA), (bf16_t*)(ws + OFF_QN), (bf16_t*)(ws + OFF_KS), (bf16_t*)(ws + OFF_VS),
                         (bf16_t*)(ws + OFF_KW), (bf16_t*)(ws + OFF_VW), (float*)(ws + OFF_KCT), (float*)(ws + OFF_VCT), (float*)(ws + OFF_GT),
                         (const float*)(ws + OFF_ROPE), (const float*)(ws + OFF_ROPE) + (size_t)S * 64, p.gateb};
        pg8::gemm_phase<pg8::EpiInProj, pg8::StaticOrder, true, true>(lds, g, so, E); }
    SEAM(4);
    if (IN(5)) { compress_naive(p, lds); dilated_naive(p, lds); }
    SEAM(5);
    if (IN(6)) { nsa_naive(p, lds); }
    SEAM(6);
    if (IN(7)) { pg8::Gemm g{XB, (const bf16_t*)(ws + OFF_WOUT), S, DM, DM}; pg8::StaticOrder so; so.init(S, DM, gridDim.x, blockIdx.x);
        pg8::EpiResid E{p.out, p.out, ALPHA, 1.0f}; pg8::gemm_phase<pg8::EpiResid, pg8::StaticOrder, true, true>(lds, g, so, E); }
    SEAM(7);
    if (IN(8)) { ln_phase(p.out, p.out, XB, p.ln2g, p.ln2b); }
    SEAM(8);
    if (IN(9)) { pg8::Gemm g{XB, (const bf16_t*)(ws + OFF_W13B), S, 2 * DFF, DM}; pg8::StaticOrder so; so.init(S, 2 * DFF, gridDim.x, blockIdx.x);
        pg8::EpiSwiglu E{HID}; pg8::gemm_phase<pg8::EpiSwiglu, pg8::StaticOrder, true, true>(lds, g, so, E); }
    SEAM(9);
    if (IN(10)) { pg8::Gemm g{HID, (const bf16_t*)(ws + OFF_W2B), S, DM, DFF}; pg8::StaticOrder so; so.init(S, DM, gridDim.x, blockIdx.x);
        pg8::EpiResid E{p.out, p.out, ALPHA, 0.5f}; pg8::gemm_phase<pg8::EpiResid, pg8::StaticOrder, true, true>(lds, g, so, E); }
    SEAM(10);
    if (IN(11)) { ln_phase(p.out, p.out, nullptr, p.ln3g, p.ln3b); }
#undef IN
#undef SEAM
}

extern "C" void kernel_launch(void* const* d_in, const int* in_sizes, int n_in, void* d_out, int out_size, void* d_ws, size_t ws_size, hipStream_t stream) {
    static int grid = 0;
    if (grid == 0) {
        if (n_in != 22 || in_sizes[0] != S * DM || out_size != S * DM || ws_size < WS_END) {
            fprintf(stderr, "kernel_launch: unexpected shapes: n_in %d in0 %d out %d ws %zu (need >= %zu)\n", n_in, n_in > 0 ? in_sizes[0] : -1, out_size, ws_size, (size_t)WS_END); grid = -1; return; }
        int dev = 0, cus = 0, per_cu = 0;
        if (hipGetDevice(&dev) != hipSuccess || hipDeviceGetAttribute(&cus, hipDeviceAttributeMultiprocessorCount, dev) != hipSuccess) { fprintf(stderr, "kernel_launch: device query failed\n"); grid = -1; return; }
        if (hipFuncSetAttribute((const void*)fwd_kernel, hipFuncAttributeMaxDynamicSharedMemorySize, LDS_BYTES) != hipSuccess) { fprintf(stderr, "kernel_launch: hipFuncSetAttribute failed\n"); grid = -1; return; }
        if (hipOccupancyMaxActiveBlocksPerMultiprocessor(&per_cu, (const void*)fwd_kernel, NTHREADS, LDS_BYTES) != hipSuccess || per_cu < 1) { fprintf(stderr, "kernel_launch: occupancy query gave %d\n", per_cu); per_cu = 1; }
        (void)hipGetLastError();
        grid = cus;
    }
    if (grid < 0) return;
    Params p{};
    p.x = (const float*)d_in[0]; p.pos = (const int*)d_in[1];
    p.ln1g = (const float*)d_in[2]; p.ln1b = (const float*)d_in[3]; p.f1w1 = (const float*)d_in[4]; p.f1w3 = (const float*)d_in[5]; p.f1w2 = (const float*)d_in[6];
    p.win = (const float*)d_in[7]; p.gateb = (const float*)d_in[8]; p.cpe = (const float*)d_in[9]; p.cw1 = (const float*)d_in[10]; p.cb1 = (const float*)d_in[11];
    p.cw2 = (const float*)d_in[12]; p.cb2 = (const float*)d_in[13]; p.wout = (const float*)d_in[14]; p.ln2g = (const float*)d_in[15]; p.ln2b = (const float*)d_in[16];
    p.f2w1 = (const float*)d_in[17]; p.f2w3 = (const float*)d_in[18]; p.f2w2 = (const float*)d_in[19]; p.ln3g = (const float*)d_in[20]; p.ln3b = (const float*)d_in[21];
    p.out = (float*)d_out; p.ws = (unsigned char*)d_ws;
#if N_LAUNCH_PER_PHASE
    for (int k = 0; k < N_PHASES; ++k) {
        p.ph_lo = k; p.ph_hi = k + 1;
        void* args[] = {&p};
        hipError_t e = hipLaunchCooperativeKernel((const void*)fwd_kernel, dim3(grid), dim3(NTHREADS), args, LDS_BYTES, stream);
        if (e != hipSuccess) { fprintf(stderr, "kernel_launch: launch of phase %d failed: %s\n", k, hipGetErrorString(e)); break; }
    }
#else
    p.ph_lo = 0; p.ph_hi = N_PHASES;
    void* args[] = {&p};
    hipError_t e = hipLaunchCooperativeKernel((const void*)fwd_kernel, dim3(grid), dim3(NTHREADS), args, LDS_BYTES, stream);
    if (e != hipSuccess) fprintf(stderr, "kernel_launch: cooperative launch failed: %s (grid %d)\n", hipGetErrorString(e), grid);
#endif
}
```

```cpp
#include <hip/hip_runtime.h>
#include <hip/hip_cooperative_groups.h>
#include <cstdio>
#include <cstdint>
namespace cg = cooperative_groups;

#ifndef N_LAUNCH_PER_PHASE
#define N_LAUNCH_PER_PHASE 0
#endif

#define LAS __attribute__((address_space(3)))
typedef unsigned short bf16_t;
typedef short bf16x8 __attribute__((ext_vector_type(8)));
typedef float f32x4 __attribute__((ext_vector_type(4)));
typedef float f32x2 __attribute__((ext_vector_type(2)));
typedef unsigned u32x4 __attribute__((ext_vector_type(4)));
typedef unsigned u32x2 __attribute__((ext_vector_type(2)));

constexpr int S = 8192, DM = 2048, DFF = 5632, HD = 128;
constexpr int NH_DIL = 6, NH_NSA = 10, NG = 2, HG = 5;
constexpr int D_DIL = 768, D_NSA = 1280;
constexpr int IN_COLS = 5150, IN_PAD = 5376;
constexpr int NCMP = 511;
constexpr float LN_EPS = 1e-5f;
constexpr float ALPHA = 1.189207115002721f;
constexpr float QSCALE = 0.08838834764831845f * 1.4426950408889634f;
constexpr int NTHREADS = 512, NWAVES = 8;

constexpr size_t MiB = 1u << 20;
constexpr size_t OFF_CTL = 0;
constexpr size_t OFF_W13A = 1 * MiB, OFF_W2A = 45 * MiB, OFF_W13B = 67 * MiB, OFF_W2B = 111 * MiB;
constexpr size_t OFF_WIN = 133 * MiB, OFF_WOUT = 154 * MiB, OFF_CW1T = 162 * MiB, OFF_CW2T = 166 * MiB;
constexpr size_t OFF_ROPE = 167 * MiB;
constexpr size_t OFF_XB = 171 * MiB;
constexpr size_t OFF_HID = 203 * MiB;
constexpr size_t OFF_QA = 291 * MiB, OFF_KA = 303 * MiB, OFF_VA = 315 * MiB, OFF_QN = 327 * MiB;
constexpr size_t OFF_KCT = 347 * MiB, OFF_VCT = 355 * MiB;
constexpr size_t OFF_KS = 363 * MiB, OFF_VS = 367 * MiB, OFF_KW = 371 * MiB, OFF_VW = 375 * MiB;
constexpr size_t OFF_GT = 379 * MiB;
constexpr size_t OFF_KC = 380 * MiB;
constexpr size_t OFF_VC = OFF_KC + 256 * 1024;
constexpr size_t WS_END = 381 * MiB;

constexpr int LDS_BYTES = 147456;

__constant__ double INV_FREQ[64] = {
1.0, 0.8659643233600653, 0.7498942093324559, 0.6493816315762113,
0.5623413251903491, 0.4869675251658631, 0.4216965034285822, 0.3651741272548377,
0.31622776601683794, 0.27384196342643613, 0.23713737056616552, 0.2053525026457146,
0.1778279410038923, 0.1539926526059492, 0.1333521432163324, 0.11547819846894582,
0.1, 0.08659643233600653, 0.07498942093324558, 0.06493816315762113,
0.05623413251903491, 0.04869675251658631, 0.042169650342858224, 0.03651741272548377,
0.03162277660168379, 0.027384196342643614, 0.023713737056616554, 0.02053525026457146,
0.01778279410038923, 0.01539926526059492, 0.01333521432163324, 0.011547819846894581,
0.01, 0.008659643233600654, 0.007498942093324558, 0.006493816315762113,
0.005623413251903491, 0.004869675251658631, 0.004216965034285823, 0.003651741272548377,
0.0031622776601683794, 0.0027384196342643613, 0.0023713737056616554, 0.002053525026457146,
0.0017782794100389228, 0.001539926526059492, 0.001333521432163324, 0.0011547819846894581,
0.001, 0.0008659643233600654, 0.0007498942093324559, 0.0006493816315762113,
0.0005623413251903491, 0.0004869675251658631, 0.00042169650342858224, 0.0003651741272548377,
0.00031622776601683794, 0.0002738419634264361, 0.00023713737056616554, 0.0002053525026457146,
0.00017782794100389227, 0.0001539926526059492, 0.0001333521432163324, 0.00011547819846894582 };

__device__ __forceinline__ unsigned f2bf(float f) { unsigned u = __builtin_bit_cast(unsigned, f); return (u + 0x7fffu + ((u >> 16) & 1u)) >> 16; }
__device__ __forceinline__ unsigned pk2(float lo, float hi) { return f2bf(lo) | (f2bf(hi) << 16); }
__device__ __forceinline__ float bflo(unsigned u) { return __uint_as_float(u << 16); }
__device__ __forceinline__ float bfhi(unsigned u) { return __uint_as_float(u & 0xffff0000u); }
__device__ __forceinline__ float wave_sum(float v) {
#pragma unroll
    for (int o = 1; o < 64; o <<= 1) v += __shfl_xor(v, o);
    return v;
}
__device__ __forceinline__ float wave_max(float v) {
#pragma unroll
    for (int o = 1; o < 64; o <<= 1) v = fmaxf(v, __shfl_xor(v, o));
    return v;
}
__device__ __forceinline__ float fast_exp2(float x) { return __builtin_amdgcn_exp2f(x); }
__device__ __forceinline__ float fast_rcp(float x) { return __builtin_amdgcn_rcpf(x); }
__device__ __forceinline__ void rope_cs(double pos, int i, float& c, float& s) {
    const double rev = pos * INV_FREQ[i] * 0.15915494309189535;
    const double fr = rev - __builtin_rint(rev);
    const float f = (float)fr;
    c = __builtin_amdgcn_cosf(f); s = __builtin_amdgcn_sinf(f);
}

namespace pg8 {
constexpr int BM = 256, BK = 64, HALF = 128, HTB = HALF * BK * 2, STAGE_BYTES = 8 * HTB, NXCD = 8, WGM = 8;
__host__ __device__ __forceinline__ int lds_byte(int r, int c) { const int st = (r >> 4) * 2 + (c >> 5), rr = r & 15, cc = c & 31, ob = rr * 64 + cc * 2; return st * 1024 + (ob ^ (((ob >> 9) & 1) << 5)); }
__host__ __device__ __forceinline__ void stage_rc(int b, int& R, int& C) { const int st = b / 1024, sb = b % 1024, swz = sb ^ (((sb >> 9) & 1) << 5); R = (st >> 1) * 16 + swz / 64; C = (st & 1) * 32 + (swz % 64) / 2; }
__host__ __device__ __forceinline__ int perm32(int rho) { const int n = rho >> 4, i = rho & 15; return 8 * (i >> 2) + 4 * n + (i & 3); }
struct Unit { int pm, pn; };
struct Gemm { const bf16_t* A; const bf16_t* Bt; int M, N, K; };
struct StaticOrder {
    int nM, nN, nwg, G, c;
    __host__ __device__ void init(int M, int N, int G_, int c_) { nM = M / BM; nN = N / BM; nwg = nM * nN; G = G_; c = c_; }
    __host__ __device__ bool next(int i, Unit& u) const {
        const long L = (long)i * G + c; if (L >= nwg) return false;
        int wgid = (int)L; { const int q = nwg / NXCD, r = nwg % NXCD, xcd = wgid % NXCD, off = wgid / NXCD; wgid = (xcd < r ? xcd * (q + 1) : r * (q + 1) + (xcd - r) * q) + off; }
        const int nig = WGM * nN, gid = wgid / nig, fm = gid * WGM, gsz = (nM - fm) < WGM ? (nM - fm) : WGM;
        u.pm = fm + ((wgid % nig) % gsz); u.pn = (wgid % nig) / gsz; return true;
    }
    __device__ __forceinline__ void a_ready(const Unit&) const {}
    __device__ __forceinline__ void done(const Unit&) const {}
};
__device__ __forceinline__ unsigned cvt_pk_bf16(float lo, float hi) { unsigned r; asm volatile("v_cvt_pk_bf16_f32 %0, %1, %2" : "=v"(r) : "v"(lo), "v"(hi)); return r; }

template <class Epi, class Sched, bool ALIGN_EPI = false, bool SP2 = false>
__device__ __forceinline__ void gemm_phase(LAS unsigned char* lds, const Gemm g, const Sched& S, const Epi& E) {
    const int tid = threadIdx.x, wid = __builtin_amdgcn_readfirstlane(tid >> 6), lane = tid & 63, wr = wid >> 2, wc = wid & 3, fr = lane & 15, fq = lane >> 4;
    const int K = g.K, nt = K / BK;
    unsigned voffA[2], voffB[2];
#pragma unroll
    for (int i = 0; i < 2; ++i) { int R, C; stage_rc(tid * 16 + i * 8192, R, C); const int Rb = Epi::PERM ? ((R & ~31) + perm32(R & 31)) : R;
        voffA[i] = (unsigned)(R * K + C) * 2u; voffB[i] = (unsigned)(Rb * K + C) * 2u; }
    const size_t kstep = (size_t)(BK * 2);
    const size_t hstep = (size_t)HALF * K * 2;
    const size_t tstep = 2 * hstep;
    const unsigned ldsw = (unsigned)wid * 1024u;
    const int aoff = lds_byte(wr * 64 + fr, fq * 8), boff = lds_byte(wc * 32 + fr, fq * 8);
#define PG8_SA(b, h) (((b) * 2 + (h)) * HTB)
#define PG8_SB(b, h) ((4 + (b) * 2 + (h)) * HTB)
#define PG8_STAGE(bufoff, gbase, voff) do { _Pragma("unroll") for (int _i = 0; _i < 2; ++_i) \
        __builtin_amdgcn_global_load_lds((const unsigned*)((const char*)(gbase) + (voff)[_i]), (LAS unsigned*)(lds + (bufoff) + ldsw + _i * 8192), 16, 0, 0); } while (0)
#define PG8_LDA(dst, b, h) do { _Pragma("unroll") for (int m = 0; m < 4; ++m) _Pragma("unroll") for (int k = 0; k < 2; ++k) dst[m][k] = *(const LAS bf16x8*)(lds + PG8_SA(b, h) + aoff + m * 2048 + k * 1024); } while (0)
#define PG8_LDB(dst, b, h) do { _Pragma("unroll") for (int n = 0; n < 2; ++n) _Pragma("unroll") for (int k = 0; k < 2; ++k) dst[n][k] = *(const LAS bf16x8*)(lds + PG8_SB(b, h) + boff + n * 2048 + k * 1024); } while (0)
#define PG8_MMA(ai, bj, At, Bt) do { __builtin_amdgcn_s_setprio(1); _Pragma("unroll") for (int m = 0; m < 4; ++m) _Pragma("unroll") for (int n = 0; n < 2; ++n) _Pragma("unroll") for (int k = 0; k < 2; ++k) \
        acc[ai][bj][m][n] = __builtin_amdgcn_mfma_f32_16x16x32_bf16(Bt[n][k], At[m][k], acc[ai][bj][m][n], 0, 0, 0); __builtin_amdgcn_s_setprio(0); } while (0)
#define PG8_WAIT_V(n) asm volatile("s_waitcnt vmcnt(" #n ")" ::: "memory")
#define PG8_WAIT_L(n) asm volatile("s_waitcnt lgkmcnt(" #n ")" ::: "memory")
#define PG8_BAR __builtin_amdgcn_s_barrier()
#define PG8_SCHED __builtin_amdgcn_sched_barrier(0)
    Unit cur, nxt; int ui = 0;
    if (!S.next(0, cur)) return;
    f32x4 acc[2][2][4][2];
#pragma unroll
    for (int a = 0; a < 2; ++a)
#pragma unroll
        for (int b = 0; b < 2; ++b)
#pragma unroll
            for (int m = 0; m < 4; ++m)
#pragma unroll
                for (int n = 0; n < 2; ++n) acc[a][b][m][n] = (f32x4){0.f, 0.f, 0.f, 0.f};
    bf16x8 At[4][2], B0[2][2], B1[2][2];
    const char* cA = (const char*)g.A + (size_t)cur.pm * tstep; const char* cB = (const char*)g.Bt + (size_t)cur.pn * tstep;
    S.a_ready(cur);
    if constexpr (SP2) {
        PG8_STAGE(PG8_SB(0, 0), cB, voffB); PG8_STAGE(PG8_SB(0, 1), cB + hstep, voffB); PG8_STAGE(PG8_SA(0, 0), cA, voffA); PG8_STAGE(PG8_SA(0, 1), cA + hstep, voffA);
        if (wr == 1) PG8_BAR;
        PG8_WAIT_V(2); PG8_BAR;
        PG8_STAGE(PG8_SB(1, 0), cB + kstep, voffB); PG8_STAGE(PG8_SA(1, 0), cA + kstep, voffA); PG8_STAGE(PG8_SB(1, 1), cB + hstep + kstep, voffB);
        PG8_WAIT_V(6); PG8_BAR;
    } else {
        PG8_STAGE(PG8_SB(0, 0), cB, voffB); PG8_STAGE(PG8_SA(0, 0), cA, voffA); PG8_STAGE(PG8_SB(0, 1), cB + hstep, voffB); PG8_STAGE(PG8_SA(0, 1), cA + hstep, voffA);
        if (wr == 1) PG8_BAR;
        PG8_WAIT_V(4); PG8_BAR;
        PG8_STAGE(PG8_SB(1, 0), cB + kstep, voffB); PG8_STAGE(PG8_SA(1, 0), cA + kstep, voffA); PG8_STAGE(PG8_SB(1, 1), cB + hstep + kstep, voffB);
        PG8_WAIT_V(6); PG8_BAR;
    }
    for (;;) {
        const bool has_next = S.next(ui + 1, nxt);
        const char* nA = has_next ? (const char*)g.A + (size_t)nxt.pm * tstep : cA; const char* nB = has_next ? (const char*)g.Bt + (size_t)nxt.pn * tstep : cB;
        for (int t = 0; t < nt; t += 2) {
            const bool last = (t == nt - 2);
            const char* a1 = cA + (size_t)(t + 1) * kstep;
            const char* a2 = last ? nA : cA + (size_t)(t + 2) * kstep; const char* b2 = last ? nB : cB + (size_t)(t + 2) * kstep;
            const char* a3 = a2 + kstep; const char* b3 = b2 + kstep;
            if (last && has_next) S.a_ready(nxt);
            if constexpr (SP2) {
            PG8_LDB(B0, 0, 0); PG8_LDB(B1, 0, 1); PG8_SCHED; PG8_LDA(At, 0, 0); PG8_STAGE(PG8_SA(1, 1), a1 + hstep, voffA);
            PG8_WAIT_V(8); PG8_WAIT_L(0); PG8_BAR; PG8_MMA(0, 0, At, B0); PG8_MMA(0, 1, At, B1); PG8_BAR; PG8_SCHED;
            PG8_LDA(At, 0, 1); PG8_STAGE(PG8_SB(0, 0), b2, voffB); PG8_STAGE(PG8_SB(0, 1), b2 + hstep, voffB); PG8_STAGE(PG8_SA(0, 0), a2, voffA);
            PG8_WAIT_V(8); PG8_WAIT_L(0); PG8_BAR; PG8_MMA(1, 0, At, B0); PG8_MMA(1, 1, At, B1); PG8_BAR; PG8_SCHED;
            PG8_LDB(B0, 1, 0); PG8_LDB(B1, 1, 1); PG8_SCHED; PG8_LDA(At, 1, 0); PG8_STAGE(PG8_SA(0, 1), a2 + hstep, voffA);
            PG8_WAIT_V(8); PG8_WAIT_L(0); PG8_BAR; PG8_MMA(0, 0, At, B0); PG8_MMA(0, 1, At, B1); PG8_BAR; PG8_SCHED;
            PG8_LDA(At, 1, 1); PG8_STAGE(PG8_SB(1, 0), b3, voffB); PG8_STAGE(PG8_SB(1, 1), b3 + hstep, voffB); PG8_STAGE(PG8_SA(1, 0), a3, voffA);
            PG8_WAIT_V(8); PG8_WAIT_L(0); PG8_BAR; PG8_MMA(1, 0, At, B0); PG8_MMA(1, 1, At, B1); PG8_BAR; PG8_SCHED;
            } else {
            PG8_LDB(B0, 0, 0); PG8_SCHED; PG8_LDA(At, 0, 0); PG8_STAGE(PG8_SA(1, 1), a1 + hstep, voffA);
            PG8_WAIT_L(8); PG8_BAR; PG8_WAIT_L(0); PG8_MMA(0, 0, At, B0); PG8_BAR; PG8_SCHED;
            PG8_LDB(B1, 0, 1); PG8_STAGE(PG8_SB(0, 0), b2, voffB);
            PG8_BAR; PG8_WAIT_L(0); PG8_MMA(0, 1, At, B1); PG8_BAR;
            PG8_LDA(At, 0, 1); PG8_STAGE(PG8_SA(0, 0), a2, voffA);
            PG8_BAR; PG8_WAIT_L(0); PG8_MMA(1, 0, At, B0); PG8_BAR; PG8_SCHED;
            PG8_STAGE(PG8_SB(0, 1), b2 + hstep, voffB);
            PG8_WAIT_V(6); PG8_BAR; PG8_MMA(1, 1, At, B1); PG8_BAR;
            PG8_LDB(B0, 1, 0); PG8_SCHED; PG8_LDA(At, 1, 0); PG8_STAGE(PG8_SA(0, 1), a2 + hstep, voffA);
            PG8_WAIT_L(8); PG8_BAR; PG8_WAIT_L(0); PG8_MMA(0, 0, At, B0); PG8_BAR; PG8_SCHED;
            PG8_LDB(B1, 1, 1); PG8_STAGE(PG8_SB(1, 0), b3, voffB);
            PG8_BAR; PG8_WAIT_L(0); PG8_MMA(0, 1, At, B1); PG8_BAR;
            PG8_LDA(At, 1, 1); PG8_STAGE(PG8_SA(1, 0), a3, voffA);
            PG8_BAR; PG8_WAIT_L(0); PG8_MMA(1, 0, At, B0); PG8_BAR; PG8_SCHED;
            PG8_STAGE(PG8_SB(1, 1), b3 + hstep, voffB);
            PG8_WAIT_V(6); PG8_BAR; PG8_MMA(1, 1, At, B1); PG8_BAR;
            }
        }
        if constexpr (ALIGN_EPI) { if (wr == 0) PG8_BAR; }
        E(acc, cur, wr, wc, fr, fq);
        if (!has_next) break;
#pragma unroll
        for (int a = 0; a < 2; ++a)
#pragma unroll
            for (int b = 0; b < 2; ++b)
#pragma unroll
                for (int m = 0; m < 4; ++m)
#pragma unroll
                    for (int n = 0; n < 2; ++n) acc[a][b][m][n] = (f32x4){0.f, 0.f, 0.f, 0.f};
        cur = nxt; cA = nA; cB = nB; ++ui;
        if constexpr (ALIGN_EPI) { if (wr == 1) PG8_BAR; }
    }
    PG8_WAIT_V(0);
    if constexpr (!ALIGN_EPI) { if (wr == 0) PG8_BAR; }
    PG8_BAR;
#undef PG8_SA
#undef PG8_SB
#undef PG8_STAGE
#undef PG8_LDA
#undef PG8_LDB
#undef PG8_MMA
#undef PG8_WAIT_V
#undef PG8_WAIT_L
#undef PG8_BAR
#undef PG8_SCHED
}

struct EpiSwiglu {
    static constexpr bool PERM = true;
    bf16_t* H;
    __device__ __forceinline__ void operator()(const f32x4 (&acc)[2][2][4][2], const Unit& u, int wr, int wc, int fr, int fq) const {
        const int row0 = u.pm * BM + wr * 64 + fr, col0 = u.pn * HALF + wc * 32 + 8 * fq;
#pragma unroll
        for (int ai = 0; ai < 2; ++ai)
#pragma unroll
            for (int m = 0; m < 4; ++m) {
                bf16_t* rowp = H + (size_t)(row0 + ai * HALF + m * 16) * DFF + col0;
                float o[8];
#pragma unroll
                for (int n = 0; n < 2; ++n)
#pragma unroll
                    for (int j = 0; j < 4; ++j) { const float a = acc[ai][0][m][n][j], b = acc[ai][1][m][n][j];
                        const float sg = fast_rcp(1.0f + fast_exp2(-1.4426950408889634f * a)); o[n * 4 + j] = a * sg * b; }
                u32x4 w; w.x = cvt_pk_bf16(o[0], o[1]); w.y = cvt_pk_bf16(o[2], o[3]); w.z = cvt_pk_bf16(o[4], o[5]); w.w = cvt_pk_bf16(o[6], o[7]);
                *(u32x4*)rowp = w;
            }
    }
};
struct EpiResid {
    static constexpr bool PERM = false;
    const float* resid; float* out; float alpha, beta;
    __device__ __forceinline__ void operator()(const f32x4 (&acc)[2][2][4][2], const Unit& u, int wr, int wc, int fr, int fq) const {
        const int col0 = u.pn * BM + wc * 32 + 4 * fq;
#pragma unroll
        for (int ai = 0; ai < 2; ++ai)
#pragma unroll
            for (int m = 0; m < 4; ++m) { const size_t off = (size_t)(u.pm * BM + ai * HALF + wr * 64 + m * 16 + fr) * DM + col0;
#pragma unroll
                for (int bj = 0; bj < 2; ++bj)
#pragma unroll
                    for (int n = 0; n < 2; ++n) { const size_t c = off + bj * HALF + n * 16; const f32x4 r = *(const f32x4*)(resid + c);
                        *(f32x4*)(out + c) = r * alpha + acc[ai][bj][m][n] * beta; } }
    }
};
struct EpiInProj {
    static constexpr bool PERM = false;
    bf16_t *QA, *KA, *VA, *QN, *KS, *VS, *KW, *VW; float *KCT, *VCT, *GT; const float *cosT, *sinT, *gateb;
    __device__ __forceinline__ void operator()(const f32x4 (&acc)[2][2][4][2], const Unit& u, int wr, int wc, int fr, int fq) const {
        const int pn = u.pn;
        const int d0 = 16 * wc + 4 * fq;
        if (pn == 20) {
#pragma unroll
            for (int ai = 0; ai < 2; ++ai)
#pragma unroll
                for (int m = 0; m < 4; ++m) { const int row = u.pm * BM + ai * HALF + wr * 64 + m * 16 + fr;
#pragma unroll
                    for (int j = 0; j < 4; ++j) { const int gc = d0 + j; if (gc < 30) { const float v = acc[ai][0][m][0][j] + gateb[gc]; GT[(size_t)row * 32 + gc] = fast_rcp(1.0f + fast_exp2(-1.4426950408889634f * v)); } } }
            return;
        }
        bool rope = false, isf32 = false; float sc = 1.f; bf16_t* bb = nullptr; float* fb = nullptr; int pitch = 128; size_t bjs = (size_t)S * 128; int colbase = 0;
        if (pn < 3)       { rope = true; sc = QSCALE; bb = QA; pitch = D_DIL; bjs = 128; colbase = 256 * pn; }
        else if (pn < 6)  { rope = true; bb = KA; pitch = D_DIL; bjs = 128; colbase = 256 * (pn - 3); }
        else if (pn < 9)  { bb = VA; pitch = D_DIL; bjs = 128; colbase = 256 * (pn - 6); }
        else if (pn < 14) { rope = true; sc = QSCALE; bb = QN; pitch = D_NSA; bjs = 128; colbase = 256 * (pn - 9); }
        else if (pn == 14) { isf32 = true; fb = KCT; }
        else if (pn == 15) { isf32 = true; fb = VCT; }
        else if (pn == 16) { rope = true; bb = KS; }
        else if (pn == 17) { bb = VS; }
        else if (pn == 18) { rope = true; bb = KW; }
        else               { bb = VW; }
#pragma unroll
        for (int ai = 0; ai < 2; ++ai)
#pragma unroll
            for (int m = 0; m < 4; ++m) {
                const int row = u.pm * BM + ai * HALF + wr * 64 + m * 16 + fr;
                f32x4 cs = (f32x4){1.f, 1.f, 1.f, 1.f}, sn = (f32x4){0.f, 0.f, 0.f, 0.f};
                if (rope) { cs = *(const f32x4*)(cosT + (size_t)row * 64 + d0); sn = *(const f32x4*)(sinT + (size_t)row * 64 + d0); }
#pragma unroll
                for (int bj = 0; bj < 2; ++bj) {
                    const f32x4 x1 = acc[ai][bj][m][0], x2 = acc[ai][bj][m][1];
                    const f32x4 o1 = (x1 * cs - x2 * sn) * sc, o2 = (x2 * cs + x1 * sn) * sc;
                    const size_t off = (size_t)row * pitch + bj * bjs + colbase + d0;
                    if (isf32) { *(f32x4*)(fb + off) = o1; *(f32x4*)(fb + off + 64) = o2; }
                    else { u32x2 w1, w2; w1.x = cvt_pk_bf16(o1[0], o1[1]); w1.y = cvt_pk_bf16(o1[2], o1[3]); w2.x = cvt_pk_bf16(o2[0], o2[1]); w2.y = cvt_pk_bf16(o2[2], o2[3]);
                        *(u32x2*)(bb + off) = w1; *(u32x2*)(bb + off + 64) = w2; }
                }
            }
    }
};
}

struct Params {
    const float* x; const int* pos;
    const float *ln1g, *ln1b, *f1w1, *f1w3, *f1w2, *win, *gateb, *cpe, *cw1, *cb1, *cw2, *cb2, *wout, *ln2g, *ln2b, *f2w1, *f2w3, *f2w2, *ln3g, *ln3b;
    float* out; unsigned char* ws; int ph_lo, ph_hi;
};

template <class SrcFn>
__device__ __forceinline__ void tr_item(int K, int k0, bf16_t* WT, int drow0, const SrcFn& src, LAS float* scr, int lane) {
    const float* sp = src(drow0 + (lane & 31));
    const int N = src.pitch;
#pragma unroll 8
    for (int i = 0; i < 32; ++i) { const int kk = 2 * i + (lane >> 5); scr[kk * 33 + (lane & 31)] = sp ? sp[(size_t)(k0 + kk) * N] : 0.f; }
    asm volatile("s_waitcnt lgkmcnt(0)" ::: "memory");
    const int c = lane & 7;
#pragma unroll
    for (int j = 0; j < 4; ++j) { const int n = (lane >> 3) + 8 * j; const LAS float* s = scr + (8 * c) * 33 + n;
        u32x4 o; o.x = pk2(s[0 * 33], s[1 * 33]); o.y = pk2(s[2 * 33], s[3 * 33]); o.z = pk2(s[4 * 33], s[5 * 33]); o.w = pk2(s[6 * 33], s[7 * 33]);
        *(u32x4*)(WT + (size_t)(drow0 + n) * K + k0 + 8 * c) = o; }
    asm volatile("s_waitcnt lgkmcnt(0)" ::: "memory");
}
struct SrcPlain { const float* W; int pitch; __device__ __forceinline__ const float* operator()(int r) const { return W + r; } };
struct SrcW13 { const float* W; int pitch; __device__ __forceinline__ const float* operator()(int r) const { const int pn = r >> 8, i = r & 127; return W + 128 * pn + i; } };
struct SrcWin { const float* W; int pitch; __device__ __forceinline__ const float* operator()(int r) const {
    const int p = r & 127, wc = (p >> 5) & 3, n = (p >> 4) & 1, d = 64 * n + 16 * wc + (p & 15); const int col = (r & ~127) + d; return col < IN_COLS ? W + col : nullptr; } };

__device__ __forceinline__ void p0_prologue(const Params& p, LAS unsigned char* lds) {
    const int tid = threadIdx.x, lane = tid & 63, wave = __builtin_amdgcn_readfirstlane(tid >> 6);
    LAS float* scr = (LAS float*)(lds + wave * 16384);
    const int gw = blockIdx.x * NWAVES + wave, NGW = gridDim.x * NWAVES;
    unsigned char* ws = p.ws;
    constexpr int I13 = (DM / 64) * (2 * DFF / 32), I2 = (DFF / 64) * (DM / 32), IIN = (DM / 64) * (IN_PAD / 32), IOUT = (DM / 64) * (DM / 32);
    constexpr int NITEMS = 2 * I13 + 2 * I2 + IIN + IOUT;
    for (int it = gw; it < NITEMS; it += NGW) {
        int r = it;
        if (r < I13) { const int nb = 2 * DFF / 32; const int dr = 32 * (r % nb); const float* W = p.f1w1; if ((dr >> 7) & 1) W = p.f1w3; SrcW13 s{W, DFF}; tr_item(DM, 64 * (r / nb), (bf16_t*)(ws + OFF_W13A), dr, s, scr, lane); continue; } r -= I13;
        if (r < I2)  { const int nb = DM / 32; SrcPlain s{p.f1w2, DM}; tr_item(DFF, 64 * (r / nb), (bf16_t*)(ws + OFF_W2A), 32 * (r % nb), s, scr, lane); continue; } r -= I2;
        if (r < I13) { const int nb = 2 * DFF / 32; const int dr = 32 * (r % nb); const float* W = p.f2w1; if ((dr >> 7) & 1) W = p.f2w3; SrcW13 s{W, DFF}; tr_item(DM, 64 * (r / nb), (bf16_t*)(ws + OFF_W13B), dr, s, scr, lane); continue; } r -= I13;
        if (r < I2)  { const int nb = DM / 32; SrcPlain s{p.f2w2, DM}; tr_item(DFF, 64 * (r / nb), (bf16_t*)(ws + OFF_W2B), 32 * (r % nb), s, scr, lane); continue; } r -= I2;
        if (r < IIN) { const int nb = IN_PAD / 32; SrcWin s{p.win, IN_COLS}; tr_item(DM, 64 * (r / nb), (bf16_t*)(ws + OFF_WIN), 32 * (r % nb), s, scr, lane); continue; } r -= IIN;
        { const int nb = DM / 32; SrcPlain s{p.wout, DM}; tr_item(DM, 64 * (r / nb), (bf16_t*)(ws + OFF_WOUT), 32 * (r % nb), s, scr, lane); }
    }
    {
        const size_t n8 = (size_t)S * DM / 8, gt = (size_t)blockIdx.x * NTHREADS + tid, GT_ = (size_t)gridDim.x * NTHREADS;
        bf16_t* XB = (bf16_t*)(ws + OFF_XB);
        for (size_t i = gt; i < n8; i += GT_) { const f32x4 a = *(const f32x4*)(p.x + i * 8), b = *(const f32x4*)(p.x + i * 8 + 4);
            u32x4 o; o.x = pk2(a[0], a[1]); o.y = pk2(a[2], a[3]); o.z = pk2(b[0], b[1]); o.w = pk2(b[2], b[3]); *(u32x4*)(XB + i * 8) = o; }
    }
    {
        float* cosT = (float*)(ws + OFF_ROPE); float* sinT = cosT + (size_t)S * 64;
        const int gt = blockIdx.x * NTHREADS + tid, GT_ = gridDim.x * NTHREADS;
        for (int i = gt; i < S * 64; i += GT_) { float c, s; rope_cs((double)p.pos[i >> 6], i & 63, c, s); cosT[i] = c; sinT[i] = s; }
    }
}

__device__ __forceinline__ void ln_phase(const float* in, float* outf, bf16_t* outb, const float* g, const float* b) {
    const int tid = threadIdx.x, lane = tid & 63, wave = __builtin_amdgcn_readfirstlane(tid >> 6);
    const int gw = blockIdx.x * NWAVES + wave, NGW = gridDim.x * NWAVES;
    for (int row = gw; row < S; row += NGW) {
        const f32x4* xr = (const f32x4*)(in + (size_t)row * DM) + lane;
        f32x4 v[8]; float s = 0.f;
#pragma unroll
        for (int j = 0; j < 8; ++j) { v[j] = xr[64 * j]; s += (v[j][0] + v[j][1]) + (v[j][2] + v[j][3]); }
        const float mean = wave_sum(s) * (1.f / DM); float s2 = 0.f;
#pragma unroll
        for (int j = 0; j < 8; ++j) { v[j] = v[j] - mean; s2 += (v[j][0] * v[j][0] + v[j][1] * v[j][1]) + (v[j][2] * v[j][2] + v[j][3] * v[j][3]); }
        const float rstd = 1.0f / sqrtf(wave_sum(s2) * (1.f / DM) + LN_EPS);
#pragma unroll
        for (int j = 0; j < 8; ++j) {
            const f32x4 gg = *((const f32x4*)g + lane + 64 * j), bb = *((const f32x4*)b + lane + 64 * j);
            const f32x4 o = v[j] * rstd * gg + bb;
            *((f32x4*)(outf + (size_t)row * DM) + lane + 64 * j) = o;
            if (outb) { u32x2 w; w.x = pk2(o[0], o[1]); w.y = pk2(o[2], o[3]); *((u32x2*)(outb + (size_t)row * DM) + lane + 64 * j) = w; }
        }
    }
}

__device__ __forceinline__ float dot128(const LAS bf16_t* q, const bf16_t* k) {
    float a0 = 0.f, a1 = 0.f;
#pragma unroll
    for (int c = 0; c < 16; ++c) { const u32x4 qv = *(const LAS u32x4*)(q + 8 * c); const u32x4 kv = *(const u32x4*)(k + 8 * c);
#pragma unroll
        for (int e = 0; e < 4; ++e) { a0 += bflo(qv[e]) * bflo(kv[e]); a1 += bfhi(qv[e]) * bfhi(kv[e]); } }
    return a0 + a1;
}
__device__ __forceinline__ float gelu_tanh(float x) {
    const float u = 0.7978845608028654f * (x + 0.044715f * x * x * x);
    const float e = __expf(2.f * u);
    const float th = 1.f - 2.f / (e + 1.f);
    return 0.5f * x * (1.f + th);
}

__device__ __forceinline__ void compress_naive(const Params& p, LAS unsigned char* lds) {
    const int tid = threadIdx.x;
    LAS float* A = (LAS float*)lds; LAS float* part = A + 4096; LAS float* hdn = part + 512; LAS float* outv = hdn + 256;
    unsigned char* ws = p.ws;
    bf16_t* KC = (bf16_t*)(ws + OFF_KC); bf16_t* VC = (bf16_t*)(ws + OFF_VC);
    for (int u = blockIdx.x; u < 2 * NG * 512; u += gridDim.x) {
        const int n = u & 511, g = (u >> 9) & 1, j = u >> 10;
        bf16_t* dst = (j ? VC : KC) + ((size_t)g * 512 + n) * 128;
        if (n >= NCMP) { if (tid < 128) dst[tid] = 0; continue; }
        const float* tok = (const float*)(ws + (j ? OFF_VCT : OFF_KCT)) + ((size_t)g * S + 16 * n) * 128;
        const float* pe = p.cpe + (size_t)j * 32 * 128;
        for (int i = tid; i < 4096; i += NTHREADS) A[i] = tok[i] + pe[i];
        __syncthreads();
        { const int h = tid & 255, half = tid >> 8; const float* w = p.cw1 + ((size_t)j * 4096 + 2048 * half) * 256 + h; const LAS float* a = A + 2048 * half;
          float acc = 0.f;
#pragma unroll 8
          for (int k = 0; k < 2048; ++k) acc += a[k] * w[(size_t)k * 256];
          part[tid] = acc; }
        __syncthreads();
        if (tid < 256) hdn[tid] = gelu_tanh(part[tid] + part[tid + 256] + p.cb1[j * 256 + tid]);
        __syncthreads();
        if (tid < 128) { const float* w = p.cw2 + (size_t)j * 256 * 128 + tid; float acc = p.cb2[j * 128 + tid];
#pragma unroll 8
            for (int h = 0; h < 256; ++h) acc += hdn[h] * w[(size_t)h * 128];
            outv[tid] = acc; }
        __syncthreads();
        if (j == 0) { if (tid < 64) { const double pc = 0.5 * ((double)p.pos[16 * n] + (double)p.pos[16 * n + 31]); float c, s; rope_cs(pc, tid, c, s);
                const float x1 = outv[tid], x2 = outv[tid + 64]; dst[tid] = (bf16_t)f2bf(x1 * c - x2 * s); dst[tid + 64] = (bf16_t)f2bf(x2 * c + x1 * s); } }
        else { if (tid < 128) dst[tid] = (bf16_t)f2bf(outv[tid]); }
        __syncthreads();
    }
}

__device__ __forceinline__ void dilated_naive(const Params& p, LAS unsigned char* lds) {
    const int tid = threadIdx.x, lane = tid & 63, wave = __builtin_amdgcn_readfirstlane(tid >> 6);
    LAS bf16_t* qs = (LAS bf16_t*)(lds + 32768) + wave * 128;
    unsigned char* ws = p.ws;
    const bf16_t* QA = (const bf16_t*)(ws + OFF_QA); const bf16_t* KA = (const bf16_t*)(ws + OFF_KA); const bf16_t* VA = (const bf16_t*)(ws + OFF_VA);
    bf16_t* MX = (bf16_t*)(ws + OFF_XB);
    const int gw = blockIdx.x * NWAVES + wave, NGW = gridDim.x * NWAVES;
    for (int u = gw; u < S * NH_DIL; u += NGW) {
        const int t = u / NH_DIL, h = u % NH_DIL;
        *(LAS unsigned*)(qs + 2 * lane) = *(const unsigned*)(QA + (size_t)t * D_DIL + h * 128 + 2 * lane);
        asm volatile("s_waitcnt lgkmcnt(0)" ::: "memory");
        float sc[3][3]; float m = -INFINITY;
#pragma unroll
        for (int c = 0; c < 3; ++c) { const int dil = c == 0 ? 1 : (c == 1 ? 4 : 16);
#pragma unroll
            for (int it = 0; it < 3; ++it) { const int k = lane + 64 * it; const int tk = t - dil * k; const bool valid = (k <= 128) && (tk >= 0);
                float s = -INFINITY; if (valid) s = dot128(qs, KA + (size_t)tk * D_DIL + h * 128); sc[c][it] = s; m = fmaxf(m, s); } }
        m = wave_max(m);
        float l = 0.f;
#pragma unroll
        for (int c = 0; c < 3; ++c)
#pragma unroll
            for (int it = 0; it < 3; ++it) { const float e = fast_exp2(sc[c][it] - m); sc[c][it] = e; l += e; }
        l = wave_sum(l);
        float o0 = 0.f, o1 = 0.f;
#pragma unroll
        for (int c = 0; c < 3; ++c) { const int dil = c == 0 ? 1 : (c == 1 ? 4 : 16);
#pragma unroll
            for (int it = 0; it < 3; ++it) { int cnt = 129 - 64 * it; cnt = cnt > 64 ? 64 : cnt; const int kmax = t / dil - 64 * it + 1; cnt = cnt < kmax ? cnt : kmax;
                for (int kk = 0; kk < cnt; ++kk) { const float pk = __uint_as_float(__builtin_amdgcn_readlane(__float_as_uint(sc[c][it]), kk));
                    const unsigned v = *(const unsigned*)(VA + (size_t)(t - dil * (kk + 64 * it)) * D_DIL + h * 128 + 2 * lane); o0 += pk * bflo(v); o1 += pk * bfhi(v); } } }
        const float inv = 1.f / l;
        *(unsigned*)(MX + (size_t)t * DM + h * 128 + 2 * lane) = pk2(o0 * inv, o1 * inv);
    }
}

__device__ __forceinline__ void nsa_naive(const Params& p, LAS unsigned char* lds) {
    const int tid = threadIdx.x, lane = tid & 63, wave = __builtin_amdgcn_readfirstlane(tid >> 6);
    LAS bf16_t* qsh = (LAS bf16_t*)lds;
    LAS float* Pc = (LAS float*)(lds + 2048);
    LAS int* sel = (LAS int*)(lds + 2048 + 10240);
    unsigned char* ws = p.ws;
    const bf16_t* QN = (const bf16_t*)(ws + OFF_QN);
    const bf16_t* KC = (const bf16_t*)(ws + OFF_KC); const bf16_t* VC = (const bf16_t*)(ws + OFF_VC);
    const bf16_t* KS = (const bf16_t*)(ws + OFF_KS); const bf16_t* VS = (const bf16_t*)(ws + OFF_VS);
    const bf16_t* KW = (const bf16_t*)(ws + OFF_KW); const bf16_t* VW = (const bf16_t*)(ws + OFF_VW);
    const float* GT = (const float*)(ws + OFF_GT);
    bf16_t* MX = (bf16_t*)(ws + OFF_XB);
    for (int u = blockIdx.x; u < S * NG; u += gridDim.x) {
        const int t = u >> 1, g = u & 1;
        const int h = HG * g + wave;
        LAS bf16_t* qs = qsh + wave * 128;
        float oc0 = 0.f, oc1 = 0.f;
        if (wave < HG) {
            *(LAS unsigned*)(qs + 2 * lane) = *(const unsigned*)(QN + (size_t)t * D_NSA + h * 128 + 2 * lane);
            asm volatile("s_waitcnt lgkmcnt(0)" ::: "memory");
            const int ncnt = (t >= 31) ? (t - 31) / 16 + 1 : 0;
            float s[8]; float m = -INFINITY;
#pragma unroll
            for (int it = 0; it < 8; ++it) { const int n = lane + 64 * it; float v = -INFINITY; if (n < ncnt) v = dot128(qs, KC + ((size_t)g * 512 + n) * 128); s[it] = v; m = fmaxf(m, v); }
            m = wave_max(m);
            float l = 0.f;
#pragma unroll
            for (int it = 0; it < 8; ++it) { const int n = lane + 64 * it; const float e = (n < ncnt) ? fast_exp2(s[it] - m) : 0.f; s[it] = e; l += e; }
            l = wave_sum(l);
            const float inv = l > 0.f ? 1.f / l : 0.f;
#pragma unroll
            for (int it = 0; it < 8; ++it) { s[it] *= inv; Pc[wave * 512 + lane + 64 * it] = s[it]; }
#pragma unroll
            for (int it = 0; it < 8; ++it) { int cnt = ncnt - 64 * it; cnt = cnt > 64 ? 64 : cnt;
                for (int kk = 0; kk < cnt; ++kk) { const float pk = __uint_as_float(__builtin_amdgcn_readlane(__float_as_uint(s[it]), kk));
                    const unsigned v = *(const unsigned*)(VC + ((size_t)g * 512 + 64 * it + kk) * 128 + 2 * lane); oc0 += pk * bflo(v); oc1 += pk * bfhi(v); } }
        }
        __syncthreads();
        if (wave == 0) {
            const int cur = t >> 6;
            float sc0, sc1;
            { const int jj = lane; float imp = 0.f;
              for (int n = 4 * jj - 1; n <= 4 * jj + 3; ++n) if (n >= 0 && n < NCMP) { for (int w = 0; w < HG; ++w) imp += Pc[w * 512 + n]; }
              const bool forced = (jj == 0) || (jj == cur) || (jj == cur - 1);
              sc0 = (jj <= cur) ? imp + (forced ? 1e4f : 0.f) : -1e30f; }
            { const int jj = lane + 64; float imp = 0.f;
              for (int n = 4 * jj - 1; n <= 4 * jj + 3; ++n) if (n >= 0 && n < NCMP) { for (int w = 0; w < HG; ++w) imp += Pc[w * 512 + n]; }
              const bool forced = (jj == 0) || (jj == cur) || (jj == cur - 1);
              sc1 = (jj <= cur) ? imp + (forced ? 1e4f : 0.f) : -1e30f; }
            for (int r = 0; r < 16; ++r) {
                const float mx = wave_max(fmaxf(sc0, sc1));
                const unsigned long long b0 = __ballot(sc0 == mx);
                int idx;
                if (b0) idx = __builtin_ctzll(b0); else { const unsigned long long b1 = __ballot(sc1 == mx); idx = 64 + __builtin_ctzll(b1); }
                if (lane == 0) sel[r] = (mx > -1e29f) ? idx : -1;
                if (idx < 64) { if (lane == idx) sc0 = -INFINITY; } else { if (lane == idx - 64) sc1 = -INFINITY; }
            }
        }
        __syncthreads();
        if (wave < HG) {
            float ss[16]; float m = -INFINITY;
#pragma unroll
            for (int r = 0; r < 16; ++r) { const int j = __builtin_amdgcn_readfirstlane(sel[r]); float v = -INFINITY;
                if (j >= 0) { const int kp = 64 * j + lane; if (kp <= t) v = dot128(qs, KS + ((size_t)g * S + kp) * 128); }
                ss[r] = v; m = fmaxf(m, v); }
            m = wave_max(m);
            float l = 0.f;
#pragma unroll
            for (int r = 0; r < 16; ++r) { const float e = fast_exp2(ss[r] - m); ss[r] = e; l += e; }
            l = wave_sum(l);
            float os0 = 0.f, os1 = 0.f;
#pragma unroll
            for (int r = 0; r < 16; ++r) { const int j = __builtin_amdgcn_readfirstlane(sel[r]); if (j >= 0) { int cnt = t - 64 * j + 1; cnt = cnt > 64 ? 64 : cnt;
                for (int kk = 0; kk < cnt; ++kk) { const float pk = __uint_as_float(__builtin_amdgcn_readlane(__float_as_uint(ss[r]), kk));
                    const unsigned v = *(const unsigned*)(VS + ((size_t)g * S + 64 * j + kk) * 128 + 2 * lane); os0 += pk * bflo(v); os1 += pk * bfhi(v); } } }
            const float invs = 1.f / l;
            float sw[8]; float mw = -INFINITY;
#pragma unroll
            for (int it = 0; it < 8; ++it) { const int kp = t - 511 + lane + 64 * it; float v = -INFINITY; if (kp >= 0) v = dot128(qs, KW + ((size_t)g * S + kp) * 128); sw[it] = v; mw = fmaxf(mw, v); }
            mw = wave_max(mw);
            float lw = 0.f;
#pragma unroll
            for (int it = 0; it < 8; ++it) { const float e = fast_exp2(sw[it] - mw); sw[it] = e; lw += e; }
            lw = wave_sum(lw);
            float ow0 = 0.f, ow1 = 0.f;
#pragma unroll
            for (int it = 0; it < 8; ++it) { const int kp0 = t - 511 + 64 * it; int k0 = kp0 < 0 ? -kp0 : 0; k0 = k0 > 64 ? 64 : k0;
                for (int kk = k0; kk < 64; ++kk) { const float pk = __uint_as_float(__builtin_amdgcn_readlane(__float_as_uint(sw[it]), kk));
                    const unsigned v = *(const unsigned*)(VW + ((size_t)g * S + kp0 + kk) * 128 + 2 * lane); ow0 += pk * bflo(v); ow1 += pk * bfhi(v); } }
            const float invw = 1.f / lw;
            const float g0 = GT[(size_t)t * 32 + h * 3 + 0], g1 = GT[(size_t)t * 32 + h * 3 + 1], g2 = GT[(size_t)t * 32 + h * 3 + 2];
            const float r0 = g0 * oc0 + g1 * os0 * invs + g2 * ow0 * invw, r1 = g0 * oc1 + g1 * os1 * invs + g2 * ow1 * invw;
            *(unsigned*)(MX + (size_t)t * DM + D_DIL + h * 128 + 2 * lane) = pk2(r0, r1);
        }
        __syncthreads();
    }
}

constexpr int N_PHASES = 12;
__global__ void __launch_bounds__(NTHREADS, 2) fwd_kernel(Params p) {
    extern __shared__ __attribute__((aligned(16))) unsigned char lds_raw[];
    LAS unsigned char* lds = (LAS unsigned char*)lds_raw;
    cg::grid_group grid = cg::this_grid();
    unsigned char* ws = p.ws;
    bf16_t* XB = (bf16_t*)(ws + OFF_XB); bf16_t* HID = (bf16_t*)(ws + OFF_HID);
    const int lo = p.ph_lo, hi = p.ph_hi;
#define IN(k) (lo <= (k) && (k) < hi)
#define SEAM(k) do { if (IN(k) && IN((k) + 1)) grid.sync(); } while (0)
    if (IN(0)) { p0_prologue(p, lds); }
    SEAM(0);
    if (IN(1)) { pg8::Gemm g{XB, (const bf16_t*)(ws + OFF_W13A), S, 2 * DFF, DM}; pg8::StaticOrder so; so.init(S, 2 * DFF, gridDim.x, blockIdx.x);
        pg8::EpiSwiglu E{HID}; pg8::gemm_phase<pg8::EpiSwiglu, pg8::StaticOrder, true, true>(lds, g, so, E); }
    SEAM(1);
    if (IN(2)) { pg8::Gemm g{HID, (const bf16_t*)(ws + OFF_W2A), S, DM, DFF}; pg8::StaticOrder so; so.init(S, DM, gridDim.x, blockIdx.x);
        pg8::EpiResid E{p.x, p.out, ALPHA, 0.5f}; pg8::gemm_phase<pg8::EpiResid, pg8::StaticOrder, true, true>(lds, g, so, E); }
    SEAM(2);
    if (IN(3)) { ln_phase(p.out, p.out, XB, p.ln1g, p.ln1b); }
    SEAM(3);
    if (IN(4)) { pg8::Gemm g{XB, (const bf16_t*)(ws + OFF_WIN), S, IN_PAD, DM}; pg8::StaticOrder so; so.init(S, IN_PAD, gridDim.x, blockIdx.x);
        pg8::EpiInProj E{(bf16_t*)(ws + OFF_QA), (bf16_t*)(ws + OFF_KA), (bf16_t*)(ws + OFF_VA), (bf16_t*)(ws + OFF_QN), (bf16_t*)(ws + OFF_KS), (bf16_t*)(ws + OFF_VS),
                         (bf16_t*)(ws + OFF_KW), (bf16_t*)(ws + OFF_VW), (float*)(ws + OFF_KCT), (float*)(ws + OFF_VCT), (float*)(ws + OFF_GT),
                         (const float*)(ws + OFF_ROPE), (const float*)(ws + OFF_ROPE) + (size_t)S * 64, p.gateb};
        pg8::gemm_phase<pg8::EpiInProj, pg8::StaticOrder, true, true>(lds, g, so, E); }
    SEAM(4);
    if (IN(5)) { compress_naive(p, lds); dilated_naive(p, lds); }
    SEAM(5);
    if (IN(6)) { nsa_naive(p, lds); }
    SEAM(6);
    if (IN(7)) { pg8::Gemm g{XB, (const bf16_t*)(ws + OFF_WOUT), S, DM, DM}; pg8::StaticOrder so; so.init(S, DM, gridDim.x, blockIdx.x);
        pg8::EpiResid E{p.out, p.out, ALPHA, 1.0f}; pg8::gemm_phase<pg8::EpiResid, pg8::StaticOrder, true, true>(lds, g, so, E); }
    SEAM(7);
    if (IN(8)) { ln_phase(p.out, p.out, XB, p.ln2g, p.ln2b); }
    SEAM(8);
    if (IN(9)) { pg8::Gemm g{XB, (const bf16_t*)(ws + OFF_W13B), S, 2 * DFF, DM}; pg8::StaticOrder so; so.init(S, 2 * DFF, gridDim.x, blockIdx.x);
        pg8::EpiSwiglu E{HID}; pg8::gemm_phase<pg8::EpiSwiglu, pg8::StaticOrder, true, true>(lds, g, so, E); }
    SEAM(9);
    if (IN(10)) { pg8::Gemm g{HID, (const bf16_t*)(ws + OFF_W2B), S, DM, DFF}; pg8::StaticOrder so; so.init(S, DM, gridDim.x, blockIdx.x);
        pg8::EpiResid E{p.out, p.out, ALPHA, 0.5f}; pg8::gemm_phase<pg8::EpiResid, pg8::StaticOrder, true, true>(lds, g, so, E); }
    SEAM(10);
    if (IN(11)) { ln_phase(p.out, p.out, nullptr, p.ln3g, p.ln3b); }
#undef IN
#undef SEAM
}

extern "C" void kernel_launch(void* const* d_in, const int* in_sizes, int n_in, void* d_out, int out_size, void* d_ws, size_t ws_size, hipStream_t stream) {
    static int grid = 0;
    if (grid == 0) {
        if (n_in != 22 || in_sizes[0] != S * DM || out_size != S * DM || ws_size < WS_END) {
            fprintf(stderr, "kernel_launch: unexpected shapes: n_in %d in0 %d out %d ws %zu (need >= %zu)\n", n_in, n_in > 0 ? in_sizes[0] : -1, out_size, ws_size, (size_t)WS_END); grid = -1; return; }
        int dev = 0, cus = 0, per_cu = 0;
        if (hipGetDevice(&dev) != hipSuccess || hipDeviceGetAttribute(&cus, hipDeviceAttributeMultiprocessorCount, dev) != hipSuccess) { fprintf(stderr, "kernel_launch: device query failed\n"); grid = -1; return; }
        if (hipFuncSetAttribute((const void*)fwd_kernel, hipFuncAttributeMaxDynamicSharedMemorySize, LDS_BYTES) != hipSuccess) { fprintf(stderr, "kernel_launch: hipFuncSetAttribute failed\n"); grid = -1; return; }
        if (hipOccupancyMaxActiveBlocksPerMultiprocessor(&per_cu, (const void*)fwd_kernel, NTHREADS, LDS_BYTES) != hipSuccess || per_cu < 1) { fprintf(stderr, "kernel_launch: occupancy query gave %d\n", per_cu); per_cu = 1; }
        (void)hipGetLastError();
        grid = cus;
    }
    if (grid < 0) return;
    Params p{};
    p.x = (const float*)d_in[0]; p.pos = (const int*)d_in[1];
    p.ln1g = (const float*)d_in[2]; p.ln1b = (const float*)d_in[3]; p.f1w1 = (const float*)d_in[4]; p.f1w3 = (const float*)d_in[5]; p.f1w2 = (const float*)d_in[6];
    p.win = (const float*)d_in[7]; p.gateb = (const float*)d_in[8]; p.cpe = (const float*)d_in[9]; p.cw1 = (const float*)d_in[10]; p.cb1 = (const float*)d_in[11];
    p.cw2 = (const float*)d_in[12]; p.cb2 = (const float*)d_in[13]; p.wout = (const float*)d_in[14]; p.ln2g = (const float*)d_in[15]; p.ln2b = (const float*)d_in[16];
    p.f2w1 = (const float*)d_in[17]; p.f2w3 = (const float*)d_in[18]; p.f2w2 = (const float*)d_in[19]; p.ln3g = (const float*)d_in[20]; p.ln3b = (const float*)d_in[21];
    p.out = (float*)d_out; p.ws = (unsigned char*)d_ws;
#if N_LAUNCH_PER_PHASE
    for (int k = 0; k < N_PHASES; ++k) {
        p.ph_lo = k; p.ph_hi = k + 1;
        void* args[] = {&p};
        hipError_t e = hipLaunchCooperativeKernel((const void*)fwd_kernel, dim3(grid), dim3(NTHREADS), args, LDS_BYTES, stream);
        if (e != hipSuccess) { fprintf(stderr, "kernel_launch: launch of phase %d failed: %s\n", k, hipGetErrorString(e)); break; }
    }
#else
    p.ph_lo = 0; p.ph_hi = N_PHASES;
    void* args[] = {&p};
    hipError_t e = hipLaunchCooperativeKernel((const void*)fwd_kernel, dim3(grid), dim3(NTHREADS), args, LDS_BYTES, stream);
    if (e != hipSuccess) fprintf(stderr, "kernel_launch: cooperative launch failed: %s (grid %d)\n", hipGetErrorString(e), grid);
#endif
}
```

```cpp
#include <hip/hip_runtime.h>
#include <hip/hip_cooperative_groups.h>
#include <cstdio>
#include <cstdint>
namespace cg = cooperative_groups;

#ifndef N_LAUNCH_PER_PHASE
#define N_LAUNCH_PER_PHASE 0
#endif

#define LAS __attribute__((address_space(3)))
typedef unsigned short bf16_t;
typedef short bf16x8 __attribute__((ext_vector_type(8)));
typedef float f32x4 __attribute__((ext_vector_type(4)));
typedef float f32x2 __attribute__((ext_vector_type(2)));
typedef unsigned u32x4 __attribute__((ext_vector_type(4)));
typedef unsigned u32x2 __attribute__((ext_vector_type(2)));

constexpr int S = 8192, DM = 2048, DFF = 5632, HD = 128;
constexpr int NH_DIL = 6, NH_NSA = 10, NG = 2, HG = 5;
constexpr int D_DIL = 768, D_NSA = 1280;
constexpr int IN_COLS = 5150, IN_PAD = 5376;
constexpr int NCMP = 511;
constexpr float LN_EPS = 1e-5f;
constexpr float ALPHA = 1.189207115002721f;
constexpr float QSCALE = 0.08838834764831845f * 1.4426950408889634f;
constexpr int NTHREADS = 512, NWAVES = 8;

constexpr size_t MiB = 1u << 20;
constexpr size_t OFF_CTL = 0;
constexpr size_t OFF_W13A = 1 * MiB, OFF_W2A = 45 * MiB, OFF_W13B = 67 * MiB, OFF_W2B = 111 * MiB;
constexpr size_t OFF_WIN = 133 * MiB, OFF_WOUT = 154 * MiB, OFF_CW1T = 162 * MiB, OFF_CW2T = 166 * MiB;
constexpr size_t OFF_ROPE = 167 * MiB;
constexpr size_t OFF_XB = 171 * MiB;
constexpr size_t OFF_HID = 203 * MiB;
constexpr size_t OFF_QA = 291 * MiB, OFF_KA = 303 * MiB, OFF_VA = 315 * MiB, OFF_QN = 327 * MiB;
constexpr size_t OFF_KCT = 347 * MiB, OFF_VCT = 355 * MiB;
constexpr size_t OFF_KS = 363 * MiB, OFF_VS = 367 * MiB, OFF_KW = 371 * MiB, OFF_VW = 375 * MiB;
constexpr size_t OFF_GT = 379 * MiB;
constexpr size_t OFF_KC = 380 * MiB;
constexpr size_t OFF_VC = OFF_KC + 256 * 1024;
constexpr size_t WS_END = 381 * MiB;

constexpr int LDS_BYTES = 147456;

__constant__ double INV_FREQ[64] = {
1.0, 0.8659643233600653, 0.7498942093324559, 0.6493816315762113,
0.5623413251903491, 0.4869675251658631, 0.4216965034285822, 0.3651741272548377,
0.31622776601683794, 0.27384196342643613, 0.23713737056616552, 0.2053525026457146,
0.1778279410038923, 0.1539926526059492, 0.1333521432163324, 0.11547819846894582,
0.1, 0.08659643233600653, 0.07498942093324558, 0.06493816315762113,
0.05623413251903491, 0.04869675251658631, 0.042169650342858224, 0.03651741272548377,
0.03162277660168379, 0.027384196342643614, 0.023713737056616554, 0.02053525026457146,
0.01778279410038923, 0.01539926526059492, 0.01333521432163324, 0.011547819846894581,
0.01, 0.008659643233600654, 0.007498942093324558, 0.006493816315762113,
0.005623413251903491, 0.004869675251658631, 0.004216965034285823, 0.003651741272548377,
0.0031622776601683794, 0.0027384196342643613, 0.0023713737056616554, 0.002053525026457146,
0.0017782794100389228, 0.001539926526059492, 0.001333521432163324, 0.0011547819846894581,
0.001, 0.0008659643233600654, 0.0007498942093324559, 0.0006493816315762113,
0.0005623413251903491, 0.0004869675251658631, 0.00042169650342858224, 0.0003651741272548377,
0.00031622776601683794, 0.0002738419634264361, 0.00023713737056616554, 0.0002053525026457146,
0.00017782794100389227, 0.0001539926526059492, 0.0001333521432163324, 0.00011547819846894582 };

__device__ __forceinline__ unsigned f2bf(float f) { unsigned u = __builtin_bit_cast(unsigned, f); return (u + 0x7fffu + ((u >> 16) & 1u)) >> 16; }
__device__ __forceinline__ unsigned pk2(float lo, float hi) { return f2bf(lo) | (f2bf(hi) << 16); }
__device__ __forceinline__ float bflo(unsigned u) { return __uint_as_float(u << 16); }
__device__ __forceinline__ float bfhi(unsigned u) { return __uint_as_float(u & 0xffff0000u); }
__device__ __forceinline__ float wave_sum(float v) {
#pragma unroll
    for (int o = 1; o < 64; o <<= 1) v += __shfl_xor(v, o);
    return v;
}
__device__ __forceinline__ float wave_max(float v) {
#pragma unroll
    for (int o = 1; o < 64; o <<= 1) v = fmaxf(v, __shfl_xor(v, o));
    return v;
}
__device__ __forceinline__ float fast_exp2(float x) { return __builtin_amdgcn_exp2f(x); }
__device__ __forceinline__ float fast_rcp(float x) { return __builtin_amdgcn_rcpf(x); }
__device__ __forceinline__ void rope_cs(double pos, int i, float& c, float& s) {
    const double rev = pos * INV_FREQ[i] * 0.15915494309189535;
    const double fr = rev - __builtin_rint(rev);
    const float f = (float)fr;
    c = __builtin_amdgcn_cosf(f); s = __builtin_amdgcn_sinf(f);
}

namespace pg8 {
constexpr int BM = 256, BK = 64, HALF = 128, HTB = HALF * BK * 2, STAGE_BYTES = 8 * HTB, NXCD = 8, WGM = 8;
__host__ __device__ __forceinline__ int lds_byte(int r, int c) { const int st = (r >> 4) * 2 + (c >> 5), rr = r & 15, cc = c & 31, ob = rr * 64 + cc * 2; return st * 1024 + (ob ^ (((ob >> 9) & 1) << 5)); }
__host__ __device__ __forceinline__ void stage_rc(int b, int& R, int& C) { const int st = b / 1024, sb = b % 1024, swz = sb ^ (((sb >> 9) & 1) << 5); R = (st >> 1) * 16 + swz / 64; C = (st & 1) * 32 + (swz % 64) / 2; }
__host__ __device__ __forceinline__ int perm32(int rho) { const int n = rho >> 4, i = rho & 15; return 8 * (i >> 2) + 4 * n + (i & 3); }
struct Unit { int pm, pn; };
struct Gemm { const bf16_t* A; const bf16_t* Bt; int M, N, K; };
struct StaticOrder {
    int nM, nN, nwg, G, c;
    __host__ __device__ void init(int M, int N, int G_, int c_) { nM = M / BM; nN = N / BM; nwg = nM * nN; G = G_; c = c_; }
    __host__ __device__ bool next(int i, Unit& u) const {
        const long L = (long)i * G + c; if (L >= nwg) return false;
        int wgid = (int)L; { const int q = nwg / NXCD, r = nwg % NXCD, xcd = wgid % NXCD, off = wgid / NXCD; wgid = (xcd < r ? xcd * (q + 1) : r * (q + 1) + (xcd - r) * q) + off; }
        const int nig = WGM * nN, gid = wgid / nig, fm = gid * WGM, gsz = (nM - fm) < WGM ? (nM - fm) : WGM;
        u.pm = fm + ((wgid % nig) % gsz); u.pn = (wgid % nig) / gsz; return true;
    }
    __device__ __forceinline__ void a_ready(const Unit&) const {}
    __device__ __forceinline__ void done(const Unit&) const {}
};
__device__ __forceinline__ unsigned cvt_pk_bf16(float lo, float hi) { unsigned r; asm volatile("v_cvt_pk_bf16_f32 %0, %1, %2" : "=v"(r) : "v"(lo), "v"(hi)); return r; }

template <class Epi, class Sched, bool ALIGN_EPI = false, bool SP2 = false>
__device__ __forceinline__ void gemm_phase(LAS unsigned char* lds, const Gemm g, const Sched& S, const Epi& E) {
    const int tid = threadIdx.x, wid = __builtin_amdgcn_readfirstlane(tid >> 6), lane = tid & 63, wr = wid >> 2, wc = wid & 3, fr = lane & 15, fq = lane >> 4;
    const int K = g.K, nt = K / BK;
    unsigned voffA[2], voffB[2];
#pragma unroll
    for (int i = 0; i < 2; ++i) { int R, C; stage_rc(tid * 16 + i * 8192, R, C); const int Rb = Epi::PERM ? ((R & ~31) + perm32(R & 31)) : R;
        voffA[i] = (unsigned)(R * K + C) * 2u; voffB[i] = (unsigned)(Rb * K + C) * 2u; }
    const size_t kstep = (size_t)(BK * 2);
    const size_t hstep = (size_t)HALF * K * 2;
    const size_t tstep = 2 * hstep;
    const unsigned ldsw = (unsigned)wid * 1024u;
    const int aoff = lds_byte(wr * 64 + fr, fq * 8), boff = lds_byte(wc * 32 + fr, fq * 8);
#define PG8_SA(b, h) (((b) * 2 + (h)) * HTB)
#define PG8_SB(b, h) ((4 + (b) * 2 + (h)) * HTB)
#define PG8_STAGE(bufoff, gbase, voff) do { _Pragma("unroll") for (int _i = 0; _i < 2; ++_i) \
        __builtin_amdgcn_global_load_lds((const unsigned*)((const char*)(gbase) + (voff)[_i]), (LAS unsigned*)(lds + (bufoff) + ldsw + _i * 8192), 16, 0, 0); } while (0)
#define PG8_LDA(dst, b, h) do { _Pragma("unroll") for (int m = 0; m < 4; ++m) _Pragma("unroll") for (int k = 0; k < 2; ++k) dst[m][k] = *(const LAS bf16x8*)(lds + PG8_SA(b, h) + aoff + m * 2048 + k * 1024); } while (0)
#define PG8_LDB(dst, b, h) do { _Pragma("unroll") for (int n = 0; n < 2; ++n) _Pragma("unroll") for (int k = 0; k < 2; ++k) dst[n][k] = *(const LAS bf16x8*)(lds + PG8_SB(b, h) + boff + n * 2048 + k * 1024); } while (0)
#define PG8_MMA(ai, bj, At, Bt) do { __builtin_amdgcn_s_setprio(1); _Pragma("unroll") for (int m = 0; m < 4; ++m) _Pragma("unroll") for (int n = 0; n < 2; ++n) _Pragma("unroll") for (int k = 0; k < 2; ++k) \
        acc[ai][bj][m][n] = __builtin_amdgcn_mfma_f32_16x16x32_bf16(Bt[n][k], At[m][k], acc[ai][bj][m][n], 0, 0, 0); __builtin_amdgcn_s_setprio(0); } while (0)
#define PG8_WAIT_V(n) asm volatile("s_waitcnt vmcnt(" #n ")" ::: "memory")
#define PG8_WAIT_L(n) asm volatile("s_waitcnt lgkmcnt(" #n ")" ::: "memory")
#define PG8_BAR __builtin_amdgcn_s_barrier()
#define PG8_SCHED __builtin_amdgcn_sched_barrier(0)
    Unit cur, nxt; int ui = 0;
    if (!S.next(0, cur)) return;
    f32x4 acc[2][2][4][2];
#pragma unroll
    for (int a = 0; a < 2; ++a)
#pragma unroll
        for (int b = 0; b < 2; ++b)
#pragma unroll
            for (int m = 0; m < 4; ++m)
#pragma unroll
                for (int n = 0; n < 2; ++n) acc[a][b][m][n] = (f32x4){0.f, 0.f, 0.f, 0.f};
    bf16x8 At[4][2], B0[2][2], B1[2][2];
    const char* cA = (const char*)g.A + (size_t)cur.pm * tstep; const char* cB = (const char*)g.Bt + (size_t)cur.pn * tstep;
    S.a_ready(cur);
    if constexpr (SP2) {
        PG8_STAGE(PG8_SB(0, 0), cB, voffB); PG8_STAGE(PG8_SB(0, 1), cB + hstep, voffB); PG8_STAGE(PG8_SA(0, 0), cA, voffA); PG8_STAGE(PG8_SA(0, 1), cA + hstep, voffA);
        if (wr == 1) PG8_BAR;
        PG8_WAIT_V(2); PG8_BAR;
        PG8_STAGE(PG8_SB(1, 0), cB + kstep, voffB); PG8_STAGE(PG8_SA(1, 0), cA + kstep, voffA); PG8_STAGE(PG8_SB(1, 1), cB + hstep + kstep, voffB);
        PG8_WAIT_V(6); PG8_BAR;
    } else {
        PG8_STAGE(PG8_SB(0, 0), cB, voffB); PG8_STAGE(PG8_SA(0, 0), cA, voffA); PG8_STAGE(PG8_SB(0, 1), cB + hstep, voffB); PG8_STAGE(PG8_SA(0, 1), cA + hstep, voffA);
        if (wr == 1) PG8_BAR;
        PG8_WAIT_V(4); PG8_BAR;
        PG8_STAGE(PG8_SB(1, 0), cB + kstep, voffB); PG8_STAGE(PG8_SA(1, 0), cA + kstep, voffA); PG8_STAGE(PG8_SB(1, 1), cB + hstep + kstep, voffB);
        PG8_WAIT_V(6); PG8_BAR;
    }
    for (;;) {
        const bool has_next = S.next(ui + 1, nxt);
        const char* nA = has_next ? (const char*)g.A + (size_t)nxt.pm * tstep : cA; const char* nB = has_next ? (const char*)g.Bt + (size_t)nxt.pn * tstep : cB;
        for (int t = 0; t < nt; t += 2) {
            const bool last = (t == nt - 2);
            const char* a1 = cA + (size_t)(t + 1) * kstep;
            const char* a2 = last ? nA : cA + (size_t)(t + 2) * kstep; const char* b2 = last ? nB : cB + (size_t)(t + 2) * kstep;
            const char* a3 = a2 + kstep; const char* b3 = b2 + kstep;
            if (last && has_next) S.a_ready(nxt);
            if constexpr (SP2) {
            PG8_LDB(B0, 0, 0); PG8_LDB(B1, 0, 1); PG8_SCHED; PG8_LDA(At, 0, 0); PG8_STAGE(PG8_SA(1, 1), a1 + hstep, voffA);
            PG8_WAIT_V(8); PG8_WAIT_L(0); PG8_BAR; PG8_MMA(0, 0, At, B0); PG8_MMA(0, 1, At, B1); PG8_BAR; PG8_SCHED;
            PG8_LDA(At, 0, 1); PG8_STAGE(PG8_SB(0, 0), b2, voffB); PG8_STAGE(PG8_SB(0, 1), b2 + hstep, voffB); PG8_STAGE(PG8_SA(0, 0), a2, voffA);
            PG8_WAIT_V(8); PG8_WAIT_L(0); PG8_BAR; PG8_MMA(1, 0, At, B0); PG8_MMA(1, 1, At, B1); PG8_BAR; PG8_SCHED;
            PG8_LDB(B0, 1, 0); PG8_LDB(B1, 1, 1); PG8_SCHED; PG8_LDA(At, 1, 0); PG8_STAGE(PG8_SA(0, 1), a2 + hstep, voffA);
            PG8_WAIT_V(8); PG8_WAIT_L(0); PG8_BAR; PG8_MMA(0, 0, At, B0); PG8_MMA(0, 1, At, B1); PG8_BAR; PG8_SCHED;
            PG8_LDA(At, 1, 1); PG8_STAGE(PG8_SB(1, 0), b3, voffB); PG8_STAGE(PG8_SB(1, 1), b3 + hstep, voffB); PG8_STAGE(PG8_SA(1, 0), a3, voffA);
            PG8_WAIT_V(8); PG8_WAIT_L(0); PG8_BAR; PG8_MMA(1, 0, At, B0); PG8_MMA(1, 1, At, B1); PG8_BAR; PG8_SCHED;
            } else {
            PG8_LDB(B0, 0, 0); PG8_SCHED; PG8_LDA(At, 0, 0); PG8_STAGE(PG8_SA(1, 1), a1 + hstep, voffA);
            PG8_WAIT_L(8); PG8_BAR; PG8_WAIT_L(0); PG8_MMA(0, 0, At, B0); PG8_BAR; PG8_SCHED;
            PG8_LDB(B1, 0, 1); PG8_STAGE(PG8_SB(0, 0), b2, voffB);
            PG8_BAR; PG8_WAIT_L(0); PG8_MMA(0, 1, At, B1); PG8_BAR;
            PG8_LDA(At, 0, 1); PG8_STAGE(PG8_SA(0, 0), a2, voffA);
            PG8_BAR; PG8_WAIT_L(0); PG8_MMA(1, 0, At, B0); PG8_BAR; PG8_SCHED;
            PG8_STAGE(PG8_SB(0, 1), b2 + hstep, voffB);
            PG8_WAIT_V(6); PG8_BAR; PG8_MMA(1, 1, At, B1); PG8_BAR;
            PG8_LDB(B0, 1, 0); PG8_SCHED; PG8_LDA(At, 1, 0); PG8_STAGE(PG8_SA(0, 1), a2 + hstep, voffA);
            PG8_WAIT_L(8); PG8_BAR; PG8_WAIT_L(0); PG8_MMA(0, 0, At, B0); PG8_BAR; PG8_SCHED;
            PG8_LDB(B1, 1, 1); PG8_STAGE(PG8_SB(1, 0), b3, voffB);
            PG8_BAR; PG8_WAIT_L(0); PG8_MMA(0, 1, At, B1); PG8_BAR;
            PG8_LDA(At, 1, 1); PG8_STAGE(PG8_SA(1, 0), a3, voffA);
            PG8_BAR; PG8_WAIT_L(0); PG8_MMA(1, 0, At, B0); PG8_BAR; PG8_SCHED;
            PG8_STAGE(PG8_SB(1, 1), b3 + hstep, voffB);
            PG8_WAIT_V(6); PG8_BAR; PG8_MMA(1, 1, At, B1); PG8_BAR;
            }
        }
        if constexpr (ALIGN_EPI) { if (wr == 0) PG8_BAR; }
        E(acc, cur, wr, wc, fr, fq);
        if (!has_next) break;
#pragma unroll
        for (int a = 0; a < 2; ++a)
#pragma unroll
            for (int b = 0; b < 2; ++b)
#pragma unroll
                for (int m = 0; m < 4; ++m)
#pragma unroll
                    for (int n = 0; n < 2; ++n) acc[a][b][m][n] = (f32x4){0.f, 0.f, 0.f, 0.f};
        cur = nxt; cA = nA; cB = nB; ++ui;
        if constexpr (ALIGN_EPI) { if (wr == 1) PG8_BAR; }
    }
    PG8_WAIT_V(0);
    if constexpr (!ALIGN_EPI) { if (wr == 0) PG8_BAR; }
    PG8_BAR;
#undef PG8_SA
#undef PG8_SB
#undef PG8_STAGE
#undef PG8_LDA
#undef PG8_LDB
#undef PG8_MMA
#undef PG8_WAIT_V
#undef PG8_WAIT_L
#undef PG8_BAR
#undef PG8_SCHED
}

struct EpiSwiglu {
    static constexpr bool PERM = true;
    bf16_t* H;
    __device__ __forceinline__ void operator()(const f32x4 (&acc)[2][2][4][2], const Unit& u, int wr, int wc, int fr, int fq) const {
        const int row0 = u.pm * BM + wr * 64 + fr, col0 = u.pn * HALF + wc * 32 + 8 * fq;
#pragma unroll
        for (int ai = 0; ai < 2; ++ai)
#pragma unroll
            for (int m = 0; m < 4; ++m) {
                bf16_t* rowp = H + (size_t)(row0 + ai * HALF + m * 16) * DFF + col0;
                float o[8];
#pragma unroll
                for (int n = 0; n < 2; ++n)
#pragma unroll
                    for (int j = 0; j < 4; ++j) { const float a = acc[ai][0][m][n][j], b = acc[ai][1][m][n][j];
                        const float sg = fast_rcp(1.0f + fast_exp2(-1.4426950408889634f * a)); o[n * 4 + j] = a * sg * b; }
                u32x4 w; w.x = cvt_pk_bf16(o[0], o[1]); w.y = cvt_pk_bf16(o[2], o[3]); w.z = cvt_pk_bf16(o[4], o[5]); w.w = cvt_pk_bf16(o[6], o[7]);
                *(u32x4*)rowp = w;
            }
    }
};
struct EpiResid {
    static constexpr bool PERM = false;
    const float* resid; float* out; float alpha, beta;
    __device__ __forceinline__ void operator()(const f32x4 (&acc)[2][2][4][2], const Unit& u, int wr, int wc, int fr, int fq) const {
        const int col0 = u.pn * BM + wc * 32 + 4 * fq;
#pragma unroll
        for (int ai = 0; ai < 2; ++ai)
#pragma unroll
            for (int m = 0; m < 4; ++m) { const size_t off = (size_t)(u.pm * BM + ai * HALF + wr * 64 + m * 16 + fr) * DM + col0;
#pragma unroll
                for (int bj = 0; bj < 2; ++bj)
#pragma unroll
                    for (int n = 0; n < 2; ++n) { const size_t c = off + bj * HALF + n * 16; const f32x4 r = *(const f32x4*)(resid + c);
                        *(f32x4*)(out + c) = r * alpha + acc[ai][bj][m][n] * beta; } }
    }
};
struct EpiInProj {
    static constexpr bool PERM = false;
    bf16_t *QA, *KA, *VA, *QN, *KS, *VS, *KW, *VW; float *KCT, *VCT, *GT; const float *cosT, *sinT, *gateb;
    __device__ __forceinline__ void operator()(const f32x4 (&acc)[2][2][4][2], const Unit& u, int wr, int wc, int fr, int fq) const {
        const int pn = u.pn;
        const int d0 = 16 * wc + 4 * fq;
        if (pn == 20) {
#pragma unroll
            for (int ai = 0; ai < 2; ++ai)
#pragma unroll
                for (int m = 0; m < 4; ++m) { const int row = u.pm * BM + ai * HALF + wr * 64 + m * 16 + fr;
#pragma unroll
                    for (int j = 0; j < 4; ++j) { const int gc = d0 + j; if (gc < 30) { const float v = acc[ai][0][m][0][j] + gateb[gc]; GT[(size_t)row * 32 + gc] = fast_rcp(1.0f + fast_exp2(-1.4426950408889634f * v)); } } }
            return;
        }
        bool rope = false, isf32 = false; float sc = 1.f; bf16_t* bb = nullptr; float* fb = nullptr; int pitch = 128; size_t bjs = (size_t)S * 128; int colbase = 0;
        if (pn < 3)       { rope = true; sc = QSCALE; bb = QA; pitch = D_DIL; bjs = 128; colbase = 256 * pn; }
        else if (pn < 6)  { rope = true; bb = KA; pitch = D_DIL; bjs = 128; colbase = 256 * (pn - 3); }
        else if (pn < 9)  { bb = VA; pitch = D_DIL; bjs = 128; colbase = 256 * (pn - 6); }
        else if (pn < 14) { rope = true; sc = QSCALE; bb = QN; pitch = D_NSA; bjs = 128; colbase = 256 * (pn - 9); }
        else if (pn == 14) { isf32 = true; fb = KCT; }
        else if (pn == 15) { isf32 = true; fb = VCT; }
        else if (pn == 16) { rope = true; bb = KS; }
        else if (pn == 17) { bb = VS; }
        else if (pn == 18) { rope = true; bb = KW; }
        else               { bb = VW; }
#pragma unroll
        for (int ai = 0; ai < 2; ++ai)
#pragma unroll
            for (int m = 0; m < 4; ++m) {
                const int row = u.pm * BM + ai * HALF + wr * 64 + m * 16 + fr;
                f32x4 cs = (f32x4){1.f, 1.f, 1.f, 1.f}, sn = (f32x4){0.f, 0.f, 0.f, 0.f};
                if (rope) { cs = *(const f32x4*)(cosT + (size_t)row * 64 + d0); sn = *(const f32x4*)(sinT + (size_t)row * 64 + d0); }
#pragma unroll
                for (int bj = 0; bj < 2; ++bj) {
                    const f32x4 x1 = acc[ai][bj][m][0], x2 = acc[ai][bj][m][1];
                    const f32x4 o1 = (x1 * cs - x2 * sn) * sc, o2 = (x2 * cs + x1 * sn) * sc;
                    const size_t off = (size_t)row * pitch + bj * bjs + colbase + d0;
                    if (isf32) { *(f32x4*)(fb + off) = o1; *(f32x4*)(fb + off + 64) = o2; }
                    else { u32x2 w1, w2; w1.x = cvt_pk_bf16(o1[0], o1[1]); w1.y = cvt_pk_bf16(o1[2], o1[3]); w2.x = cvt_pk_bf16(o2[0], o2[1]); w2.y = cvt_pk_bf16(o2[2], o2[3]);
                        *(u32x2*)(bb + off) = w1; *(u32x2*)(bb + off + 64) = w2; }
                }
            }
    }
};
}

struct Params {
    const float* x; const int* pos;
    const float *ln1g, *ln1b, *f1w1, *f1w3, *f1w2, *win, *gateb, *cpe, *cw1, *cb1, *cw2, *cb2, *wout, *ln2g, *ln2b, *f2w1, *f2w3, *f2w2, *ln3g, *ln3b;
    float* out; unsigned char* ws; int ph_lo, ph_hi;
};

template <class SrcFn>
__device__ __forceinline__ void tr_item(int K, int k0, bf16_t* WT, int drow0, const SrcFn& src, LAS float* scr, int lane) {
    const float* sp = src(drow0 + (lane & 31));
    const int N = src.pitch;
#pragma unroll 8
    for (int i = 0; i < 32; ++i) { const int kk = 2 * i + (lane >> 5); scr[kk * 33 + (lane & 31)] = sp ? sp[(size_t)(k0 + kk) * N] : 0.f; }
    asm volatile("s_waitcnt lgkmcnt(0)" ::: "memory");
    const int c = lane & 7;
#pragma unroll
    for (int j = 0; j < 4; ++j) { const int n = (lane >> 3) + 8 * j; const LAS float* s = scr + (8 * c) * 33 + n;
        u32x4 o; o.x = pk2(s[0 * 33], s[1 * 33]); o.y = pk2(s[2 * 33], s[3 * 33]); o.z = pk2(s[4 * 33], s[5 * 33]); o.w = pk2(s[6 * 33], s[7 * 33]);
        *(u32x4*)(WT + (size_t)(drow0 + n) * K + k0 + 8 * c) = o; }
    asm volatile("s_waitcnt lgkmcnt(0)" ::: "memory");
}
struct SrcPlain { const float* W; int pitch; __device__ __forceinline__ const float* operator()(int r) const { return W + r; } };
struct SrcW13 { const float* W; int pitch; __device__ __forceinline__ const float* operator()(int r) const { const int pn = r >> 8, i = r & 127; return W + 128 * pn + i; } };
struct SrcWin { const float* W; int pitch; __device__ __forceinline__ const float* operator()(int r) const {
    const int p = r & 127, wc = (p >> 5) & 3, n = (p >> 4) & 1, d = 64 * n + 16 * wc + (p & 15); const int col = (r & ~127) + d; return col < IN_COLS ? W + col : nullptr; } };

__device__ __forceinline__ void p0_prologue(const Params& p, LAS unsigned char* lds) {
    const int tid = threadIdx.x, lane = tid & 63, wave = __builtin_amdgcn_readfirstlane(tid >> 6);
    LAS float* scr = (LAS float*)(lds + wave * 16384);
    const int gw = blockIdx.x * NWAVES + wave, NGW = gridDim.x * NWAVES;
    unsigned char* ws = p.ws;
    constexpr int I13 = (DM / 64) * (2 * DFF / 32), I2 = (DFF / 64) * (DM / 32), IIN = (DM / 64) * (IN_PAD / 32), IOUT = (DM / 64) * (DM / 32);
    constexpr int ICW1 = (4096 / 64) * (256 / 32), ICW2 = (256 / 64) * (128 / 32);
    constexpr int NITEMS = 2 * I13 + 2 * I2 + IIN + IOUT + 2 * ICW1 + 2 * ICW2;
    if (blockIdx.x == 0 && tid < 16) ((unsigned*)(ws + OFF_CTL))[tid] = 0u;
    for (int it = gw; it < NITEMS; it += NGW) {
        int r = it;
        if (r < I13) { const int nb = 2 * DFF / 32; const int dr = 32 * (r % nb); const float* W = p.f1w1; if ((dr >> 7) & 1) W = p.f1w3; SrcW13 s{W, DFF}; tr_item(DM, 64 * (r / nb), (bf16_t*)(ws + OFF_W13A), dr, s, scr, lane); continue; } r -= I13;
        if (r < I2)  { const int nb = DM / 32; SrcPlain s{p.f1w2, DM}; tr_item(DFF, 64 * (r / nb), (bf16_t*)(ws + OFF_W2A), 32 * (r % nb), s, scr, lane); continue; } r -= I2;
        if (r < I13) { const int nb = 2 * DFF / 32; const int dr = 32 * (r % nb); const float* W = p.f2w1; if ((dr >> 7) & 1) W = p.f2w3; SrcW13 s{W, DFF}; tr_item(DM, 64 * (r / nb), (bf16_t*)(ws + OFF_W13B), dr, s, scr, lane); continue; } r -= I13;
        if (r < I2)  { const int nb = DM / 32; SrcPlain s{p.f2w2, DM}; tr_item(DFF, 64 * (r / nb), (bf16_t*)(ws + OFF_W2B), 32 * (r % nb), s, scr, lane); continue; } r -= I2;
        if (r < IIN) { const int nb = IN_PAD / 32; SrcWin s{p.win, IN_COLS}; tr_item(DM, 64 * (r / nb), (bf16_t*)(ws + OFF_WIN), 32 * (r % nb), s, scr, lane); continue; } r -= IIN;
        if (r < IOUT) { const int nb = DM / 32; SrcPlain s{p.wout, DM}; tr_item(DM, 64 * (r / nb), (bf16_t*)(ws + OFF_WOUT), 32 * (r % nb), s, scr, lane); continue; } r -= IOUT;
        if (r < 2 * ICW1) { const int j = r / ICW1, q = r % ICW1, nb = 256 / 32; SrcPlain s{p.cw1 + (size_t)j * 4096 * 256, 256}; tr_item(4096, 64 * (q / nb), (bf16_t*)(ws + OFF_CW1T) + (size_t)j * 256 * 4096, 32 * (q % nb), s, scr, lane); continue; } r -= 2 * ICW1;
        { const int j = r / ICW2, q = r % ICW2, nb = 128 / 32; SrcPlain s{p.cw2 + (size_t)j * 256 * 128, 128}; tr_item(256, 64 * (q / nb), (bf16_t*)(ws + OFF_CW2T) + (size_t)j * 128 * 256, 32 * (q % nb), s, scr, lane); }
    }
    {
        const size_t n8 = (size_t)S * DM / 8, gt = (size_t)blockIdx.x * NTHREADS + tid, GT_ = (size_t)gridDim.x * NTHREADS;
        bf16_t* XB = (bf16_t*)(ws + OFF_XB);
        for (size_t i = gt; i < n8; i += GT_) { const f32x4 a = *(const f32x4*)(p.x + i * 8), b = *(const f32x4*)(p.x + i * 8 + 4);
            u32x4 o; o.x = pk2(a[0], a[1]); o.y = pk2(a[2], a[3]); o.z = pk2(b[0], b[1]); o.w = pk2(b[2], b[3]); *(u32x4*)(XB + i * 8) = o; }
    }
    {
        float* cosT = (float*)(ws + OFF_ROPE); float* sinT = cosT + (size_t)S * 64;
        const int gt = blockIdx.x * NTHREADS + tid, GT_ = gridDim.x * NTHREADS;
        for (int i = gt; i < S * 64; i += GT_) { float c, s; rope_cs((double)p.pos[i >> 6], i & 63, c, s); cosT[i] = c; sinT[i] = s; }
    }
}

__device__ __forceinline__ void ln_phase(const float* in, float* outf, bf16_t* outb, const float* g, const float* b) {
    const int tid = threadIdx.x, lane = tid & 63, wave = __builtin_amdgcn_readfirstlane(tid >> 6);
    const int gw = blockIdx.x * NWAVES + wave, NGW = gridDim.x * NWAVES;
    for (int row = gw; row < S; row += NGW) {
        const f32x4* xr = (const f32x4*)(in + (size_t)row * DM) + lane;
        f32x4 v[8]; float s = 0.f;
#pragma unroll
        for (int j = 0; j < 8; ++j) { v[j] = xr[64 * j]; s += (v[j][0] + v[j][1]) + (v[j][2] + v[j][3]); }
        const float mean = wave_sum(s) * (1.f / DM); float s2 = 0.f;
#pragma unroll
        for (int j = 0; j < 8; ++j) { v[j] = v[j] - mean; s2 += (v[j][0] * v[j][0] + v[j][1] * v[j][1]) + (v[j][2] * v[j][2] + v[j][3] * v[j][3]); }
        const float rstd = 1.0f / sqrtf(wave_sum(s2) * (1.f / DM) + LN_EPS);
#pragma unroll
        for (int j = 0; j < 8; ++j) {
            const f32x4 gg = *((const f32x4*)g + lane + 64 * j), bb = *((const f32x4*)b + lane + 64 * j);
            const f32x4 o = v[j] * rstd * gg + bb;
            *((f32x4*)(outf + (size_t)row * DM) + lane + 64 * j) = o;
            if (outb) { u32x2 w; w.x = pk2(o[0], o[1]); w.y = pk2(o[2], o[3]); *((u32x2*)(outb + (size_t)row * DM) + lane + 64 * j) = w; }
        }
    }
}

__device__ __forceinline__ float dot128(const LAS bf16_t* q, const bf16_t* k) {
    float a0 = 0.f, a1 = 0.f;
#pragma unroll
    for (int c = 0; c < 16; ++c) { const u32x4 qv = *(const LAS u32x4*)(q + 8 * c); const u32x4 kv = *(const u32x4*)(k + 8 * c);
#pragma unroll
        for (int e = 0; e < 4; ++e) { a0 += bflo(qv[e]) * bflo(kv[e]); a1 += bfhi(qv[e]) * bfhi(kv[e]); } }
    return a0 + a1;
}
__device__ __forceinline__ float gelu_tanh(float x) {
    const float u = 0.7978845608028654f * (x + 0.044715f * x * x * x);
    const float e = __expf(2.f * u);
    const float th = 1.f - 2.f / (e + 1.f);
    return 0.5f * x * (1.f + th);
}

__device__ __forceinline__ void compress_naive(const Params& p, LAS unsigned char* lds) {
    const int tid = threadIdx.x;
    LAS float* A = (LAS float*)lds; LAS float* part = A + 4096; LAS float* hdn = part + 512; LAS float* outv = hdn + 256;
    unsigned char* ws = p.ws;
    bf16_t* KC = (bf16_t*)(ws + OFF_KC); bf16_t* VC = (bf16_t*)(ws + OFF_VC);
    for (int u = blockIdx.x; u < 2 * NG * 512; u += gridDim.x) {
        const int n = u & 511, g = (u >> 9) & 1, j = u >> 10;
        bf16_t* dst = (j ? VC : KC) + ((size_t)g * 512 + n) * 128;
        if (n >= NCMP) { if (tid < 128) dst[tid] = 0; continue; }
        const float* tok = (const float*)(ws + (j ? OFF_VCT : OFF_KCT)) + ((size_t)g * S + 16 * n) * 128;
        const float* pe = p.cpe + (size_t)j * 32 * 128;
        for (int i = tid; i < 4096; i += NTHREADS) A[i] = tok[i] + pe[i];
        __syncthreads();
        { const int h = tid & 255, half = tid >> 8; const float* w = p.cw1 + ((size_t)j * 4096 + 2048 * half) * 256 + h; const LAS float* a = A + 2048 * half;
          float acc = 0.f;
#pragma unroll 8
          for (int k = 0; k < 2048; ++k) acc += a[k] * w[(size_t)k * 256];
          part[tid] = acc; }
        __syncthreads();
        if (tid < 256) hdn[tid] = gelu_tanh(part[tid] + part[tid + 256] + p.cb1[j * 256 + tid]);
        __syncthreads();
        if (tid < 128) { const float* w = p.cw2 + (size_t)j * 256 * 128 + tid; float acc = p.cb2[j * 128 + tid];
#pragma unroll 8
            for (int h = 0; h < 256; ++h) acc += hdn[h] * w[(size_t)h * 128];
            outv[tid] = acc; }
        __syncthreads();
        if (j == 0) { if (tid < 64) { const double pc = 0.5 * ((double)p.pos[16 * n] + (double)p.pos[16 * n + 31]); float c, s; rope_cs(pc, tid, c, s);
                const float x1 = outv[tid], x2 = outv[tid + 64]; dst[tid] = (bf16_t)f2bf(x1 * c - x2 * s); dst[tid + 64] = (bf16_t)f2bf(x2 * c + x1 * s); } }
        else { if (tid < 128) dst[tid] = (bf16_t)f2bf(outv[tid]); }
        __syncthreads();
    }
}

__device__ __forceinline__ void dilated_naive(const Params& p, LAS unsigned char* lds) {
    const int tid = threadIdx.x, lane = tid & 63, wave = __builtin_amdgcn_readfirstlane(tid >> 6);
    LAS bf16_t* qs = (LAS bf16_t*)(lds + 32768) + wave * 128;
    unsigned char* ws = p.ws;
    const bf16_t* QA = (const bf16_t*)(ws + OFF_QA); const bf16_t* KA = (const bf16_t*)(ws + OFF_KA); const bf16_t* VA = (const bf16_t*)(ws + OFF_VA);
    bf16_t* MX = (bf16_t*)(ws + OFF_XB);
    const int gw = blockIdx.x * NWAVES + wave, NGW = gridDim.x * NWAVES;
    for (int u = gw; u < S * NH_DIL; u += NGW) {
        const int t = u / NH_DIL, h = u % NH_DIL;
        *(LAS unsigned*)(qs + 2 * lane) = *(const unsigned*)(QA + (size_t)t * D_DIL + h * 128 + 2 * lane);
        asm volatile("s_waitcnt lgkmcnt(0)" ::: "memory");
        float sc[3][3]; float m = -INFINITY;
#pragma unroll
        for (int c = 0; c < 3; ++c) { const int dil = c == 0 ? 1 : (c == 1 ? 4 : 16);
#pragma unroll
            for (int it = 0; it < 3; ++it) { const int k = lane + 64 * it; const int tk = t - dil * k; const bool valid = (k <= 128) && (tk >= 0);
                float s = -INFINITY; if (valid) s = dot128(qs, KA + (size_t)tk * D_DIL + h * 128); sc[c][it] = s; m = fmaxf(m, s); } }
        m = wave_max(m);
        float l = 0.f;
#pragma unroll
        for (int c = 0; c < 3; ++c)
#pragma unroll
            for (int it = 0; it < 3; ++it) { const float e = fast_exp2(sc[c][it] - m); sc[c][it] = e; l += e; }
        l = wave_sum(l);
        float o0 = 0.f, o1 = 0.f;
#pragma unroll
        for (int c = 0; c < 3; ++c) { const int dil = c == 0 ? 1 : (c == 1 ? 4 : 16);
#pragma unroll
            for (int it = 0; it < 3; ++it) { int cnt = 129 - 64 * it; cnt = cnt > 64 ? 64 : cnt; const int kmax = t / dil - 64 * it + 1; cnt = cnt < kmax ? cnt : kmax;
                for (int kk = 0; kk < cnt; ++kk) { const float pk = __uint_as_float(__builtin_amdgcn_readlane(__float_as_uint(sc[c][it]), kk));
                    const unsigned v = *(const unsigned*)(VA + (size_t)(t - dil * (kk + 64 * it)) * D_DIL + h * 128 + 2 * lane); o0 += pk * bflo(v); o1 += pk * bfhi(v); } } }
        const float inv = 1.f / l;
        *(unsigned*)(MX + (size_t)t * DM + h * 128 + 2 * lane) = pk2(o0 * inv, o1 * inv);
    }
}

__device__ __forceinline__ void nsa_naive(const Params& p, LAS unsigned char* lds) {
    const int tid = threadIdx.x, lane = tid & 63, wave = __builtin_amdgcn_readfirstlane(tid >> 6);
    LAS bf16_t* qsh = (LAS bf16_t*)lds;
    LAS float* Pc = (LAS float*)(lds + 2048);
    LAS int* sel = (LAS int*)(lds + 2048 + 10240);
    unsigned char* ws = p.ws;
    const bf16_t* QN = (const bf16_t*)(ws + OFF_QN);
    const bf16_t* KC = (const bf16_t*)(ws + OFF_KC); const bf16_t* VC = (const bf16_t*)(ws + OFF_VC);
    const bf16_t* KS = (const bf16_t*)(ws + OFF_KS); const bf16_t* VS = (const bf16_t*)(ws + OFF_VS);
    const bf16_t* KW = (const bf16_t*)(ws + OFF_KW); const bf16_t* VW = (const bf16_t*)(ws + OFF_VW);
    const float* GT = (const float*)(ws + OFF_GT);
    bf16_t* MX = (bf16_t*)(ws + OFF_XB);
    for (int u = blockIdx.x; u < S * NG; u += gridDim.x) {
        const int t = u >> 1, g = u & 1;
        const int h = HG * g + wave;
        LAS bf16_t* qs = qsh + wave * 128;
        float oc0 = 0.f, oc1 = 0.f;
        if (wave < HG) {
            *(LAS unsigned*)(qs + 2 * lane) = *(const unsigned*)(QN + (size_t)t * D_NSA + h * 128 + 2 * lane);
            asm volatile("s_waitcnt lgkmcnt(0)" ::: "memory");
            const int ncnt = (t >= 31) ? (t - 31) / 16 + 1 : 0;
            float s[8]; float m = -INFINITY;
#pragma unroll
            for (int it = 0; it < 8; ++it) { const int n = lane + 64 * it; float v = -INFINITY; if (n < ncnt) v = dot128(qs, KC + ((size_t)g * 512 + n) * 128); s[it] = v; m = fmaxf(m, v); }
            m = wave_max(m);
            float l = 0.f;
#pragma unroll
            for (int it = 0; it < 8; ++it) { const int n = lane + 64 * it; const float e = (n < ncnt) ? fast_exp2(s[it] - m) : 0.f; s[it] = e; l += e; }
            l = wave_sum(l);
            const float inv = l > 0.f ? 1.f / l : 0.f;
#pragma unroll
            for (int it = 0; it < 8; ++it) { s[it] *= inv; Pc[wave * 512 + lane + 64 * it] = s[it]; }
#pragma unroll
            for (int it = 0; it < 8; ++it) { int cnt = ncnt - 64 * it; cnt = cnt > 64 ? 64 : cnt;
                for (int kk = 0; kk < cnt; ++kk) { const float pk = __uint_as_float(__builtin_amdgcn_readlane(__float_as_uint(s[it]), kk));
                    const unsigned v = *(const unsigned*)(VC + ((size_t)g * 512 + 64 * it + kk) * 128 + 2 * lane); oc0 += pk * bflo(v); oc1 += pk * bfhi(v); } }
        }
        __syncthreads();
        if (wave == 0) {
            const int cur = t >> 6;
            float sc0, sc1;
            { const int jj = lane; float imp = 0.f;
              for (int n = 4 * jj - 1; n <= 4 * jj + 3; ++n) if (n >= 0 && n < NCMP) { for (int w = 0; w < HG; ++w) imp += Pc[w * 512 + n]; }
              const bool forced = (jj == 0) || (jj == cur) || (jj == cur - 1);
              sc0 = (jj <= cur) ? imp + (forced ? 1e4f : 0.f) : -1e30f; }
            { const int jj = lane + 64; float imp = 0.f;
              for (int n = 4 * jj - 1; n <= 4 * jj + 3; ++n) if (n >= 0 && n < NCMP) { for (int w = 0; w < HG; ++w) imp += Pc[w * 512 + n]; }
              const bool forced = (jj == 0) || (jj == cur) || (jj == cur - 1);
              sc1 = (jj <= cur) ? imp + (forced ? 1e4f : 0.f) : -1e30f; }
            for (int r = 0; r < 16; ++r) {
                const float mx = wave_max(fmaxf(sc0, sc1));
                const unsigned long long b0 = __ballot(sc0 == mx);
                int idx;
                if (b0) idx = __builtin_ctzll(b0); else { const unsigned long long b1 = __ballot(sc1 == mx); idx = 64 + __builtin_ctzll(b1); }
                if (lane == 0) sel[r] = (mx > -1e29f) ? idx : -1;
                if (idx < 64) { if (lane == idx) sc0 = -INFINITY; } else { if (lane == idx - 64) sc1 = -INFINITY; }
            }
        }
        __syncthreads();
        if (wave < HG) {
            float ss[16]; float m = -INFINITY;
#pragma unroll
            for (int r = 0; r < 16; ++r) { const int j = __builtin_amdgcn_readfirstlane(sel[r]); float v = -INFINITY;
                if (j >= 0) { const int kp = 64 * j + lane; if (kp <= t) v = dot128(qs, KS + ((size_t)g * S + kp) * 128); }
                ss[r] = v; m = fmaxf(m, v); }
            m = wave_max(m);
            float l = 0.f;
#pragma unroll
            for (int r = 0; r < 16; ++r) { const float e = fast_exp2(ss[r] - m); ss[r] = e; l += e; }
            l = wave_sum(l);
            float os0 = 0.f, os1 = 0.f;
#pragma unroll
            for (int r = 0; r < 16; ++r) { const int j = __builtin_amdgcn_readfirstlane(sel[r]); if (j >= 0) { int cnt = t - 64 * j + 1; cnt = cnt > 64 ? 64 : cnt;
                for (int kk = 0; kk < cnt; ++kk) { const float pk = __uint_as_float(__builtin_amdgcn_readlane(__float_as_uint(ss[r]), kk));
                    const unsigned v = *(const unsigned*)(VS + ((size_t)g * S + 64 * j + kk) * 128 + 2 * lane); os0 += pk * bflo(v); os1 += pk * bfhi(v); } } }
            const float invs = 1.f / l;
            float sw[8]; float mw = -INFINITY;
#pragma unroll
            for (int it = 0; it < 8; ++it) { const int kp = t - 511 + lane + 64 * it; float v = -INFINITY; if (kp >= 0) v = dot128(qs, KW + ((size_t)g * S + kp) * 128); sw[it] = v; mw = fmaxf(mw, v); }
            mw = wave_max(mw);
            float lw = 0.f;
#pragma unroll
            for (int it = 0; it < 8; ++it) { const float e = fast_exp2(sw[it] - mw); sw[it] = e; lw += e; }
            lw = wave_sum(lw);
            float ow0 = 0.f, ow1 = 0.f;
#pragma unroll
            for (int it = 0; it < 8; ++it) { const int kp0 = t - 511 + 64 * it; int k0 = kp0 < 0 ? -kp0 : 0; k0 = k0 > 64 ? 64 : k0;
                for (int kk = k0; kk < 64; ++kk) { const float pk = __uint_as_float(__builtin_amdgcn_readlane(__float_as_uint(sw[it]), kk));
                    const unsigned v = *(const unsigned*)(VW + ((size_t)g * S + kp0 + kk) * 128 + 2 * lane); ow0 += pk * bflo(v); ow1 += pk * bfhi(v); } }
            const float invw = 1.f / lw;
            const float g0 = GT[(size_t)t * 32 + h * 3 + 0], g1 = GT[(size_t)t * 32 + h * 3 + 1], g2 = GT[(size_t)t * 32 + h * 3 + 2];
            const float r0 = g0 * oc0 + g1 * os0 * invs + g2 * ow0 * invw, r1 = g0 * oc1 + g1 * os1 * invs + g2 * ow1 * invw;
            *(unsigned*)(MX + (size_t)t * DM + D_DIL + h * 128 + 2 * lane) = pk2(r0, r1);
        }
        __syncthreads();
    }
}

namespace att {
typedef short s16x4 __attribute__((ext_vector_type(4)));
constexpr int KP = 272, VP = 288;
constexpr int KT_BYTES = 64 * KP, VT_BYTES = 64 * VP;
constexpr int L_K0 = 0, L_K1 = KT_BYTES, L_V0 = 2 * KT_BYTES, L_V1 = 2 * KT_BYTES + VT_BYTES;
constexpr int L_MISC = 73728;
constexpr int L_SLOT = 143360;
constexpr unsigned W_CAUSAL = 0x80000000u;
constexpr size_t OV_OD = 0, OV_LSE = 40 * MiB, OV_OC = 41 * MiB, OV_SEL = 82 * MiB;

struct TileSrc { const char* K; const char* V; size_t kst, vst; };

__device__ __forceinline__ void tile_load(u32x4 (&r)[4], const TileSrc& s, int key0, int tid) {
    const int k = tid >> 4, cc = (tid & 15) * 16;
    const char* kp = s.K + (size_t)(key0 + k) * s.kst + cc; const char* vp = s.V + (size_t)(key0 + k) * s.vst + cc;
    r[0] = *(const u32x4*)kp; r[1] = *(const u32x4*)(kp + 32 * s.kst); r[2] = *(const u32x4*)vp; r[3] = *(const u32x4*)(vp + 32 * s.vst);
}
__device__ __forceinline__ void tile_store(LAS unsigned char* lds, int buf, const u32x4 (&r)[4], int tid) {
    const int k = tid >> 4, cc = (tid & 15) * 16;
    const int lam = 16 * ((k >> 2) & 1) + 4 * ((k >> 3) & 3) + (k & 3);
    const int lv = (k & 16) + 8 * ((k >> 2) & 1) + 4 * ((k >> 3) & 1) + (k & 3);
    LAS unsigned char* Kt = lds + (buf ? L_K1 : L_K0); LAS unsigned char* Vt = lds + (buf ? L_V1 : L_V0);
    *(LAS u32x4*)(Kt + lam * KP + cc) = r[0]; *(LAS u32x4*)(Kt + (lam + 32) * KP + cc) = r[1];
    *(LAS u32x4*)(Vt + lv * VP + cc) = r[2]; *(LAS u32x4*)(Vt + (lv + 32) * VP + cc) = r[3];
}
struct QState { bf16x8 qf[4]; f32x4 o[8]; float m, l; };
__device__ __forceinline__ void q_reset(QState& st) {
#pragma unroll
    for (int i = 0; i < 8; ++i) st.o[i] = (f32x4){0.f, 0.f, 0.f, 0.f};
    st.m = -1e30f; st.l = 0.f;
}
__device__ __forceinline__ void q_load(QState& st, const bf16_t* qrow, int g) {
#pragma unroll
    for (int ds = 0; ds < 4; ++ds) st.qf[ds] = *(const bf16x8*)(qrow + 32 * ds + 8 * g);
    q_reset(st);
}
__device__ __forceinline__ void qk_tile(f32x4 (&s)[4], const LAS unsigned char* Kt, const QState& st, int c, int g) {
    const LAS unsigned char* kb = Kt + c * KP + g * 16;
#pragma unroll
    for (int T = 0; T < 4; ++T) { s[T] = (f32x4){0.f, 0.f, 0.f, 0.f};
#pragma unroll
        for (int ds = 0; ds < 4; ++ds) { const bf16x8 kf = *(const LAS bf16x8*)(kb + T * 16 * KP + ds * 64); s[T] = __builtin_amdgcn_mfma_f32_16x16x32_bf16(kf, st.qf[ds], s[T], 0, 0, 0); } }
}
__device__ __forceinline__ void mask_tile(f32x4 (&s)[4], int dq, unsigned W, bool en, int g) {
#pragma unroll
    for (int T = 0; T < 4; ++T)
#pragma unroll
        for (int r = 0; r < 4; ++r) { const int kt = 32 * (T >> 1) + 8 * g + 4 * (T & 1) + r; if (!(en && (unsigned)(dq - kt) < W)) s[T][r] = -INFINITY; }
}
__device__ __forceinline__ float group_max(float v) { v = fmaxf(v, __shfl_xor(v, 16)); v = fmaxf(v, __shfl_xor(v, 32)); return v; }
__device__ __forceinline__ float group_sum(float v) { v += __shfl_xor(v, 16); v += __shfl_xor(v, 32); return v; }
template <bool PV> __device__ __forceinline__ void softmax_online(f32x4 (&s)[4], QState& st) {
    float mx = -INFINITY;
#pragma unroll
    for (int T = 0; T < 4; ++T)
#pragma unroll
        for (int r = 0; r < 4; ++r) mx = fmaxf(mx, s[T][r]);
    mx = group_max(mx);
    const float mn = fmaxf(st.m, mx), alpha = fast_exp2(st.m - mn); st.m = mn;
    float sum = 0.f;
#pragma unroll
    for (int T = 0; T < 4; ++T)
#pragma unroll
        for (int r = 0; r < 4; ++r) { const float e = fast_exp2(s[T][r] - mn); s[T][r] = e; sum += e; }
    st.l = st.l * alpha + sum;
    if (PV) {
#pragma unroll
        for (int i = 0; i < 8; ++i) st.o[i] = st.o[i] * alpha;
    }
}
__device__ __forceinline__ s16x4 tr_read(const LAS unsigned char* p) { return __builtin_bit_cast(s16x4, __builtin_amdgcn_ds_read_tr16_b64_v4i16((LAS s16x4*)p)); }
__device__ __forceinline__ void pv_tile(const f32x4 (&s)[4], const LAS unsigned char* Vt, QState& st, int c, int g) {
    const LAS unsigned char* vb = Vt + (16 * (g >> 1) + 4 * (g & 1) + (c >> 2)) * VP + (c & 3) * 8;
#pragma unroll
    for (int ch = 0; ch < 2; ++ch) {
        u32x4 pw; pw.x = pg8::cvt_pk_bf16(s[2 * ch][0], s[2 * ch][1]); pw.y = pg8::cvt_pk_bf16(s[2 * ch][2], s[2 * ch][3]);
        pw.z = pg8::cvt_pk_bf16(s[2 * ch + 1][0], s[2 * ch + 1][1]); pw.w = pg8::cvt_pk_bf16(s[2 * ch + 1][2], s[2 * ch + 1][3]);
        const bf16x8 pf = __builtin_bit_cast(bf16x8, pw);
#pragma unroll
        for (int dt = 0; dt < 8; ++dt) {
            const s16x4 lo = tr_read(vb + ch * 32 * VP + dt * 32), hi = tr_read(vb + ch * 32 * VP + 8 * VP + dt * 32);
            const bf16x8 vf = (bf16x8){lo[0], lo[1], lo[2], lo[3], hi[0], hi[1], hi[2], hi[3]};
            st.o[dt] = __builtin_amdgcn_mfma_f32_16x16x32_bf16(vf, pf, st.o[dt], 0, 0, 0);
        }
    }
}
template <bool PV, class F>
__device__ __forceinline__ void attn_pass(LAS unsigned char* lds, const TileSrc& src, int t0, int t1, QState& st, const F& f, int tid, int c, int g) {
    if (t0 >= t1) return;
    u32x4 r[4];
    tile_load(r, src, 64 * t0, tid); tile_store(lds, 0, r, tid); __syncthreads();
    for (int t = t0; t < t1; ++t) {
        const int buf = (t - t0) & 1;
        if (t + 1 < t1) tile_load(r, src, 64 * (t + 1), tid);
        if (f.relevant(t)) {
            f32x4 s[4]; qk_tile(s, lds + (buf ? L_K1 : L_K0), st, c, g); mask_tile(s, f.dq(t), f.W(), f.en(t), g); softmax_online<PV>(s, st);
            if (PV) pv_tile(s, lds + (buf ? L_V1 : L_V0), st, c, g);
        }
        if (t + 1 < t1) tile_store(lds, buf ^ 1, r, tid);
        __syncthreads();
    }
}
__device__ __forceinline__ int next_unit(unsigned* ctr, LAS unsigned char* lds) {
    LAS int* slot = (LAS int*)(lds + L_SLOT);
    __syncthreads();
    if (threadIdx.x == 0) *slot = (int)atomicAdd(ctr, 1u);
    __syncthreads();
    return *slot;
}

struct DilF { int iq, iw;
    __device__ __forceinline__ bool relevant(int t) const { return 64 * t <= iw + 15 && 64 * t + 63 >= iw - 128; }
    __device__ __forceinline__ int dq(int t) const { return iq - 64 * t; }
    __device__ __forceinline__ unsigned W() const { return 129u; }
    __device__ __forceinline__ bool en(int) const { return true; } };
__device__ __forceinline__ void dil_unit(const Params& p, LAS unsigned char* lds, int u) {
    const int tid = threadIdx.x, lane = tid & 63, wave = __builtin_amdgcn_readfirstlane(tid >> 6), c = lane & 15, g = lane >> 4;
    const int cfg = u / 384, v = u % 384, h = v % NH_DIL, rb = v / NH_DIL;
    const int dil = cfg == 0 ? 1 : (cfg == 1 ? 4 : 16), nb = (S / dil) / 128, r = rb / nb, b = rb % nb;
    unsigned char* ws = p.ws;
    const int iw = 128 * b + 16 * wave, iq = iw + c, tok = dil * iq + r;
    QState st; q_load(st, (const bf16_t*)(ws + OFF_QA) + (size_t)tok * D_DIL + h * 128, g);
    TileSrc src{(const char*)(ws + OFF_KA) + ((size_t)r * D_DIL + h * 128) * 2, (const char*)(ws + OFF_VA) + ((size_t)r * D_DIL + h * 128) * 2, (size_t)dil * D_DIL * 2, (size_t)dil * D_DIL * 2};
    DilF f{iq, iw};
    attn_pass<true>(lds, src, b == 0 ? 0 : 2 * (b - 1), 2 * b + 2, st, f, tid, c, g);
    const float lt = group_sum(st.l), inv = 1.f / lt;
    bf16_t* od = (bf16_t*)(ws + OFF_HID + OV_OD) + ((size_t)cfg * S + tok) * D_DIL + h * 128 + 4 * g;
#pragma unroll
    for (int dt = 0; dt < 8; ++dt) { u32x2 w; w.x = pg8::cvt_pk_bf16(st.o[dt][0] * inv, st.o[dt][1] * inv); w.y = pg8::cvt_pk_bf16(st.o[dt][2] * inv, st.o[dt][3] * inv); *(u32x2*)(od + 16 * dt) = w; }
    if (g == 0) ((float*)(ws + OFF_HID + OV_LSE))[((size_t)cfg * S + tok) * 8 + h] = st.m + __log2f(lt);
}
__device__ __forceinline__ void dil_merge(const Params& p) {
    unsigned char* ws = p.ws;
    const bf16_t* OD = (const bf16_t*)(ws + OFF_HID + OV_OD); const float* LSE = (const float*)(ws + OFF_HID + OV_LSE); bf16_t* MX = (bf16_t*)(ws + OFF_XB);
    const int gt = blockIdx.x * NTHREADS + threadIdx.x, GT_ = gridDim.x * NTHREADS;
    for (int i = gt; i < S * NH_DIL * 16; i += GT_) {
        const int ch = i & 15, th = i >> 4, h = th % NH_DIL, t = th / NH_DIL;
        const float l0 = LSE[((size_t)0 * S + t) * 8 + h], l1 = LSE[((size_t)1 * S + t) * 8 + h], l2 = LSE[((size_t)2 * S + t) * 8 + h];
        const float mx = fmaxf(l0, fmaxf(l1, l2)); float w0 = fast_exp2(l0 - mx), w1 = fast_exp2(l1 - mx), w2 = fast_exp2(l2 - mx);
        const float inv = 1.f / (w0 + w1 + w2); w0 *= inv; w1 *= inv; w2 *= inv;
        const size_t off = (size_t)t * D_DIL + h * 128 + 8 * ch;
        const u32x4 a = *(const u32x4*)(OD + off), b = *(const u32x4*)(OD + (size_t)S * D_DIL + off), cc = *(const u32x4*)(OD + (size_t)2 * S * D_DIL + off);
        u32x4 o;
#pragma unroll
        for (int e = 0; e < 4; ++e) o[e] = pk2(w0 * bflo(a[e]) + w1 * bflo(b[e]) + w2 * bflo(cc[e]), w0 * bfhi(a[e]) + w1 * bfhi(b[e]) + w2 * bfhi(cc[e]));
        *(u32x4*)(MX + (size_t)t * DM + h * 128 + 8 * ch) = o;
    }
}

__device__ __forceinline__ void compress_unit(const Params& p, LAS unsigned char* lds, int u) {
    const int tid = threadIdx.x, lane = tid & 63, wave = __builtin_amdgcn_readfirstlane(tid >> 6), c = lane & 15, g4 = lane >> 4;
    const int nb = u & 31, grp = (u >> 5) & 1, j = u >> 6, n0 = 16 * nb;
    unsigned char* ws = p.ws;
    constexpr int AP = 1040, HP = 528, OP = 132;
    LAS unsigned char* Ach = lds; LAS unsigned char* HDl = lds + 16 * AP; LAS float* OUTF = (LAS float*)(lds + 16 * AP + 16 * HP);
    const float* TOK = (const float*)(ws + (j ? OFF_VCT : OFF_KCT)) + ((size_t)grp * S + n0 * 16) * 128;
    const float* pe = p.cpe + (size_t)j * 32 * 128;
    const bf16_t* W1T = (const bf16_t*)(ws + OFF_CW1T) + (size_t)j * 256 * 4096; const bf16_t* W2T = (const bf16_t*)(ws + OFF_CW2T) + (size_t)j * 128 * 256;
    f32x4 acc[2]; acc[0] = (f32x4){0.f, 0.f, 0.f, 0.f}; acc[1] = acc[0];
    for (int kc = 0; kc < 8; ++kc) {
        { const int n = tid >> 5, kl = (tid & 31) * 16, l = 4 * kc + (kl >> 7), d = kl & 127;
          const float* sp = TOK + ((size_t)(16 * n + l)) * 128 + d; const float* pp = pe + l * 128 + d;
          f32x4 a[4];
#pragma unroll
          for (int e = 0; e < 4; ++e) a[e] = *(const f32x4*)(sp + 4 * e) + *(const f32x4*)(pp + 4 * e);
          u32x4 w0, w1; w0.x = pk2(a[0][0], a[0][1]); w0.y = pk2(a[0][2], a[0][3]); w0.z = pk2(a[1][0], a[1][1]); w0.w = pk2(a[1][2], a[1][3]);
          w1.x = pk2(a[2][0], a[2][1]); w1.y = pk2(a[2][2], a[2][3]); w1.z = pk2(a[3][0], a[3][1]); w1.w = pk2(a[3][2], a[3][3]);
          *(LAS u32x4*)(Ach + n * AP + kl * 2) = w0; *(LAS u32x4*)(Ach + n * AP + kl * 2 + 16) = w1; }
        __syncthreads();
#pragma unroll 4
        for (int ks = 0; ks < 16; ++ks) {
            const bf16x8 bfr = *(const LAS bf16x8*)(Ach + c * AP + (32 * ks + 8 * g4) * 2);
#pragma unroll
            for (int nn = 0; nn < 2; ++nn) { const bf16x8 afr = *(const bf16x8*)(W1T + (size_t)(32 * wave + 16 * nn + c) * 4096 + 512 * kc + 32 * ks + 8 * g4);
                acc[nn] = __builtin_amdgcn_mfma_f32_16x16x32_bf16(afr, bfr, acc[nn], 0, 0, 0); }
        }
        __syncthreads();
    }
#pragma unroll
    for (int nn = 0; nn < 2; ++nn) { const int hb = 32 * wave + 16 * nn + 4 * g4; const f32x4 bb = *(const f32x4*)(p.cb1 + j * 256 + hb);
        u32x2 w; w.x = pk2(gelu_tanh(acc[nn][0] + bb[0]), gelu_tanh(acc[nn][1] + bb[1])); w.y = pk2(gelu_tanh(acc[nn][2] + bb[2]), gelu_tanh(acc[nn][3] + bb[3]));
        *(LAS u32x2*)(HDl + c * HP + hb * 2) = w; }
    __syncthreads();
    { f32x4 a2 = (f32x4){0.f, 0.f, 0.f, 0.f};
#pragma unroll
      for (int ks = 0; ks < 8; ++ks) { const bf16x8 afr = *(const bf16x8*)(W2T + (size_t)(16 * wave + c) * 256 + 32 * ks + 8 * g4); const bf16x8 bfr = *(const LAS bf16x8*)(HDl + c * HP + (32 * ks + 8 * g4) * 2);
          a2 = __builtin_amdgcn_mfma_f32_16x16x32_bf16(afr, bfr, a2, 0, 0, 0); }
      const int d = 16 * wave + 4 * g4; const f32x4 bb = *(const f32x4*)(p.cb2 + j * 128 + d);
      *(LAS f32x4*)(OUTF + c * OP + d) = a2 + bb; }
    __syncthreads();
    if (j == 0) {
        bf16_t* KC = (bf16_t*)(ws + OFF_KC) + ((size_t)grp * 512 + n0) * 128;
#pragma unroll
        for (int e = 0; e < 2; ++e) { const int idx = tid + 512 * e, n = idx >> 6, d = idx & 63;
            if (n0 + n >= NCMP) { KC[n * 128 + d] = 0; KC[n * 128 + d + 64] = 0; }
            else { const int nn = n0 + n; const double pc = 0.5 * ((double)p.pos[16 * nn] + (double)p.pos[16 * nn + 31]); float cs, sn; rope_cs(pc, d, cs, sn);
                const float x1 = OUTF[n * OP + d], x2 = OUTF[n * OP + d + 64]; KC[n * 128 + d] = (bf16_t)f2bf(x1 * cs - x2 * sn); KC[n * 128 + d + 64] = (bf16_t)f2bf(x2 * cs + x1 * sn); } }
    } else {
        bf16_t* VC = (bf16_t*)(ws + OFF_VC) + ((size_t)grp * 512 + n0) * 128;
#pragma unroll
        for (int e = 0; e < 4; ++e) { const int idx = tid + 512 * e, n = idx >> 7, d = idx & 127; VC[n * 128 + d] = (n0 + n >= NCMP) ? (bf16_t)0 : (bf16_t)f2bf(OUTF[n * OP + d]); }
    }
}

struct CmpF { int dq0; bool act;
    __device__ __forceinline__ bool relevant(int) const { return act; }
    __device__ __forceinline__ int dq(int t) const { return dq0 - 64 * t; }
    __device__ __forceinline__ unsigned W() const { return W_CAUSAL; }
    __device__ __forceinline__ bool en(int) const { return true; } };
__device__ __forceinline__ void cmp_unit(const Params& p, LAS unsigned char* lds, int u) {
    const int tid = threadIdx.x, lane = tid & 63, wave = __builtin_amdgcn_readfirstlane(tid >> 6), c = lane & 15, g = lane >> 4;
    const int qb = 511 - (u >> 1), grp = u & 1;
    unsigned char* ws = p.ws;
    constexpr int PP = 513;
    LAS float* Psum = (LAS float*)(lds + L_MISC);
    const int tw = 16 * qb, tq = tw + c;
    const bool act = wave < HG;
    const int h = HG * grp + (act ? wave : 0);
    for (int i = tid; i < 16 * PP; i += NTHREADS) Psum[i] = 0.f;
    __syncthreads();
    const int ncq = tq >= 31 ? (tq - 31) / 16 + 1 : 0;
    const int ncw = (tw + 15 >= 31) ? (tw + 15 - 31) / 16 + 1 : 0;
    const int nt = (ncw + 63) >> 6;
    QState st; q_load(st, (const bf16_t*)(ws + OFF_QN) + (size_t)tq * D_NSA + h * 128, g);
    TileSrc src{(const char*)(ws + OFF_KC) + (size_t)grp * 512 * 256, (const char*)(ws + OFF_VC) + (size_t)grp * 512 * 256, 256, 256};
    CmpF f{ncq - 1, act};
    attn_pass<false>(lds, src, 0, nt, st, f, tid, c, g);
    const float mfin = st.m, lt = group_sum(st.l), invl = lt > 0.f ? 1.f / lt : 0.f;
    if (nt > 0) {
        u32x4 r[4];
        tile_load(r, src, 0, tid); tile_store(lds, 0, r, tid); __syncthreads();
        for (int t = 0; t < nt; ++t) {
            const int buf = t & 1;
            if (t + 1 < nt) tile_load(r, src, 64 * (t + 1), tid);
            if (act) {
                f32x4 s[4]; qk_tile(s, lds + (buf ? L_K1 : L_K0), st, c, g); mask_tile(s, f.dq(t), W_CAUSAL, true, g);
#pragma unroll
                for (int T = 0; T < 4; ++T)
#pragma unroll
                    for (int rr = 0; rr < 4; ++rr) { const float e = fast_exp2(s[T][rr] - mfin) * invl; s[T][rr] = e;
                        const int kt = 32 * (T >> 1) + 8 * g + 4 * (T & 1) + rr;
                        __hip_atomic_fetch_add(Psum + c * PP + 64 * t + kt, e, __ATOMIC_RELAXED, __HIP_MEMORY_SCOPE_WORKGROUP); }
                pv_tile(s, lds + (buf ? L_V1 : L_V0), st, c, g);
            }
            if (t + 1 < nt) tile_store(lds, buf ^ 1, r, tid);
            __syncthreads();
        }
    }
    if (act) { const float g0 = ((const float*)(ws + OFF_GT))[(size_t)tq * 32 + h * 3 + 0];
        float* oc = (float*)(ws + OFF_HID + OV_OC) + (size_t)tq * D_NSA + h * 128 + 4 * g;
#pragma unroll
        for (int dt = 0; dt < 8; ++dt) *(f32x4*)(oc + 16 * dt) = st.o[dt] * g0; }
    for (int qi = 0; qi < 2; ++qi) {
        const int q = 2 * wave + qi, t = tw + q, cur = t >> 6;
        const LAS float* P = Psum + q * PP;
        float sc0, sc1;
        { const int jj = lane; float imp = 0.f;
#pragma unroll
          for (int n = 4 * jj - 1; n <= 4 * jj + 3; ++n) if (n >= 0 && n < NCMP) imp += P[n];
          const bool forced = (jj == 0) || (jj == cur) || (jj == cur - 1);
          sc0 = (jj <= cur) ? imp + (forced ? 1e4f : 0.f) : -1e30f; }
        { const int jj = lane + 64; float imp = 0.f;
#pragma unroll
          for (int n = 4 * jj - 1; n <= 4 * jj + 3; ++n) if (n >= 0 && n < NCMP) imp += P[n];
          const bool forced = (jj == cur) || (jj == cur - 1);
          sc1 = (jj <= cur) ? imp + (forced ? 1e4f : 0.f) : -1e30f; }
        unsigned long long mlo = 0ull, mhi = 0ull;
        for (int r = 0; r < 16; ++r) {
            const float mx = wave_max(fmaxf(sc0, sc1));
            if (!(mx > -1e29f)) break;
            const unsigned long long b0 = __ballot(sc0 == mx);
            if (b0) { const int idx = __builtin_ctzll(b0); mlo |= 1ull << idx; if (lane == idx) sc0 = -INFINITY; }
            else { const unsigned long long b1 = __ballot(sc1 == mx); const int idx = __builtin_ctzll(b1); mhi |= 1ull << idx; if (lane == idx) sc1 = -INFINITY; }
        }
        if (lane == 0) { u32x4 w; w.x = (unsigned)mlo; w.y = (unsigned)(mlo >> 32); w.z = (unsigned)mhi; w.w = (unsigned)(mhi >> 32);
            *(u32x4*)((unsigned*)(ws + OFF_HID + OV_SEL) + ((size_t)t * 2 + grp) * 4) = w; }
    }
}

struct WinF { int tq, tw;
    __device__ __forceinline__ bool relevant(int t) const { return 64 * t <= tw + 15 && 64 * t + 63 >= tw - 511; }
    __device__ __forceinline__ int dq(int t) const { return tq - 64 * t; }
    __device__ __forceinline__ unsigned W() const { return 512u; }
    __device__ __forceinline__ bool en(int) const { return true; } };
struct SlcF { int tq, tw; const LAS unsigned* selrow;
    __device__ __forceinline__ bool en(int t) const { return (selrow[t >> 5] >> (t & 31)) & 1u; }
    __device__ __forceinline__ bool relevant(int t) const { return 64 * t <= tw + 15 && __ballot(en(t)) != 0ull; }
    __device__ __forceinline__ int dq(int t) const { return tq - 64 * t; }
    __device__ __forceinline__ unsigned W() const { return W_CAUSAL; } };
__device__ __forceinline__ void slcwin_unit(const Params& p, LAS unsigned char* lds, int u) {
    const int tid = threadIdx.x, lane = tid & 63, wave = __builtin_amdgcn_readfirstlane(tid >> 6), c = lane & 15, g = lane >> 4;
    const int qb = 63 - u / NH_NSA, h = u % NH_NSA, grp = h / HG;
    unsigned char* ws = p.ws;
    const int tw = 128 * qb + 16 * wave, tq = tw + c;
    const float* GT = (const float*)(ws + OFF_GT) + (size_t)tq * 32 + h * 3;
    QState st; q_load(st, (const bf16_t*)(ws + OFF_QN) + (size_t)tq * D_NSA + h * 128, g);
    LAS unsigned* sel_lds = (LAS unsigned*)(lds + L_MISC);
    sel_lds[tid] = ((const unsigned*)(ws + OFF_HID + OV_SEL))[((size_t)(128 * qb + (tid >> 2)) * 2 + grp) * 4 + (tid & 3)];
    f32x4 res[8];
    { TileSrc src{(const char*)(ws + OFF_KW) + (size_t)grp * S * 256, (const char*)(ws + OFF_VW) + (size_t)grp * S * 256, 256, 256};
      WinF f{tq, tw};
      attn_pass<true>(lds, src, (2 * qb - 8) > 0 ? 2 * qb - 8 : 0, 2 * qb + 2, st, f, tid, c, g);
      const float sc = GT[2] / group_sum(st.l);
#pragma unroll
      for (int dt = 0; dt < 8; ++dt) res[dt] = st.o[dt] * sc; }
    q_reset(st);
    { TileSrc src{(const char*)(ws + OFF_KS) + (size_t)grp * S * 256, (const char*)(ws + OFF_VS) + (size_t)grp * S * 256, 256, 256};
      SlcF f{tq, tw, sel_lds + (16 * wave + c) * 4};
      attn_pass<true>(lds, src, 0, 2 * qb + 2, st, f, tid, c, g);
      const float sc = GT[1] / group_sum(st.l);
#pragma unroll
      for (int dt = 0; dt < 8; ++dt) res[dt] = res[dt] + st.o[dt] * sc; }
    const float* oc = (const float*)(ws + OFF_HID + OV_OC) + (size_t)tq * D_NSA + h * 128 + 4 * g;
    bf16_t* mx = (bf16_t*)(ws + OFF_XB) + (size_t)tq * DM + D_DIL + h * 128 + 4 * g;
#pragma unroll
    for (int dt = 0; dt < 8; ++dt) { const f32x4 o = res[dt] + *(const f32x4*)(oc + 16 * dt);
        u32x2 w; w.x = pg8::cvt_pk_bf16(o[0], o[1]); w.y = pg8::cvt_pk_bf16(o[2], o[3]); *(u32x2*)(mx + 16 * dt) = w; }
}
}


#ifndef NAIVE_COMPRESS
#define NAIVE_COMPRESS 0
#endif
#ifndef NAIVE_DIL
#define NAIVE_DIL 0
#endif
#ifndef NAIVE_NSA
#define NAIVE_NSA 0
#endif
__device__ __forceinline__ void phase_mix_a(const Params& p, LAS unsigned char* lds) {
#if NAIVE_COMPRESS
    compress_naive(p, lds);
#endif
#if NAIVE_DIL
    dilated_naive(p, lds);
#endif
#if !NAIVE_COMPRESS || !NAIVE_DIL
    unsigned* ctr = (unsigned*)(p.ws + OFF_CTL) + 0;
    constexpr int NC = NAIVE_COMPRESS ? 0 : 128, ND = NAIVE_DIL ? 0 : 1152;
    for (;;) { const int u = att::next_unit(ctr, lds); if (u >= NC + ND) break;
        if (u < NC) att::compress_unit(p, lds, u); else att::dil_unit(p, lds, u - NC); }
#endif
}
__device__ __forceinline__ void phase_mix_b(const Params& p, LAS unsigned char* lds) {
#if !NAIVE_NSA
    unsigned* ctr = (unsigned*)(p.ws + OFF_CTL) + 1;
    for (;;) { const int u = att::next_unit(ctr, lds); if (u >= 1024) break; att::cmp_unit(p, lds, u); }
#endif
#if !NAIVE_DIL
    att::dil_merge(p);
#endif
}
__device__ __forceinline__ void phase_mix_c(const Params& p, LAS unsigned char* lds) {
#if NAIVE_NSA
    nsa_naive(p, lds);
#else
    unsigned* ctr = (unsigned*)(p.ws + OFF_CTL) + 2;
    for (;;) { const int u = att::next_unit(ctr, lds); if (u >= 640) break; att::slcwin_unit(p, lds, u); }
#endif
}

constexpr int N_PHASES = 13;
__global__ void __launch_bounds__(NTHREADS, 2) fwd_kernel(Params p) {
    extern __shared__ __attribute__((aligned(16))) unsigned char lds_raw[];
    LAS unsigned char* lds = (LAS unsigned char*)lds_raw;
    cg::grid_group grid = cg::this_grid();
    unsigned char* ws = p.ws;
    bf16_t* XB = (bf16_t*)(ws + OFF_XB); bf16_t* HID = (bf16_t*)(ws + OFF_HID);
    const int lo = p.ph_lo, hi = p.ph_hi;
#define IN(k) (lo <= (k) && (k) < hi)
#define SEAM(k) do { if (IN(k) && IN((k) + 1)) grid.sync(); } while (0)
    if (IN(0)) { p0_prologue(p, lds); }
    SEAM(0);
    if (IN(1)) { pg8::Gemm g{XB, (const bf16_t*)(ws + OFF_W13A), S, 2 * DFF, DM}; pg8::StaticOrder so; so.init(S, 2 * DFF, gridDim.x, blockIdx.x);
        pg8::EpiSwiglu E{HID}; pg8::gemm_phase<pg8::EpiSwiglu, pg8::StaticOrder, true, true>(lds, g, so, E); }
    SEAM(1);
    if (IN(2)) { pg8::Gemm g{HID, (const bf16_t*)(ws + OFF_W2A), S, DM, DFF}; pg8::StaticOrder so; so.init(S, DM, gridDim.x, blockIdx.x);
        pg8::EpiResid E{p.x, p.out, ALPHA, 0.5f}; pg8::gemm_phase<pg8::EpiResid, pg8::StaticOrder, true, true>(lds, g, so, E); }
    SEAM(2);
    if (IN(3)) { ln_phase(p.out, p.out, XB, p.ln1g, p.ln1b); }
    SEAM(3);
    if (IN(4)) { pg8::Gemm g{XB, (const bf16_t*)(ws + OFF_WIN), S, IN_PAD, DM}; pg8::StaticOrder so; so.init(S, IN_PAD, gridDim.x, blockIdx.x);
        pg8::EpiInProj E{(bf16_t*)(ws + OFF_QA), (bf16_t*)(ws + OFF_KA), (bf16_t*)(ws + OFF_VA), (bf16_t*)(ws + OFF_QN), (bf16_t*)(ws + OFF_KS), (bf16_t*)(ws + OFF_VS),
                         (bf16_t*)(ws + OFF_KW), (bf16_t*)(ws + OFF_VW), (float*)(ws + OFF_KCT), (float*)(ws + OFF_VCT), (float*)(ws + OFF_GT),
                         (const float*)(ws + OFF_ROPE), (const float*)(ws + OFF_ROPE) + (size_t)S * 64, p.gateb};
        pg8::gemm_phase<pg8::EpiInProj, pg8::StaticOrder, true, true>(lds, g, so, E); }
    SEAM(4);
    if (IN(5)) { phase_mix_a(p, lds); }
    SEAM(5);
    if (IN(6)) { phase_mix_b(p, lds); }
    SEAM(6);
    if (IN(7)) { phase_mix_c(p, lds); }
    SEAM(7);
    if (IN(8)) { pg8::Gemm g{XB, (const bf16_t*)(ws + OFF_WOUT), S, DM, DM}; pg8::StaticOrder so; so.init(S, DM, gridDim.x, blockIdx.x);
        pg8::EpiResid E{p.out, p.out, ALPHA, 1.0f}; pg8::gemm_phase<pg8::EpiResid, pg8::StaticOrder, true, true>(lds, g, so, E); }
    SEAM(8);
    if (IN(9)) { ln_phase(p.out, p.out, XB, p.ln2g, p.ln2b); }
    SEAM(9);
    if (IN(10)) { pg8::Gemm g{XB, (const bf16_t*)(ws + OFF_W13B), S, 2 * DFF, DM}; pg8::StaticOrder so; so.init(S, 2 * DFF, gridDim.x, blockIdx.x);
        pg8::EpiSwiglu E{HID}; pg8::gemm_phase<pg8::EpiSwiglu, pg8::StaticOrder, true, true>(lds, g, so, E); }
    SEAM(10);
    if (IN(11)) { pg8::Gemm g{HID, (const bf16_t*)(ws + OFF_W2B), S, DM, DFF}; pg8::StaticOrder so; so.init(S, DM, gridDim.x, blockIdx.x);
        pg8::EpiResid E{p.out, p.out, ALPHA, 0.5f}; pg8::gemm_phase<pg8::EpiResid, pg8::StaticOrder, true, true>(lds, g, so, E); }
    SEAM(11);
    if (IN(12)) { ln_phase(p.out, p.out, nullptr, p.ln3g, p.ln3b); }
#undef IN
#undef SEAM
}

extern "C" void kernel_launch(void* const* d_in, const int* in_sizes, int n_in, void* d_out, int out_size, void* d_ws, size_t ws_size, hipStream_t stream) {
    static int grid = 0;
    if (grid == 0) {
        if (n_in != 22 || in_sizes[0] != S * DM || out_size != S * DM || ws_size < WS_END) {
            fprintf(stderr, "kernel_launch: unexpected shapes: n_in %d in0 %d out %d ws %zu (need >= %zu)\n", n_in, n_in > 0 ? in_sizes[0] : -1, out_size, ws_size, (size_t)WS_END); grid = -1; return; }
        int dev = 0, cus = 0, per_cu = 0;
        if (hipGetDevice(&dev) != hipSuccess || hipDeviceGetAttribute(&cus, hipDeviceAttributeMultiprocessorCount, dev) != hipSuccess) { fprintf(stderr, "kernel_launch: device query failed\n"); grid = -1; return; }
        if (hipFuncSetAttribute((const void*)fwd_kernel, hipFuncAttributeMaxDynamicSharedMemorySize, LDS_BYTES) != hipSuccess) { fprintf(stderr, "kernel_launch: hipFuncSetAttribute failed\n"); grid = -1; return; }
        if (hipOccupancyMaxActiveBlocksPerMultiprocessor(&per_cu, (const void*)fwd_kernel, NTHREADS, LDS_BYTES) != hipSuccess || per_cu < 1) { fprintf(stderr, "kernel_launch: occupancy query gave %d\n", per_cu); per_cu = 1; }
        (void)hipGetLastError();
        grid = cus;
    }
    if (grid < 0) return;
    Params p{};
    p.x = (const float*)d_in[0]; p.pos = (const int*)d_in[1];
    p.ln1g = (const float*)d_in[2]; p.ln1b = (const float*)d_in[3]; p.f1w1 = (const float*)d_in[4]; p.f1w3 = (const float*)d_in[5]; p.f1w2 = (const float*)d_in[6];
    p.win = (const float*)d_in[7]; p.gateb = (const float*)d_in[8]; p.cpe = (const float*)d_in[9]; p.cw1 = (const float*)d_in[10]; p.cb1 = (const float*)d_in[11];
    p.cw2 = (const float*)d_in[12]; p.cb2 = (const float*)d_in[13]; p.wout = (const float*)d_in[14]; p.ln2g = (const float*)d_in[15]; p.ln2b = (const float*)d_in[16];
    p.f2w1 = (const float*)d_in[17]; p.f2w3 = (const float*)d_in[18]; p.f2w2 = (const float*)d_in[19]; p.ln3g = (const float*)d_in[20]; p.ln3b = (const float*)d_in[21];
    p.out = (float*)d_out; p.ws = (unsigned char*)d_ws;
#if N_LAUNCH_PER_PHASE
    for (int k = 0; k < N_PHASES; ++k) {
        p.ph_lo = k; p.ph_hi = k + 1;
        void* args[] = {&p};
        hipError_t e = hipLaunchCooperativeKernel((const void*)fwd_kernel, dim3(grid), dim3(NTHREADS), args, LDS_BYTES, stream);
        if (e != hipSuccess) { fprintf(stderr, "kernel_launch: launch of phase %d failed: %s\n", k, hipGetErrorString(e)); break; }
    }
#else
    p.ph_lo = 0; p.ph_hi = N_PHASES;
    void* args[] = {&p};
    hipError_t e = hipLaunchCooperativeKernel((const void*)fwd_kernel, dim3(grid), dim3(NTHREADS), args, LDS_BYTES, stream);
    if (e != hipSuccess) fprintf(stderr, "kernel_launch: cooperative launch failed: %s (grid %d)\n", hipGetErrorString(e), grid);
#endif
}
```

```cpp
#include <hip/hip_runtime.h>
#include <hip/hip_cooperative_groups.h>
#include <cstdio>
#include <cstdint>
namespace cg = cooperative_groups;

#ifndef N_LAUNCH_PER_PHASE
#define N_LAUNCH_PER_PHASE 0
#endif

#define LAS __attribute__((address_space(3)))
typedef unsigned short bf16_t;
typedef short bf16x8 __attribute__((ext_vector_type(8)));
typedef float f32x4 __attribute__((ext_vector_type(4)));
typedef float f32x2 __attribute__((ext_vector_type(2)));
typedef unsigned u32x4 __attribute__((ext_vector_type(4)));
typedef unsigned u32x2 __attribute__((ext_vector_type(2)));

constexpr int S = 8192, DM = 2048, DFF = 5632, HD = 128;
constexpr int NH_DIL = 6, NH_NSA = 10, NG = 2, HG = 5;
constexpr int D_DIL = 768, D_NSA = 1280;
constexpr int IN_COLS = 5150, IN_PAD = 5376;
constexpr int NCMP = 511;
constexpr float LN_EPS = 1e-5f;
constexpr float ALPHA = 1.189207115002721f;
constexpr float QSCALE = 0.08838834764831845f * 1.4426950408889634f;
constexpr int NTHREADS = 512, NWAVES = 8;

constexpr size_t MiB = 1u << 20;
constexpr size_t OFF_CTL = 0;
constexpr size_t OFF_W13A = 1 * MiB, OFF_W2A = 45 * MiB, OFF_W13B = 67 * MiB, OFF_W2B = 111 * MiB;
constexpr size_t OFF_WIN = 133 * MiB, OFF_WOUT = 154 * MiB, OFF_CW1T = 162 * MiB, OFF_CW2T = 166 * MiB;
constexpr size_t OFF_ROPE = 167 * MiB;
constexpr size_t OFF_XB = 171 * MiB;
constexpr size_t OFF_HID = 203 * MiB;
constexpr size_t OFF_QA = 291 * MiB, OFF_KA = 303 * MiB, OFF_VA = 315 * MiB, OFF_QN = 327 * MiB;
constexpr size_t OFF_KCT = 347 * MiB, OFF_VCT = 355 * MiB;
constexpr size_t OFF_KS = 363 * MiB, OFF_VS = 367 * MiB, OFF_KW = 371 * MiB, OFF_VW = 375 * MiB;
constexpr size_t OFF_GT = 379 * MiB;
constexpr size_t OFF_KC = 380 * MiB;
constexpr size_t OFF_VC = OFF_KC + 256 * 1024;
constexpr size_t WS_END = 381 * MiB;

constexpr int LDS_BYTES = 147456;
constexpr int XCD_BAR_WORDS_C = 3456, CW_BAR_C = 4096;

__constant__ double INV_FREQ[64] = {
1.0, 0.8659643233600653, 0.7498942093324559, 0.6493816315762113,
0.5623413251903491, 0.4869675251658631, 0.4216965034285822, 0.3651741272548377,
0.31622776601683794, 0.27384196342643613, 0.23713737056616552, 0.2053525026457146,
0.1778279410038923, 0.1539926526059492, 0.1333521432163324, 0.11547819846894582,
0.1, 0.08659643233600653, 0.07498942093324558, 0.06493816315762113,
0.05623413251903491, 0.04869675251658631, 0.042169650342858224, 0.03651741272548377,
0.03162277660168379, 0.027384196342643614, 0.023713737056616554, 0.02053525026457146,
0.01778279410038923, 0.01539926526059492, 0.01333521432163324, 0.011547819846894581,
0.01, 0.008659643233600654, 0.007498942093324558, 0.006493816315762113,
0.005623413251903491, 0.004869675251658631, 0.004216965034285823, 0.003651741272548377,
0.0031622776601683794, 0.0027384196342643613, 0.0023713737056616554, 0.002053525026457146,
0.0017782794100389228, 0.001539926526059492, 0.001333521432163324, 0.0011547819846894581,
0.001, 0.0008659643233600654, 0.0007498942093324559, 0.0006493816315762113,
0.0005623413251903491, 0.0004869675251658631, 0.00042169650342858224, 0.0003651741272548377,
0.00031622776601683794, 0.0002738419634264361, 0.00023713737056616554, 0.0002053525026457146,
0.00017782794100389227, 0.0001539926526059492, 0.0001333521432163324, 0.00011547819846894582 };

__device__ __forceinline__ unsigned f2bf(float f) { unsigned u = __builtin_bit_cast(unsigned, f); return (u + 0x7fffu + ((u >> 16) & 1u)) >> 16; }
__device__ __forceinline__ unsigned pk2(float lo, float hi) { return f2bf(lo) | (f2bf(hi) << 16); }
__device__ __forceinline__ float bflo(unsigned u) { return __uint_as_float(u << 16); }
__device__ __forceinline__ float bfhi(unsigned u) { return __uint_as_float(u & 0xffff0000u); }
__device__ __forceinline__ float wave_sum(float v) {
#pragma unroll
    for (int o = 1; o < 64; o <<= 1) v += __shfl_xor(v, o);
    return v;
}
__device__ __forceinline__ float wave_max(float v) {
#pragma unroll
    for (int o = 1; o < 64; o <<= 1) v = fmaxf(v, __shfl_xor(v, o));
    return v;
}
__device__ __forceinline__ float fast_exp2(float x) { return __builtin_amdgcn_exp2f(x); }
__device__ __forceinline__ float fast_rcp(float x) { return __builtin_amdgcn_rcpf(x); }
__device__ __forceinline__ void rope_cs(double pos, int i, float& c, float& s) {
    const double rev = pos * INV_FREQ[i] * 0.15915494309189535;
    const double fr = rev - __builtin_rint(rev);
    const float f = (float)fr;
    c = __builtin_amdgcn_cosf(f); s = __builtin_amdgcn_sinf(f);
}

namespace pg8 {
constexpr int BM = 256, BK = 64, HALF = 128, HTB = HALF * BK * 2, STAGE_BYTES = 8 * HTB, NXCD = 8, WGM = 8;
__host__ __device__ __forceinline__ int lds_byte(int r, int c) { const int st = (r >> 4) * 2 + (c >> 5), rr = r & 15, cc = c & 31, ob = rr * 64 + cc * 2; return st * 1024 + (ob ^ (((ob >> 9) & 1) << 5)); }
__host__ __device__ __forceinline__ void stage_rc(int b, int& R, int& C) { const int st = b / 1024, sb = b % 1024, swz = sb ^ (((sb >> 9) & 1) << 5); R = (st >> 1) * 16 + swz / 64; C = (st & 1) * 32 + (swz % 64) / 2; }
__host__ __device__ __forceinline__ int perm32(int rho) { const int n = rho >> 4, i = rho & 15; return 8 * (i >> 2) + 4 * n + (i & 3); }
struct Unit { int pm, pn; };
struct Gemm { const bf16_t* A; const bf16_t* Bt; int M, N, K; };
struct StaticOrder {
    int nM, nN, nwg, G, c;
    __host__ __device__ void init(int M, int N, int G_, int c_) { nM = M / BM; nN = N / BM; nwg = nM * nN; G = G_; c = c_; }
    __host__ __device__ bool next(int i, Unit& u) const {
        const long L = (long)i * G + c; if (L >= nwg) return false;
        int wgid = (int)L; { const int q = nwg / NXCD, r = nwg % NXCD, xcd = wgid % NXCD, off = wgid / NXCD; wgid = (xcd < r ? xcd * (q + 1) : r * (q + 1) + (xcd - r) * q) + off; }
        const int nig = WGM * nN, gid = wgid / nig, fm = gid * WGM, gsz = (nM - fm) < WGM ? (nM - fm) : WGM;
        u.pm = fm + ((wgid % nig) % gsz); u.pn = (wgid % nig) / gsz; return true;
    }
    __device__ __forceinline__ void a_ready(const Unit&) const {}
    __device__ __forceinline__ void done(const Unit&) const {}
};
__device__ __forceinline__ unsigned cvt_pk_bf16(float lo, float hi) { unsigned r; asm volatile("v_cvt_pk_bf16_f32 %0, %1, %2" : "=v"(r) : "v"(lo), "v"(hi)); return r; }

template <class Epi, class Sched, bool ALIGN_EPI = false, bool SP2 = false>
__device__ __forceinline__ void gemm_phase(LAS unsigned char* lds, const Gemm g, const Sched& S, const Epi& E) {
    const int tid = threadIdx.x, wid = __builtin_amdgcn_readfirstlane(tid >> 6), lane = tid & 63, wr = wid >> 2, wc = wid & 3, fr = lane & 15, fq = lane >> 4;
    const int K = g.K, nt = K / BK;
    unsigned voffA[2], voffB[2];
#pragma unroll
    for (int i = 0; i < 2; ++i) { int R, C; stage_rc(tid * 16 + i * 8192, R, C); const int Rb = Epi::PERM ? ((R & ~31) + perm32(R & 31)) : R;
        voffA[i] = (unsigned)(R * K + C) * 2u; voffB[i] = (unsigned)(Rb * K + C) * 2u; }
    const size_t kstep = (size_t)(BK * 2);
    const size_t hstep = (size_t)HALF * K * 2;
    const size_t tstep = 2 * hstep;
    const unsigned ldsw = (unsigned)wid * 1024u;
    const int aoff = lds_byte(wr * 64 + fr, fq * 8), boff = lds_byte(wc * 32 + fr, fq * 8);
#define PG8_SA(b, h) (((b) * 2 + (h)) * HTB)
#define PG8_SB(b, h) ((4 + (b) * 2 + (h)) * HTB)
#define PG8_STAGE(bufoff, gbase, voff) do { _Pragma("unroll") for (int _i = 0; _i < 2; ++_i) \
        __builtin_amdgcn_global_load_lds((const unsigned*)((const char*)(gbase) + (voff)[_i]), (LAS unsigned*)(lds + (bufoff) + ldsw + _i * 8192), 16, 0, 0); } while (0)
#define PG8_LDA(dst, b, h) do { _Pragma("unroll") for (int m = 0; m < 4; ++m) _Pragma("unroll") for (int k = 0; k < 2; ++k) dst[m][k] = *(const LAS bf16x8*)(lds + PG8_SA(b, h) + aoff + m * 2048 + k * 1024); } while (0)
#define PG8_LDB(dst, b, h) do { _Pragma("unroll") for (int n = 0; n < 2; ++n) _Pragma("unroll") for (int k = 0; k < 2; ++k) dst[n][k] = *(const LAS bf16x8*)(lds + PG8_SB(b, h) + boff + n * 2048 + k * 1024); } while (0)
#define PG8_MMA(ai, bj, At, Bt) do { __builtin_amdgcn_s_setprio(1); _Pragma("unroll") for (int m = 0; m < 4; ++m) _Pragma("unroll") for (int n = 0; n < 2; ++n) _Pragma("unroll") for (int k = 0; k < 2; ++k) \
        acc[ai][bj][m][n] = __builtin_amdgcn_mfma_f32_16x16x32_bf16(Bt[n][k], At[m][k], acc[ai][bj][m][n], 0, 0, 0); __builtin_amdgcn_s_setprio(0); } while (0)
#define PG8_WAIT_V(n) asm volatile("s_waitcnt vmcnt(" #n ")" ::: "memory")
#define PG8_WAIT_L(n) asm volatile("s_waitcnt lgkmcnt(" #n ")" ::: "memory")
#define PG8_BAR __builtin_amdgcn_s_barrier()
#define PG8_SCHED __builtin_amdgcn_sched_barrier(0)
    Unit cur, nxt; int ui = 0;
    if (!S.next(0, cur)) return;
    f32x4 acc[2][2][4][2];
#pragma unroll
    for (int a = 0; a < 2; ++a)
#pragma unroll
        for (int b = 0; b < 2; ++b)
#pragma unroll
            for (int m = 0; m < 4; ++m)
#pragma unroll
                for (int n = 0; n < 2; ++n) acc[a][b][m][n] = (f32x4){0.f, 0.f, 0.f, 0.f};
    bf16x8 At[4][2], B0[2][2], B1[2][2];
    const char* cA = (const char*)g.A + (size_t)cur.pm * tstep; const char* cB = (const char*)g.Bt + (size_t)cur.pn * tstep;
    S.a_ready(cur);
    if constexpr (SP2) {
        PG8_STAGE(PG8_SB(0, 0), cB, voffB); PG8_STAGE(PG8_SB(0, 1), cB + hstep, voffB); PG8_STAGE(PG8_SA(0, 0), cA, voffA); PG8_STAGE(PG8_SA(0, 1), cA + hstep, voffA);
        if (wr == 1) PG8_BAR;
        PG8_WAIT_V(2); PG8_BAR;
        PG8_STAGE(PG8_SB(1, 0), cB + kstep, voffB); PG8_STAGE(PG8_SA(1, 0), cA + kstep, voffA); PG8_STAGE(PG8_SB(1, 1), cB + hstep + kstep, voffB);
        PG8_WAIT_V(6); PG8_BAR;
    } else {
        PG8_STAGE(PG8_SB(0, 0), cB, voffB); PG8_STAGE(PG8_SA(0, 0), cA, voffA); PG8_STAGE(PG8_SB(0, 1), cB + hstep, voffB); PG8_STAGE(PG8_SA(0, 1), cA + hstep, voffA);
        if (wr == 1) PG8_BAR;
        PG8_WAIT_V(4); PG8_BAR;
        PG8_STAGE(PG8_SB(1, 0), cB + kstep, voffB); PG8_STAGE(PG8_SA(1, 0), cA + kstep, voffA); PG8_STAGE(PG8_SB(1, 1), cB + hstep + kstep, voffB);
        PG8_WAIT_V(6); PG8_BAR;
    }
    for (;;) {
        const bool has_next = S.next(ui + 1, nxt);
        const char* nA = has_next ? (const char*)g.A + (size_t)nxt.pm * tstep : cA; const char* nB = has_next ? (const char*)g.Bt + (size_t)nxt.pn * tstep : cB;
        for (int t = 0; t < nt; t += 2) {
            const bool last = (t == nt - 2);
            const char* a1 = cA + (size_t)(t + 1) * kstep;
            const char* a2 = last ? nA : cA + (size_t)(t + 2) * kstep; const char* b2 = last ? nB : cB + (size_t)(t + 2) * kstep;
            const char* a3 = a2 + kstep; const char* b3 = b2 + kstep;
            if (last && has_next) S.a_ready(nxt);
            if constexpr (SP2) {
            PG8_LDB(B0, 0, 0); PG8_LDB(B1, 0, 1); PG8_SCHED; PG8_LDA(At, 0, 0); PG8_STAGE(PG8_SA(1, 1), a1 + hstep, voffA);
            PG8_WAIT_V(8); PG8_WAIT_L(0); PG8_BAR; PG8_MMA(0, 0, At, B0); PG8_MMA(0, 1, At, B1); PG8_BAR; PG8_SCHED;
            PG8_LDA(At, 0, 1); PG8_STAGE(PG8_SB(0, 0), b2, voffB); PG8_STAGE(PG8_SB(0, 1), b2 + hstep, voffB); PG8_STAGE(PG8_SA(0, 0), a2, voffA);
            PG8_WAIT_V(8); PG8_WAIT_L(0); PG8_BAR; PG8_MMA(1, 0, At, B0); PG8_MMA(1, 1, At, B1); PG8_BAR; PG8_SCHED;
            PG8_LDB(B0, 1, 0); PG8_LDB(B1, 1, 1); PG8_SCHED; PG8_LDA(At, 1, 0); PG8_STAGE(PG8_SA(0, 1), a2 + hstep, voffA);
            PG8_WAIT_V(8); PG8_WAIT_L(0); PG8_BAR; PG8_MMA(0, 0, At, B0); PG8_MMA(0, 1, At, B1); PG8_BAR; PG8_SCHED;
            PG8_LDA(At, 1, 1); PG8_STAGE(PG8_SB(1, 0), b3, voffB); PG8_STAGE(PG8_SB(1, 1), b3 + hstep, voffB); PG8_STAGE(PG8_SA(1, 0), a3, voffA);
            PG8_WAIT_V(8); PG8_WAIT_L(0); PG8_BAR; PG8_MMA(1, 0, At, B0); PG8_MMA(1, 1, At, B1); PG8_BAR; PG8_SCHED;
            } else {
            PG8_LDB(B0, 0, 0); PG8_SCHED; PG8_LDA(At, 0, 0); PG8_STAGE(PG8_SA(1, 1), a1 + hstep, voffA);
            PG8_WAIT_L(8); PG8_BAR; PG8_WAIT_L(0); PG8_MMA(0, 0, At, B0); PG8_BAR; PG8_SCHED;
            PG8_LDB(B1, 0, 1); PG8_STAGE(PG8_SB(0, 0), b2, voffB);
            PG8_BAR; PG8_WAIT_L(0); PG8_MMA(0, 1, At, B1); PG8_BAR;
            PG8_LDA(At, 0, 1); PG8_STAGE(PG8_SA(0, 0), a2, voffA);
            PG8_BAR; PG8_WAIT_L(0); PG8_MMA(1, 0, At, B0); PG8_BAR; PG8_SCHED;
            PG8_STAGE(PG8_SB(0, 1), b2 + hstep, voffB);
            PG8_WAIT_V(6); PG8_BAR; PG8_MMA(1, 1, At, B1); PG8_BAR;
            PG8_LDB(B0, 1, 0); PG8_SCHED; PG8_LDA(At, 1, 0); PG8_STAGE(PG8_SA(0, 1), a2 + hstep, voffA);
            PG8_WAIT_L(8); PG8_BAR; PG8_WAIT_L(0); PG8_MMA(0, 0, At, B0); PG8_BAR; PG8_SCHED;
            PG8_LDB(B1, 1, 1); PG8_STAGE(PG8_SB(1, 0), b3, voffB);
            PG8_BAR; PG8_WAIT_L(0); PG8_MMA(0, 1, At, B1); PG8_BAR;
            PG8_LDA(At, 1, 1); PG8_STAGE(PG8_SA(1, 0), a3, voffA);
            PG8_BAR; PG8_WAIT_L(0); PG8_MMA(1, 0, At, B0); PG8_BAR; PG8_SCHED;
            PG8_STAGE(PG8_SB(1, 1), b3 + hstep, voffB);
            PG8_WAIT_V(6); PG8_BAR; PG8_MMA(1, 1, At, B1); PG8_BAR;
            }
        }
        if constexpr (ALIGN_EPI) { if (wr == 0) PG8_BAR; }
        E(acc, cur, wr, wc, fr, fq);
        if (!has_next) break;
#pragma unroll
        for (int a = 0; a < 2; ++a)
#pragma unroll
            for (int b = 0; b < 2; ++b)
#pragma unroll
                for (int m = 0; m < 4; ++m)
#pragma unroll
                    for (int n = 0; n < 2; ++n) acc[a][b][m][n] = (f32x4){0.f, 0.f, 0.f, 0.f};
        cur = nxt; cA = nA; cB = nB; ++ui;
        if constexpr (ALIGN_EPI) { if (wr == 1) PG8_BAR; }
    }
    PG8_WAIT_V(0);
    if constexpr (!ALIGN_EPI) { if (wr == 0) PG8_BAR; }
    PG8_BAR;
#undef PG8_SA
#undef PG8_SB
#undef PG8_STAGE
#undef PG8_LDA
#undef PG8_LDB
#undef PG8_MMA
#undef PG8_WAIT_V
#undef PG8_WAIT_L
#undef PG8_BAR
#undef PG8_SCHED
}

struct EpiSwiglu {
    static constexpr bool PERM = true;
    bf16_t* H;
    __device__ __forceinline__ void operator()(const f32x4 (&acc)[2][2][4][2], const Unit& u, int wr, int wc, int fr, int fq) const {
        const int row0 = u.pm * BM + wr * 64 + fr, col0 = u.pn * HALF + wc * 32 + 8 * fq;
#pragma unroll
        for (int ai = 0; ai < 2; ++ai)
#pragma unroll
            for (int m = 0; m < 4; ++m) {
                bf16_t* rowp = H + (size_t)(row0 + ai * HALF + m * 16) * DFF + col0;
                float o[8];
#pragma unroll
                for (int n = 0; n < 2; ++n)
#pragma unroll
                    for (int j = 0; j < 4; ++j) { const float a = acc[ai][0][m][n][j], b = acc[ai][1][m][n][j];
                        const float sg = fast_rcp(1.0f + fast_exp2(-1.4426950408889634f * a)); o[n * 4 + j] = a * sg * b; }
                u32x4 w; w.x = cvt_pk_bf16(o[0], o[1]); w.y = cvt_pk_bf16(o[2], o[3]); w.z = cvt_pk_bf16(o[4], o[5]); w.w = cvt_pk_bf16(o[6], o[7]);
                *(u32x4*)rowp = w;
            }
    }
};
struct EpiResid {
    static constexpr bool PERM = false;
    const float* resid; float* out; float alpha, beta;
    __device__ __forceinline__ void operator()(const f32x4 (&acc)[2][2][4][2], const Unit& u, int wr, int wc, int fr, int fq) const {
        const int col0 = u.pn * BM + wc * 32 + 4 * fq;
#pragma unroll
        for (int ai = 0; ai < 2; ++ai)
#pragma unroll
            for (int m = 0; m < 4; ++m) { const size_t off = (size_t)(u.pm * BM + ai * HALF + wr * 64 + m * 16 + fr) * DM + col0;
#pragma unroll
                for (int bj = 0; bj < 2; ++bj)
#pragma unroll
                    for (int n = 0; n < 2; ++n) { const size_t c = off + bj * HALF + n * 16; const f32x4 r = *(const f32x4*)(resid + c);
                        *(f32x4*)(out + c) = r * alpha + acc[ai][bj][m][n] * beta; } }
    }
};
struct EpiInProj {
    static constexpr bool PERM = false;
    bf16_t *QA, *KA, *VA, *QN, *KS, *VS, *KW, *VW; float *KCT, *VCT, *GT; const float *cosT, *sinT, *gateb;
    __device__ __forceinline__ void operator()(const f32x4 (&acc)[2][2][4][2], const Unit& u, int wr, int wc, int fr, int fq) const {
        const int pn = u.pn;
        const int d0 = 16 * wc + 4 * fq;
        if (pn == 20) {
#pragma unroll
            for (int ai = 0; ai < 2; ++ai)
#pragma unroll
                for (int m = 0; m < 4; ++m) { const int row = u.pm * BM + ai * HALF + wr * 64 + m * 16 + fr;
#pragma unroll
                    for (int j = 0; j < 4; ++j) { const int gc = d0 + j; if (gc < 30) { const float v = acc[ai][0][m][0][j] + gateb[gc]; GT[(size_t)row * 32 + gc] = fast_rcp(1.0f + fast_exp2(-1.4426950408889634f * v)); } } }
            return;
        }
        bool rope = false, isf32 = false; float sc = 1.f; bf16_t* bb = nullptr; float* fb = nullptr; int pitch = 128; size_t bjs = (size_t)S * 128; int colbase = 0;
        if (pn < 3)       { rope = true; sc = QSCALE; bb = QA; pitch = D_DIL; bjs = 128; colbase = 256 * pn; }
        else if (pn < 6)  { rope = true; bb = KA; pitch = D_DIL; bjs = 128; colbase = 256 * (pn - 3); }
        else if (pn < 9)  { bb = VA; pitch = D_DIL; bjs = 128; colbase = 256 * (pn - 6); }
        else if (pn < 14) { rope = true; sc = QSCALE; bb = QN; pitch = D_NSA; bjs = 128; colbase = 256 * (pn - 9); }
        else if (pn == 14) { isf32 = true; fb = KCT; }
        else if (pn == 15) { isf32 = true; fb = VCT; }
        else if (pn == 16) { rope = true; bb = KS; }
        else if (pn == 17) { bb = VS; }
        else if (pn == 18) { rope = true; bb = KW; }
        else               { bb = VW; }
#pragma unroll
        for (int ai = 0; ai < 2; ++ai)
#pragma unroll
            for (int m = 0; m < 4; ++m) {
                const int row = u.pm * BM + ai * HALF + wr * 64 + m * 16 + fr;
                f32x4 cs = (f32x4){1.f, 1.f, 1.f, 1.f}, sn = (f32x4){0.f, 0.f, 0.f, 0.f};
                if (rope) { cs = *(const f32x4*)(cosT + (size_t)row * 64 + d0); sn = *(const f32x4*)(sinT + (size_t)row * 64 + d0); }
#pragma unroll
                for (int bj = 0; bj < 2; ++bj) {
                    const f32x4 x1 = acc[ai][bj][m][0], x2 = acc[ai][bj][m][1];
                    const f32x4 o1 = (x1 * cs - x2 * sn) * sc, o2 = (x2 * cs + x1 * sn) * sc;
                    const size_t off = (size_t)row * pitch + bj * bjs + colbase + d0;
                    if (isf32) { *(f32x4*)(fb + off) = o1; *(f32x4*)(fb + off + 64) = o2; }
                    else { u32x2 w1, w2; w1.x = cvt_pk_bf16(o1[0], o1[1]); w1.y = cvt_pk_bf16(o1[2], o1[3]); w2.x = cvt_pk_bf16(o2[0], o2[1]); w2.y = cvt_pk_bf16(o2[2], o2[3]);
                        *(u32x2*)(bb + off) = w1; *(u32x2*)(bb + off + 64) = w2; }
                }
            }
    }
};
}

struct Params {
    const float* x; const int* pos;
    const float *ln1g, *ln1b, *f1w1, *f1w3, *f1w2, *win, *gateb, *cpe, *cw1, *cb1, *cw2, *cb2, *wout, *ln2g, *ln2b, *f2w1, *f2w3, *f2w2, *ln3g, *ln3b;
    float* out; unsigned char* ws; int ph_lo, ph_hi;
};

template <class SrcFn>
__device__ __forceinline__ void tr_item(int K, int k0, bf16_t* WT, int drow0, const SrcFn& src, LAS float* scr, int lane) {
    const float* sp = src(drow0 + (lane & 31));
    const int N = src.pitch;
#pragma unroll 8
    for (int i = 0; i < 32; ++i) { const int kk = 2 * i + (lane >> 5); scr[kk * 33 + (lane & 31)] = sp ? sp[(size_t)(k0 + kk) * N] : 0.f; }
    asm volatile("s_waitcnt lgkmcnt(0)" ::: "memory");
    const int c = lane & 7;
#pragma unroll
    for (int j = 0; j < 4; ++j) { const int n = (lane >> 3) + 8 * j; const LAS float* s = scr + (8 * c) * 33 + n;
        u32x4 o; o.x = pk2(s[0 * 33], s[1 * 33]); o.y = pk2(s[2 * 33], s[3 * 33]); o.z = pk2(s[4 * 33], s[5 * 33]); o.w = pk2(s[6 * 33], s[7 * 33]);
        *(u32x4*)(WT + (size_t)(drow0 + n) * K + k0 + 8 * c) = o; }
    asm volatile("s_waitcnt lgkmcnt(0)" ::: "memory");
}
struct SrcPlain { const float* W; int pitch; __device__ __forceinline__ const float* operator()(int r) const { return W + r; } };
struct SrcW13 { const float* W; int pitch; __device__ __forceinline__ const float* operator()(int r) const { const int pn = r >> 8, i = r & 127; return W + 128 * pn + i; } };
struct SrcWin { const float* W; int pitch; __device__ __forceinline__ const float* operator()(int r) const {
    const int p = r & 127, wc = (p >> 5) & 3, n = (p >> 4) & 1, d = 64 * n + 16 * wc + (p & 15); const int col = (r & ~127) + d; return col < IN_COLS ? W + col : nullptr; } };

__device__ __forceinline__ void p0_prologue(const Params& p, LAS unsigned char* lds) {
    const int tid = threadIdx.x, lane = tid & 63, wave = __builtin_amdgcn_readfirstlane(tid >> 6);
    LAS float* scr = (LAS float*)(lds + wave * 16384);
    const int gw = blockIdx.x * NWAVES + wave, NGW = gridDim.x * NWAVES;
    unsigned char* ws = p.ws;
    constexpr int I13 = (DM / 64) * (2 * DFF / 32), I2 = (DFF / 64) * (DM / 32), IIN = (DM / 64) * (IN_PAD / 32), IOUT = (DM / 64) * (DM / 32);
    constexpr int ICW1 = (4096 / 64) * (256 / 32), ICW2 = (256 / 64) * (128 / 32);
    constexpr int NITEMS = 2 * I13 + 2 * I2 + IIN + IOUT + 2 * ICW1 + 2 * ICW2;
    if (blockIdx.x == 0) { if (tid < 16) ((unsigned*)(ws + OFF_CTL))[tid] = 0u;
        for (int i = tid; i < XCD_BAR_WORDS_C; i += NTHREADS) ((unsigned*)(ws + OFF_CTL))[CW_BAR_C + i] = 0u; }
    for (int it = gw; it < NITEMS; it += NGW) {
        int r = it;
        if (r < I13) { const int nb = 2 * DFF / 32; const int dr = 32 * (r % nb); const float* W = p.f1w1; if ((dr >> 7) & 1) W = p.f1w3; SrcW13 s{W, DFF}; tr_item(DM, 64 * (r / nb), (bf16_t*)(ws + OFF_W13A), dr, s, scr, lane); continue; } r -= I13;
        if (r < I2)  { const int nb = DM / 32; SrcPlain s{p.f1w2, DM}; tr_item(DFF, 64 * (r / nb), (bf16_t*)(ws + OFF_W2A), 32 * (r % nb), s, scr, lane); continue; } r -= I2;
        if (r < I13) { const int nb = 2 * DFF / 32; const int dr = 32 * (r % nb); const float* W = p.f2w1; if ((dr >> 7) & 1) W = p.f2w3; SrcW13 s{W, DFF}; tr_item(DM, 64 * (r / nb), (bf16_t*)(ws + OFF_W13B), dr, s, scr, lane); continue; } r -= I13;
        if (r < I2)  { const int nb = DM / 32; SrcPlain s{p.f2w2, DM}; tr_item(DFF, 64 * (r / nb), (bf16_t*)(ws + OFF_W2B), 32 * (r % nb), s, scr, lane); continue; } r -= I2;
        if (r < IIN) { const int nb = IN_PAD / 32; SrcWin s{p.win, IN_COLS}; tr_item(DM, 64 * (r / nb), (bf16_t*)(ws + OFF_WIN), 32 * (r % nb), s, scr, lane); continue; } r -= IIN;
        if (r < IOUT) { const int nb = DM / 32; SrcPlain s{p.wout, DM}; tr_item(DM, 64 * (r / nb), (bf16_t*)(ws + OFF_WOUT), 32 * (r % nb), s, scr, lane); continue; } r -= IOUT;
        if (r < 2 * ICW1) { const int j = r / ICW1, q = r % ICW1, nb = 256 / 32; SrcPlain s{p.cw1 + (size_t)j * 4096 * 256, 256}; tr_item(4096, 64 * (q / nb), (bf16_t*)(ws + OFF_CW1T) + (size_t)j * 256 * 4096, 32 * (q % nb), s, scr, lane); continue; } r -= 2 * ICW1;
        { const int j = r / ICW2, q = r % ICW2, nb = 128 / 32; SrcPlain s{p.cw2 + (size_t)j * 256 * 128, 128}; tr_item(256, 64 * (q / nb), (bf16_t*)(ws + OFF_CW2T) + (size_t)j * 128 * 256, 32 * (q % nb), s, scr, lane); }
    }
    {
        const size_t n8 = (size_t)S * DM / 8, gt = (size_t)blockIdx.x * NTHREADS + tid, GT_ = (size_t)gridDim.x * NTHREADS;
        bf16_t* XB = (bf16_t*)(ws + OFF_XB);
        for (size_t i = gt; i < n8; i += GT_) { const f32x4 a = *(const f32x4*)(p.x + i * 8), b = *(const f32x4*)(p.x + i * 8 + 4);
            u32x4 o; o.x = pk2(a[0], a[1]); o.y = pk2(a[2], a[3]); o.z = pk2(b[0], b[1]); o.w = pk2(b[2], b[3]); *(u32x4*)(XB + i * 8) = o; }
    }
    {
        float* cosT = (float*)(ws + OFF_ROPE); float* sinT = cosT + (size_t)S * 64;
        const int gt = blockIdx.x * NTHREADS + tid, GT_ = gridDim.x * NTHREADS;
        for (int i = gt; i < S * 64; i += GT_) { float c, s; rope_cs((double)p.pos[i >> 6], i & 63, c, s); cosT[i] = c; sinT[i] = s; }
    }
}

__device__ __forceinline__ void ln_phase(const float* in, float* outf, bf16_t* outb, const float* g, const float* b) {
    const int tid = threadIdx.x, lane = tid & 63, wave = __builtin_amdgcn_readfirstlane(tid >> 6);
    const int gw = blockIdx.x * NWAVES + wave, NGW = gridDim.x * NWAVES;
    for (int row = gw; row < S; row += NGW) {
        const f32x4* xr = (const f32x4*)(in + (size_t)row * DM) + lane;
        f32x4 v[8]; float s = 0.f;
#pragma unroll
        for (int j = 0; j < 8; ++j) { v[j] = xr[64 * j]; s += (v[j][0] + v[j][1]) + (v[j][2] + v[j][3]); }
        const float mean = wave_sum(s) * (1.f / DM); float s2 = 0.f;
#pragma unroll
        for (int j = 0; j < 8; ++j) { v[j] = v[j] - mean; s2 += (v[j][0] * v[j][0] + v[j][1] * v[j][1]) + (v[j][2] * v[j][2] + v[j][3] * v[j][3]); }
        const float rstd = 1.0f / sqrtf(wave_sum(s2) * (1.f / DM) + LN_EPS);
#pragma unroll
        for (int j = 0; j < 8; ++j) {
            const f32x4 gg = *((const f32x4*)g + lane + 64 * j), bb = *((const f32x4*)b + lane + 64 * j);
            const f32x4 o = v[j] * rstd * gg + bb;
            *((f32x4*)(outf + (size_t)row * DM) + lane + 64 * j) = o;
            if (outb) { u32x2 w; w.x = pk2(o[0], o[1]); w.y = pk2(o[2], o[3]); *((u32x2*)(outb + (size_t)row * DM) + lane + 64 * j) = w; }
        }
    }
}

__device__ __forceinline__ float dot128(const LAS bf16_t* q, const bf16_t* k) {
    float a0 = 0.f, a1 = 0.f;
#pragma unroll
    for (int c = 0; c < 16; ++c) { const u32x4 qv = *(const LAS u32x4*)(q + 8 * c); const u32x4 kv = *(const u32x4*)(k + 8 * c);
#pragma unroll
        for (int e = 0; e < 4; ++e) { a0 += bflo(qv[e]) * bflo(kv[e]); a1 += bfhi(qv[e]) * bfhi(kv[e]); } }
    return a0 + a1;
}
__device__ __forceinline__ float gelu_tanh(float x) {
    const float u = 0.7978845608028654f * (x + 0.044715f * x * x * x);
    const float e = __expf(2.f * u);
    const float th = 1.f - 2.f / (e + 1.f);
    return 0.5f * x * (1.f + th);
}

__device__ __forceinline__ void compress_naive(const Params& p, LAS unsigned char* lds) {
    const int tid = threadIdx.x;
    LAS float* A = (LAS float*)lds; LAS float* part = A + 4096; LAS float* hdn = part + 512; LAS float* outv = hdn + 256;
    unsigned char* ws = p.ws;
    bf16_t* KC = (bf16_t*)(ws + OFF_KC); bf16_t* VC = (bf16_t*)(ws + OFF_VC);
    for (int u = blockIdx.x; u < 2 * NG * 512; u += gridDim.x) {
        const int n = u & 511, g = (u >> 9) & 1, j = u >> 10;
        bf16_t* dst = (j ? VC : KC) + ((size_t)g * 512 + n) * 128;
        if (n >= NCMP) { if (tid < 128) dst[tid] = 0; continue; }
        const float* tok = (const float*)(ws + (j ? OFF_VCT : OFF_KCT)) + ((size_t)g * S + 16 * n) * 128;
        const float* pe = p.cpe + (size_t)j * 32 * 128;
        for (int i = tid; i < 4096; i += NTHREADS) A[i] = tok[i] + pe[i];
        __syncthreads();
        { const int h = tid & 255, half = tid >> 8; const float* w = p.cw1 + ((size_t)j * 4096 + 2048 * half) * 256 + h; const LAS float* a = A + 2048 * half;
          float acc = 0.f;
#pragma unroll 8
          for (int k = 0; k < 2048; ++k) acc += a[k] * w[(size_t)k * 256];
          part[tid] = acc; }
        __syncthreads();
        if (tid < 256) hdn[tid] = gelu_tanh(part[tid] + part[tid + 256] + p.cb1[j * 256 + tid]);
        __syncthreads();
        if (tid < 128) { const float* w = p.cw2 + (size_t)j * 256 * 128 + tid; float acc = p.cb2[j * 128 + tid];
#pragma unroll 8
            for (int h = 0; h < 256; ++h) acc += hdn[h] * w[(size_t)h * 128];
            outv[tid] = acc; }
        __syncthreads();
        if (j == 0) { if (tid < 64) { const double pc = 0.5 * ((double)p.pos[16 * n] + (double)p.pos[16 * n + 31]); float c, s; rope_cs(pc, tid, c, s);
                const float x1 = outv[tid], x2 = outv[tid + 64]; dst[tid] = (bf16_t)f2bf(x1 * c - x2 * s); dst[tid + 64] = (bf16_t)f2bf(x2 * c + x1 * s); } }
        else { if (tid < 128) dst[tid] = (bf16_t)f2bf(outv[tid]); }
        __syncthreads();
    }
}

__device__ __forceinline__ void dilated_naive(const Params& p, LAS unsigned char* lds) {
    const int tid = threadIdx.x, lane = tid & 63, wave = __builtin_amdgcn_readfirstlane(tid >> 6);
    LAS bf16_t* qs = (LAS bf16_t*)(lds + 32768) + wave * 128;
    unsigned char* ws = p.ws;
    const bf16_t* QA = (const bf16_t*)(ws + OFF_QA); const bf16_t* KA = (const bf16_t*)(ws + OFF_KA); const bf16_t* VA = (const bf16_t*)(ws + OFF_VA);
    bf16_t* MX = (bf16_t*)(ws + OFF_XB);
    const int gw = blockIdx.x * NWAVES + wave, NGW = gridDim.x * NWAVES;
    for (int u = gw; u < S * NH_DIL; u += NGW) {
        const int t = u / NH_DIL, h = u % NH_DIL;
        *(LAS unsigned*)(qs + 2 * lane) = *(const unsigned*)(QA + (size_t)t * D_DIL + h * 128 + 2 * lane);
        asm volatile("s_waitcnt lgkmcnt(0)" ::: "memory");
        float sc[3][3]; float m = -INFINITY;
#pragma unroll
        for (int c = 0; c < 3; ++c) { const int dil = c == 0 ? 1 : (c == 1 ? 4 : 16);
#pragma unroll
            for (int it = 0; it < 3; ++it) { const int k = lane + 64 * it; const int tk = t - dil * k; const bool valid = (k <= 128) && (tk >= 0);
                float s = -INFINITY; if (valid) s = dot128(qs, KA + (size_t)tk * D_DIL + h * 128); sc[c][it] = s; m = fmaxf(m, s); } }
        m = wave_max(m);
        float l = 0.f;
#pragma unroll
        for (int c = 0; c < 3; ++c)
#pragma unroll
            for (int it = 0; it < 3; ++it) { const float e = fast_exp2(sc[c][it] - m); sc[c][it] = e; l += e; }
        l = wave_sum(l);
        float o0 = 0.f, o1 = 0.f;
#pragma unroll
        for (int c = 0; c < 3; ++c) { const int dil = c == 0 ? 1 : (c == 1 ? 4 : 16);
#pragma unroll
            for (int it = 0; it < 3; ++it) { int cnt = 129 - 64 * it; cnt = cnt > 64 ? 64 : cnt; const int kmax = t / dil - 64 * it + 1; cnt = cnt < kmax ? cnt : kmax;
                for (int kk = 0; kk < cnt; ++kk) { const float pk = __uint_as_float(__builtin_amdgcn_readlane(__float_as_uint(sc[c][it]), kk));
                    const unsigned v = *(const unsigned*)(VA + (size_t)(t - dil * (kk + 64 * it)) * D_DIL + h * 128 + 2 * lane); o0 += pk * bflo(v); o1 += pk * bfhi(v); } } }
        const float inv = 1.f / l;
        *(unsigned*)(MX + (size_t)t * DM + h * 128 + 2 * lane) = pk2(o0 * inv, o1 * inv);
    }
}

__device__ __forceinline__ void nsa_naive(const Params& p, LAS unsigned char* lds) {
    const int tid = threadIdx.x, lane = tid & 63, wave = __builtin_amdgcn_readfirstlane(tid >> 6);
    LAS bf16_t* qsh = (LAS bf16_t*)lds;
    LAS float* Pc = (LAS float*)(lds + 2048);
    LAS int* sel = (LAS int*)(lds + 2048 + 10240);
    unsigned char* ws = p.ws;
    const bf16_t* QN = (const bf16_t*)(ws + OFF_QN);
    const bf16_t* KC = (const bf16_t*)(ws + OFF_KC); const bf16_t* VC = (const bf16_t*)(ws + OFF_VC);
    const bf16_t* KS = (const bf16_t*)(ws + OFF_KS); const bf16_t* VS = (const bf16_t*)(ws + OFF_VS);
    const bf16_t* KW = (const bf16_t*)(ws + OFF_KW); const bf16_t* VW = (const bf16_t*)(ws + OFF_VW);
    const float* GT = (const float*)(ws + OFF_GT);
    bf16_t* MX = (bf16_t*)(ws + OFF_XB);
    for (int u = blockIdx.x; u < S * NG; u += gridDim.x) {
        const int t = u >> 1, g = u & 1;
        const int h = HG * g + wave;
        LAS bf16_t* qs = qsh + wave * 128;
        float oc0 = 0.f, oc1 = 0.f;
        if (wave < HG) {
            *(LAS unsigned*)(qs + 2 * lane) = *(const unsigned*)(QN + (size_t)t * D_NSA + h * 128 + 2 * lane);
            asm volatile("s_waitcnt lgkmcnt(0)" ::: "memory");
            const int ncnt = (t >= 31) ? (t - 31) / 16 + 1 : 0;
            float s[8]; float m = -INFINITY;
#pragma unroll
            for (int it = 0; it < 8; ++it) { const int n = lane + 64 * it; float v = -INFINITY; if (n < ncnt) v = dot128(qs, KC + ((size_t)g * 512 + n) * 128); s[it] = v; m = fmaxf(m, v); }
            m = wave_max(m);
            float l = 0.f;
#pragma unroll
            for (int it = 0; it < 8; ++it) { const int n = lane + 64 * it; const float e = (n < ncnt) ? fast_exp2(s[it] - m) : 0.f; s[it] = e; l += e; }
            l = wave_sum(l);
            const float inv = l > 0.f ? 1.f / l : 0.f;
#pragma unroll
            for (int it = 0; it < 8; ++it) { s[it] *= inv; Pc[wave * 512 + lane + 64 * it] = s[it]; }
#pragma unroll
            for (int it = 0; it < 8; ++it) { int cnt = ncnt - 64 * it; cnt = cnt > 64 ? 64 : cnt;
                for (int kk = 0; kk < cnt; ++kk) { const float pk = __uint_as_float(__builtin_amdgcn_readlane(__float_as_uint(s[it]), kk));
                    const unsigned v = *(const unsigned*)(VC + ((size_t)g * 512 + 64 * it + kk) * 128 + 2 * lane); oc0 += pk * bflo(v); oc1 += pk * bfhi(v); } }
        }
        __syncthreads();
        if (wave == 0) {
            const int cur = t >> 6;
            float sc0, sc1;
            { const int jj = lane; float imp = 0.f;
              for (int n = 4 * jj - 1; n <= 4 * jj + 3; ++n) if (n >= 0 && n < NCMP) { for (int w = 0; w < HG; ++w) imp += Pc[w * 512 + n]; }
              const bool forced = (jj == 0) || (jj == cur) || (jj == cur - 1);
              sc0 = (jj <= cur) ? imp + (forced ? 1e4f : 0.f) : -1e30f; }
            { const int jj = lane + 64; float imp = 0.f;
              for (int n = 4 * jj - 1; n <= 4 * jj + 3; ++n) if (n >= 0 && n < NCMP) { for (int w = 0; w < HG; ++w) imp += Pc[w * 512 + n]; }
              const bool forced = (jj == 0) || (jj == cur) || (jj == cur - 1);
              sc1 = (jj <= cur) ? imp + (forced ? 1e4f : 0.f) : -1e30f; }
            for (int r = 0; r < 16; ++r) {
                const float mx = wave_max(fmaxf(sc0, sc1));
                const unsigned long long b0 = __ballot(sc0 == mx);
                int idx;
                if (b0) idx = __builtin_ctzll(b0); else { const unsigned long long b1 = __ballot(sc1 == mx); idx = 64 + __builtin_ctzll(b1); }
                if (lane == 0) sel[r] = (mx > -1e29f) ? idx : -1;
                if (idx < 64) { if (lane == idx) sc0 = -INFINITY; } else { if (lane == idx - 64) sc1 = -INFINITY; }
            }
        }
        __syncthreads();
        if (wave < HG) {
            float ss[16]; float m = -INFINITY;
#pragma unroll
            for (int r = 0; r < 16; ++r) { const int j = __builtin_amdgcn_readfirstlane(sel[r]); float v = -INFINITY;
                if (j >= 0) { const int kp = 64 * j + lane; if (kp <= t) v = dot128(qs, KS + ((size_t)g * S + kp) * 128); }
                ss[r] = v; m = fmaxf(m, v); }
            m = wave_max(m);
            float l = 0.f;
#pragma unroll
            for (int r = 0; r < 16; ++r) { const float e = fast_exp2(ss[r] - m); ss[r] = e; l += e; }
            l = wave_sum(l);
            float os0 = 0.f, os1 = 0.f;
#pragma unroll
            for (int r = 0; r < 16; ++r) { const int j = __builtin_amdgcn_readfirstlane(sel[r]); if (j >= 0) { int cnt = t - 64 * j + 1; cnt = cnt > 64 ? 64 : cnt;
                for (int kk = 0; kk < cnt; ++kk) { const float pk = __uint_as_float(__builtin_amdgcn_readlane(__float_as_uint(ss[r]), kk));
                    const unsigned v = *(const unsigned*)(VS + ((size_t)g * S + 64 * j + kk) * 128 + 2 * lane); os0 += pk * bflo(v); os1 += pk * bfhi(v); } } }
            const float invs = 1.f / l;
            float sw[8]; float mw = -INFINITY;
#pragma unroll
            for (int it = 0; it < 8; ++it) { const int kp = t - 511 + lane + 64 * it; float v = -INFINITY; if (kp >= 0) v = dot128(qs, KW + ((size_t)g * S + kp) * 128); sw[it] = v; mw = fmaxf(mw, v); }
            mw = wave_max(mw);
            float lw = 0.f;
#pragma unroll
            for (int it = 0; it < 8; ++it) { const float e = fast_exp2(sw[it] - mw); sw[it] = e; lw += e; }
            lw = wave_sum(lw);
            float ow0 = 0.f, ow1 = 0.f;
#pragma unroll
            for (int it = 0; it < 8; ++it) { const int kp0 = t - 511 + 64 * it; int k0 = kp0 < 0 ? -kp0 : 0; k0 = k0 > 64 ? 64 : k0;
                for (int kk = k0; kk < 64; ++kk) { const float pk = __uint_as_float(__builtin_amdgcn_readlane(__float_as_uint(sw[it]), kk));
                    const unsigned v = *(const unsigned*)(VW + ((size_t)g * S + kp0 + kk) * 128 + 2 * lane); ow0 += pk * bflo(v); ow1 += pk * bfhi(v); } }
            const float invw = 1.f / lw;
            const float g0 = GT[(size_t)t * 32 + h * 3 + 0], g1 = GT[(size_t)t * 32 + h * 3 + 1], g2 = GT[(size_t)t * 32 + h * 3 + 2];
            const float r0 = g0 * oc0 + g1 * os0 * invs + g2 * ow0 * invw, r1 = g0 * oc1 + g1 * os1 * invs + g2 * ow1 * invw;
            *(unsigned*)(MX + (size_t)t * DM + D_DIL + h * 128 + 2 * lane) = pk2(r0, r1);
        }
        __syncthreads();
    }
}

namespace att {
typedef short s16x4 __attribute__((ext_vector_type(4)));
constexpr int KP = 272, VP = 288;
constexpr int KT_BYTES = 64 * KP, VT_BYTES = 64 * VP;
constexpr int L_K0 = 0, L_K1 = KT_BYTES, L_V0 = 2 * KT_BYTES, L_V1 = 2 * KT_BYTES + VT_BYTES;
constexpr int L_MISC = 73728;
constexpr int L_SLOT = 143360;
constexpr unsigned W_CAUSAL = 0x80000000u;
constexpr size_t OV_OD = 0, OV_LSE = 40 * MiB, OV_OC = 41 * MiB, OV_SEL = 82 * MiB;

struct TileSrc { const char* K; const char* V; size_t kst, vst; };

__device__ __forceinline__ void tile_load(u32x4 (&r)[4], const TileSrc& s, int key0, int tid) {
    const int k = tid >> 4, cc = (tid & 15) * 16;
    const char* kp = s.K + (size_t)(key0 + k) * s.kst + cc; const char* vp = s.V + (size_t)(key0 + k) * s.vst + cc;
    r[0] = *(const u32x4*)kp; r[1] = *(const u32x4*)(kp + 32 * s.kst); r[2] = *(const u32x4*)vp; r[3] = *(const u32x4*)(vp + 32 * s.vst);
}
__device__ __forceinline__ void tile_store(LAS unsigned char* lds, int buf, const u32x4 (&r)[4], int tid) {
    const int k = tid >> 4, cc = (tid & 15) * 16;
    const int lam = 16 * ((k >> 2) & 1) + 4 * ((k >> 3) & 3) + (k & 3);
    const int lv = (k & 16) + 8 * ((k >> 2) & 1) + 4 * ((k >> 3) & 1) + (k & 3);
    LAS unsigned char* Kt = lds + (buf ? L_K1 : L_K0); LAS unsigned char* Vt = lds + (buf ? L_V1 : L_V0);
    *(LAS u32x4*)(Kt + lam * KP + cc) = r[0]; *(LAS u32x4*)(Kt + (lam + 32) * KP + cc) = r[1];
    *(LAS u32x4*)(Vt + lv * VP + cc) = r[2]; *(LAS u32x4*)(Vt + (lv + 32) * VP + cc) = r[3];
}
struct QState { bf16x8 qf[4]; f32x4 o[8]; float m, l; };
__device__ __forceinline__ void q_reset(QState& st) {
#pragma unroll
    for (int i = 0; i < 8; ++i) st.o[i] = (f32x4){0.f, 0.f, 0.f, 0.f};
    st.m = -1e30f; st.l = 0.f;
}
__device__ __forceinline__ void q_load(QState& st, const bf16_t* qrow, int g) {
#pragma unroll
    for (int ds = 0; ds < 4; ++ds) st.qf[ds] = *(const bf16x8*)(qrow + 32 * ds + 8 * g);
    q_reset(st);
}
__device__ __forceinline__ void qk_tile(f32x4 (&s)[4], const LAS unsigned char* Kt, const QState& st, int c, int g) {
    const LAS unsigned char* kb = Kt + c * KP + g * 16;
#pragma unroll
    for (int T = 0; T < 4; ++T) { s[T] = (f32x4){0.f, 0.f, 0.f, 0.f};
#pragma unroll
        for (int ds = 0; ds < 4; ++ds) { const bf16x8 kf = *(const LAS bf16x8*)(kb + T * 16 * KP + ds * 64); s[T] = __builtin_amdgcn_mfma_f32_16x16x32_bf16(kf, st.qf[ds], s[T], 0, 0, 0); } }
}
__device__ __forceinline__ void mask_tile(f32x4 (&s)[4], int dq, unsigned W, bool en, int g) {
#pragma unroll
    for (int T = 0; T < 4; ++T)
#pragma unroll
        for (int r = 0; r < 4; ++r) { const int kt = 32 * (T >> 1) + 8 * g + 4 * (T & 1) + r; if (!(en && (unsigned)(dq - kt) < W)) s[T][r] = -INFINITY; }
}
__device__ __forceinline__ float group_max(float v) { v = fmaxf(v, __shfl_xor(v, 16)); v = fmaxf(v, __shfl_xor(v, 32)); return v; }
__device__ __forceinline__ float group_sum(float v) { v += __shfl_xor(v, 16); v += __shfl_xor(v, 32); return v; }
template <bool PV> __device__ __forceinline__ void softmax_online(f32x4 (&s)[4], QState& st) {
    float mx = -INFINITY;
#pragma unroll
    for (int T = 0; T < 4; ++T)
#pragma unroll
        for (int r = 0; r < 4; ++r) mx = fmaxf(mx, s[T][r]);
    mx = group_max(mx);
    const float mn = fmaxf(st.m, mx), alpha = fast_exp2(st.m - mn); st.m = mn;
    float sum = 0.f;
#pragma unroll
    for (int T = 0; T < 4; ++T)
#pragma unroll
        for (int r = 0; r < 4; ++r) { const float e = fast_exp2(s[T][r] - mn); s[T][r] = e; sum += e; }
    st.l = st.l * alpha + sum;
    if (PV) {
#pragma unroll
        for (int i = 0; i < 8; ++i) st.o[i] = st.o[i] * alpha;
    }
}
__device__ __forceinline__ s16x4 tr_read(const LAS unsigned char* p) { return __builtin_bit_cast(s16x4, __builtin_amdgcn_ds_read_tr16_b64_v4i16((LAS s16x4*)p)); }
__device__ __forceinline__ void pv_tile(const f32x4 (&s)[4], const LAS unsigned char* Vt, QState& st, int c, int g) {
    const LAS unsigned char* vb = Vt + (16 * (g >> 1) + 4 * (g & 1) + (c >> 2)) * VP + (c & 3) * 8;
#pragma unroll
    for (int ch = 0; ch < 2; ++ch) {
        u32x4 pw; pw.x = pg8::cvt_pk_bf16(s[2 * ch][0], s[2 * ch][1]); pw.y = pg8::cvt_pk_bf16(s[2 * ch][2], s[2 * ch][3]);
        pw.z = pg8::cvt_pk_bf16(s[2 * ch + 1][0], s[2 * ch + 1][1]); pw.w = pg8::cvt_pk_bf16(s[2 * ch + 1][2], s[2 * ch + 1][3]);
        const bf16x8 pf = __builtin_bit_cast(bf16x8, pw);
#pragma unroll
        for (int dt = 0; dt < 8; ++dt) {
            const s16x4 lo = tr_read(vb + ch * 32 * VP + dt * 32), hi = tr_read(vb + ch * 32 * VP + 8 * VP + dt * 32);
            const bf16x8 vf = (bf16x8){lo[0], lo[1], lo[2], lo[3], hi[0], hi[1], hi[2], hi[3]};
            st.o[dt] = __builtin_amdgcn_mfma_f32_16x16x32_bf16(vf, pf, st.o[dt], 0, 0, 0);
        }
    }
}
template <bool PV, class F>
__device__ __forceinline__ void attn_pass(LAS unsigned char* lds, const TileSrc& src, int t0, int t1, QState& st, const F& f, int tid, int c, int g) {
    if (t0 >= t1) return;
    u32x4 r[4];
    tile_load(r, src, 64 * t0, tid); tile_store(lds, 0, r, tid); __syncthreads();
    for (int t = t0; t < t1; ++t) {
        const int buf = (t - t0) & 1;
        if (t + 1 < t1) tile_load(r, src, 64 * (t + 1), tid);
        if (f.relevant(t)) {
            f32x4 s[4]; qk_tile(s, lds + (buf ? L_K1 : L_K0), st, c, g); mask_tile(s, f.dq(t), f.W(), f.en(t), g); softmax_online<PV>(s, st);
            if (PV) pv_tile(s, lds + (buf ? L_V1 : L_V0), st, c, g);
        }
        if (t + 1 < t1) tile_store(lds, buf ^ 1, r, tid);
        __syncthreads();
    }
}
__device__ __forceinline__ int next_unit(unsigned* ctr, LAS unsigned char* lds) {
    LAS int* slot = (LAS int*)(lds + L_SLOT);
    __syncthreads();
    if (threadIdx.x == 0) *slot = (int)atomicAdd(ctr, 1u);
    __syncthreads();
    return *slot;
}

struct DilF { int iq, iw;
    __device__ __forceinline__ bool relevant(int t) const { return 64 * t <= iw + 15 && 64 * t + 63 >= iw - 128; }
    __device__ __forceinline__ int dq(int t) const { return iq - 64 * t; }
    __device__ __forceinline__ unsigned W() const { return 129u; }
    __device__ __forceinline__ bool en(int) const { return true; } };
__device__ __forceinline__ void dil_unit(const Params& p, LAS unsigned char* lds, int u) {
    const int tid = threadIdx.x, lane = tid & 63, wave = __builtin_amdgcn_readfirstlane(tid >> 6), c = lane & 15, g = lane >> 4;
    const int cfg = u / 384, v = u % 384, h = v % NH_DIL, rb = v / NH_DIL;
    const int dil = cfg == 0 ? 1 : (cfg == 1 ? 4 : 16), nb = (S / dil) / 128, r = rb / nb, b = rb % nb;
    unsigned char* ws = p.ws;
    const int iw = 128 * b + 16 * wave, iq = iw + c, tok = dil * iq + r;
    QState st; q_load(st, (const bf16_t*)(ws + OFF_QA) + (size_t)tok * D_DIL + h * 128, g);
    TileSrc src{(const char*)(ws + OFF_KA) + ((size_t)r * D_DIL + h * 128) * 2, (const char*)(ws + OFF_VA) + ((size_t)r * D_DIL + h * 128) * 2, (size_t)dil * D_DIL * 2, (size_t)dil * D_DIL * 2};
    DilF f{iq, iw};
    attn_pass<true>(lds, src, b == 0 ? 0 : 2 * (b - 1), 2 * b + 2, st, f, tid, c, g);
    const float lt = group_sum(st.l), inv = 1.f / lt;
    bf16_t* od = (bf16_t*)(ws + OFF_HID + OV_OD) + ((size_t)cfg * S + tok) * D_DIL + h * 128 + 4 * g;
#pragma unroll
    for (int dt = 0; dt < 8; ++dt) { u32x2 w; w.x = pg8::cvt_pk_bf16(st.o[dt][0] * inv, st.o[dt][1] * inv); w.y = pg8::cvt_pk_bf16(st.o[dt][2] * inv, st.o[dt][3] * inv); *(u32x2*)(od + 16 * dt) = w; }
    if (g == 0) ((float*)(ws + OFF_HID + OV_LSE))[((size_t)cfg * S + tok) * 8 + h] = st.m + __log2f(lt);
}
__device__ __forceinline__ void dil_merge(const Params& p) {
    unsigned char* ws = p.ws;
    const bf16_t* OD = (const bf16_t*)(ws + OFF_HID + OV_OD); const float* LSE = (const float*)(ws + OFF_HID + OV_LSE); bf16_t* MX = (bf16_t*)(ws + OFF_XB);
    const int gt = blockIdx.x * NTHREADS + threadIdx.x, GT_ = gridDim.x * NTHREADS;
    for (int i = gt; i < S * NH_DIL * 16; i += GT_) {
        const int ch = i & 15, th = i >> 4, h = th % NH_DIL, t = th / NH_DIL;
        const float l0 = LSE[((size_t)0 * S + t) * 8 + h], l1 = LSE[((size_t)1 * S + t) * 8 + h], l2 = LSE[((size_t)2 * S + t) * 8 + h];
        const float mx = fmaxf(l0, fmaxf(l1, l2)); float w0 = fast_exp2(l0 - mx), w1 = fast_exp2(l1 - mx), w2 = fast_exp2(l2 - mx);
        const float inv = 1.f / (w0 + w1 + w2); w0 *= inv; w1 *= inv; w2 *= inv;
        const size_t off = (size_t)t * D_DIL + h * 128 + 8 * ch;
        const u32x4 a = *(const u32x4*)(OD + off), b = *(const u32x4*)(OD + (size_t)S * D_DIL + off), cc = *(const u32x4*)(OD + (size_t)2 * S * D_DIL + off);
        u32x4 o;
#pragma unroll
        for (int e = 0; e < 4; ++e) o[e] = pk2(w0 * bflo(a[e]) + w1 * bflo(b[e]) + w2 * bflo(cc[e]), w0 * bfhi(a[e]) + w1 * bfhi(b[e]) + w2 * bfhi(cc[e]));
        *(u32x4*)(MX + (size_t)t * DM + h * 128 + 8 * ch) = o;
    }
}

__device__ __forceinline__ void compress_unit(const Params& p, LAS unsigned char* lds, int u) {
    const int tid = threadIdx.x, lane = tid & 63, wave = __builtin_amdgcn_readfirstlane(tid >> 6), c = lane & 15, g4 = lane >> 4;
    const int nb = u & 31, grp = (u >> 5) & 1, j = u >> 6, n0 = 16 * nb;
    unsigned char* ws = p.ws;
    constexpr int AP = 1040, HP = 528, OP = 132;
    LAS unsigned char* Ach = lds; LAS unsigned char* HDl = lds + 16 * AP; LAS float* OUTF = (LAS float*)(lds + 16 * AP + 16 * HP);
    const float* TOK = (const float*)(ws + (j ? OFF_VCT : OFF_KCT)) + ((size_t)grp * S + n0 * 16) * 128;
    const float* pe = p.cpe + (size_t)j * 32 * 128;
    const bf16_t* W1T = (const bf16_t*)(ws + OFF_CW1T) + (size_t)j * 256 * 4096; const bf16_t* W2T = (const bf16_t*)(ws + OFF_CW2T) + (size_t)j * 128 * 256;
    f32x4 acc[2]; acc[0] = (f32x4){0.f, 0.f, 0.f, 0.f}; acc[1] = acc[0];
    for (int kc = 0; kc < 8; ++kc) {
        { const int n = tid >> 5, kl = (tid & 31) * 16, l = 4 * kc + (kl >> 7), d = kl & 127;
          const float* sp = TOK + ((size_t)(16 * n + l)) * 128 + d; const float* pp = pe + l * 128 + d;
          f32x4 a[4];
#pragma unroll
          for (int e = 0; e < 4; ++e) a[e] = *(const f32x4*)(sp + 4 * e) + *(const f32x4*)(pp + 4 * e);
          u32x4 w0, w1; w0.x = pk2(a[0][0], a[0][1]); w0.y = pk2(a[0][2], a[0][3]); w0.z = pk2(a[1][0], a[1][1]); w0.w = pk2(a[1][2], a[1][3]);
          w1.x = pk2(a[2][0], a[2][1]); w1.y = pk2(a[2][2], a[2][3]); w1.z = pk2(a[3][0], a[3][1]); w1.w = pk2(a[3][2], a[3][3]);
          *(LAS u32x4*)(Ach + n * AP + kl * 2) = w0; *(LAS u32x4*)(Ach + n * AP + kl * 2 + 16) = w1; }
        __syncthreads();
#pragma unroll 4
        for (int ks = 0; ks < 16; ++ks) {
            const bf16x8 bfr = *(const LAS bf16x8*)(Ach + c * AP + (32 * ks + 8 * g4) * 2);
#pragma unroll
            for (int nn = 0; nn < 2; ++nn) { const bf16x8 afr = *(const bf16x8*)(W1T + (size_t)(32 * wave + 16 * nn + c) * 4096 + 512 * kc + 32 * ks + 8 * g4);
                acc[nn] = __builtin_amdgcn_mfma_f32_16x16x32_bf16(afr, bfr, acc[nn], 0, 0, 0); }
        }
        __syncthreads();
    }
#pragma unroll
    for (int nn = 0; nn < 2; ++nn) { const int hb = 32 * wave + 16 * nn + 4 * g4; const f32x4 bb = *(const f32x4*)(p.cb1 + j * 256 + hb);
        u32x2 w; w.x = pk2(gelu_tanh(acc[nn][0] + bb[0]), gelu_tanh(acc[nn][1] + bb[1])); w.y = pk2(gelu_tanh(acc[nn][2] + bb[2]), gelu_tanh(acc[nn][3] + bb[3]));
        *(LAS u32x2*)(HDl + c * HP + hb * 2) = w; }
    __syncthreads();
    { f32x4 a2 = (f32x4){0.f, 0.f, 0.f, 0.f};
#pragma unroll
      for (int ks = 0; ks < 8; ++ks) { const bf16x8 afr = *(const bf16x8*)(W2T + (size_t)(16 * wave + c) * 256 + 32 * ks + 8 * g4); const bf16x8 bfr = *(const LAS bf16x8*)(HDl + c * HP + (32 * ks + 8 * g4) * 2);
          a2 = __builtin_amdgcn_mfma_f32_16x16x32_bf16(afr, bfr, a2, 0, 0, 0); }
      const int d = 16 * wave + 4 * g4; const f32x4 bb = *(const f32x4*)(p.cb2 + j * 128 + d);
      *(LAS f32x4*)(OUTF + c * OP + d) = a2 + bb; }
    __syncthreads();
    if (j == 0) {
        bf16_t* KC = (bf16_t*)(ws + OFF_KC) + ((size_t)grp * 512 + n0) * 128;
#pragma unroll
        for (int e = 0; e < 2; ++e) { const int idx = tid + 512 * e, n = idx >> 6, d = idx & 63;
            if (n0 + n >= NCMP) { KC[n * 128 + d] = 0; KC[n * 128 + d + 64] = 0; }
            else { const int nn = n0 + n; const double pc = 0.5 * ((double)p.pos[16 * nn] + (double)p.pos[16 * nn + 31]); float cs, sn; rope_cs(pc, d, cs, sn);
                const float x1 = OUTF[n * OP + d], x2 = OUTF[n * OP + d + 64]; KC[n * 128 + d] = (bf16_t)f2bf(x1 * cs - x2 * sn); KC[n * 128 + d + 64] = (bf16_t)f2bf(x2 * cs + x1 * sn); } }
    } else {
        bf16_t* VC = (bf16_t*)(ws + OFF_VC) + ((size_t)grp * 512 + n0) * 128;
#pragma unroll
        for (int e = 0; e < 4; ++e) { const int idx = tid + 512 * e, n = idx >> 7, d = idx & 127; VC[n * 128 + d] = (n0 + n >= NCMP) ? (bf16_t)0 : (bf16_t)f2bf(OUTF[n * OP + d]); }
    }
}

struct CmpF { int dq0; bool act;
    __device__ __forceinline__ bool relevant(int) const { return act; }
    __device__ __forceinline__ int dq(int t) const { return dq0 - 64 * t; }
    __device__ __forceinline__ unsigned W() const { return W_CAUSAL; }
    __device__ __forceinline__ bool en(int) const { return true; } };
__device__ __forceinline__ void cmp_unit(const Params& p, LAS unsigned char* lds, int u) {
    const int tid = threadIdx.x, lane = tid & 63, wave = __builtin_amdgcn_readfirstlane(tid >> 6), c = lane & 15, g = lane >> 4;
    const int qb = 511 - (u >> 1), grp = u & 1;
    unsigned char* ws = p.ws;
    constexpr int PP = 513;
    LAS float* Psum = (LAS float*)(lds + L_MISC);
    const int tw = 16 * qb, tq = tw + c;
    const bool act = wave < HG;
    const int h = HG * grp + (act ? wave : 0);
    for (int i = tid; i < 16 * PP; i += NTHREADS) Psum[i] = 0.f;
    __syncthreads();
    const int ncq = tq >= 31 ? (tq - 31) / 16 + 1 : 0;
    const int ncw = (tw + 15 >= 31) ? (tw + 15 - 31) / 16 + 1 : 0;
    const int nt = (ncw + 63) >> 6;
    QState st; q_load(st, (const bf16_t*)(ws + OFF_QN) + (size_t)tq * D_NSA + h * 128, g);
    TileSrc src{(const char*)(ws + OFF_KC) + (size_t)grp * 512 * 256, (const char*)(ws + OFF_VC) + (size_t)grp * 512 * 256, 256, 256};
    CmpF f{ncq - 1, act};
    attn_pass<false>(lds, src, 0, nt, st, f, tid, c, g);
    const float mfin = st.m, lt = group_sum(st.l), invl = lt > 0.f ? 1.f / lt : 0.f;
    if (nt > 0) {
        u32x4 r[4];
        tile_load(r, src, 0, tid); tile_store(lds, 0, r, tid); __syncthreads();
        for (int t = 0; t < nt; ++t) {
            const int buf = t & 1;
            if (t + 1 < nt) tile_load(r, src, 64 * (t + 1), tid);
            if (act) {
                f32x4 s[4]; qk_tile(s, lds + (buf ? L_K1 : L_K0), st, c, g); mask_tile(s, f.dq(t), W_CAUSAL, true, g);
#pragma unroll
                for (int T = 0; T < 4; ++T)
#pragma unroll
                    for (int rr = 0; rr < 4; ++rr) { const float e = fast_exp2(s[T][rr] - mfin) * invl; s[T][rr] = e;
                        const int kt = 32 * (T >> 1) + 8 * g + 4 * (T & 1) + rr;
                        __hip_atomic_fetch_add(Psum + c * PP + 64 * t + kt, e, __ATOMIC_RELAXED, __HIP_MEMORY_SCOPE_WORKGROUP); }
                pv_tile(s, lds + (buf ? L_V1 : L_V0), st, c, g);
            }
            if (t + 1 < nt) tile_store(lds, buf ^ 1, r, tid);
            __syncthreads();
        }
    }
    if (act) { const float g0 = ((const float*)(ws + OFF_GT))[(size_t)tq * 32 + h * 3 + 0];
        float* oc = (float*)(ws + OFF_HID + OV_OC) + (size_t)tq * D_NSA + h * 128 + 4 * g;
#pragma unroll
        for (int dt = 0; dt < 8; ++dt) *(f32x4*)(oc + 16 * dt) = st.o[dt] * g0; }
    for (int qi = 0; qi < 2; ++qi) {
        const int q = 2 * wave + qi, t = tw + q, cur = t >> 6;
        const LAS float* P = Psum + q * PP;
        float sc0, sc1;
        { const int jj = lane; float imp = 0.f;
#pragma unroll
          for (int n = 4 * jj - 1; n <= 4 * jj + 3; ++n) if (n >= 0 && n < NCMP) imp += P[n];
          const bool forced = (jj == 0) || (jj == cur) || (jj == cur - 1);
          sc0 = (jj <= cur) ? imp + (forced ? 1e4f : 0.f) : -1e30f; }
        { const int jj = lane + 64; float imp = 0.f;
#pragma unroll
          for (int n = 4 * jj - 1; n <= 4 * jj + 3; ++n) if (n >= 0 && n < NCMP) imp += P[n];
          const bool forced = (jj == cur) || (jj == cur - 1);
          sc1 = (jj <= cur) ? imp + (forced ? 1e4f : 0.f) : -1e30f; }
        unsigned long long mlo = 0ull, mhi = 0ull;
        for (int r = 0; r < 16; ++r) {
            const float mx = wave_max(fmaxf(sc0, sc1));
            if (!(mx > -1e29f)) break;
            const unsigned long long b0 = __ballot(sc0 == mx);
            if (b0) { const int idx = __builtin_ctzll(b0); mlo |= 1ull << idx; if (lane == idx) sc0 = -INFINITY; }
            else { const unsigned long long b1 = __ballot(sc1 == mx); const int idx = __builtin_ctzll(b1); mhi |= 1ull << idx; if (lane == idx) sc1 = -INFINITY; }
        }
        if (lane == 0) { u32x4 w; w.x = (unsigned)mlo; w.y = (unsigned)(mlo >> 32); w.z = (unsigned)mhi; w.w = (unsigned)(mhi >> 32);
            *(u32x4*)((unsigned*)(ws + OFF_HID + OV_SEL) + ((size_t)t * 2 + grp) * 4) = w; }
    }
}

struct WinF { int tq, tw;
    __device__ __forceinline__ bool relevant(int t) const { return 64 * t <= tw + 15 && 64 * t + 63 >= tw - 511; }
    __device__ __forceinline__ int dq(int t) const { return tq - 64 * t; }
    __device__ __forceinline__ unsigned W() const { return 512u; }
    __device__ __forceinline__ bool en(int) const { return true; } };
struct SlcF { int tq, tw; const LAS unsigned* selrow;
    __device__ __forceinline__ bool en(int t) const { return (selrow[t >> 5] >> (t & 31)) & 1u; }
    __device__ __forceinline__ bool relevant(int t) const { return 64 * t <= tw + 15 && __ballot(en(t)) != 0ull; }
    __device__ __forceinline__ int dq(int t) const { return tq - 64 * t; }
    __device__ __forceinline__ unsigned W() const { return W_CAUSAL; } };
__device__ __forceinline__ void slcwin_unit(const Params& p, LAS unsigned char* lds, int u) {
    const int tid = threadIdx.x, lane = tid & 63, wave = __builtin_amdgcn_readfirstlane(tid >> 6), c = lane & 15, g = lane >> 4;
    const int qb = 63 - u / NH_NSA, h = u % NH_NSA, grp = h / HG;
    unsigned char* ws = p.ws;
    const int tw = 128 * qb + 16 * wave, tq = tw + c;
    const float* GT = (const float*)(ws + OFF_GT) + (size_t)tq * 32 + h * 3;
    QState st; q_load(st, (const bf16_t*)(ws + OFF_QN) + (size_t)tq * D_NSA + h * 128, g);
    LAS unsigned* sel_lds = (LAS unsigned*)(lds + L_MISC);
    sel_lds[tid] = ((const unsigned*)(ws + OFF_HID + OV_SEL))[((size_t)(128 * qb + (tid >> 2)) * 2 + grp) * 4 + (tid & 3)];
    f32x4 res[8];
    { TileSrc src{(const char*)(ws + OFF_KW) + (size_t)grp * S * 256, (const char*)(ws + OFF_VW) + (size_t)grp * S * 256, 256, 256};
      WinF f{tq, tw};
      attn_pass<true>(lds, src, (2 * qb - 8) > 0 ? 2 * qb - 8 : 0, 2 * qb + 2, st, f, tid, c, g);
      const float sc = GT[2] / group_sum(st.l);
#pragma unroll
      for (int dt = 0; dt < 8; ++dt) res[dt] = st.o[dt] * sc; }
    q_reset(st);
    { TileSrc src{(const char*)(ws + OFF_KS) + (size_t)grp * S * 256, (const char*)(ws + OFF_VS) + (size_t)grp * S * 256, 256, 256};
      SlcF f{tq, tw, sel_lds + (16 * wave + c) * 4};
      attn_pass<true>(lds, src, 0, 2 * qb + 2, st, f, tid, c, g);
      const float sc = GT[1] / group_sum(st.l);
#pragma unroll
      for (int dt = 0; dt < 8; ++dt) res[dt] = res[dt] + st.o[dt] * sc; }
    const float* oc = (const float*)(ws + OFF_HID + OV_OC) + (size_t)tq * D_NSA + h * 128 + 4 * g;
    bf16_t* mx = (bf16_t*)(ws + OFF_XB) + (size_t)tq * DM + D_DIL + h * 128 + 4 * g;
#pragma unroll
    for (int dt = 0; dt < 8; ++dt) { const f32x4 o = res[dt] + *(const f32x4*)(oc + 16 * dt);
        u32x2 w; w.x = pg8::cvt_pk_bf16(o[0], o[1]); w.y = pg8::cvt_pk_bf16(o[2], o[3]); *(u32x2*)(mx + 16 * dt) = w; }
}
}


#ifndef NAIVE_COMPRESS
#define NAIVE_COMPRESS 0
#endif
#ifndef NAIVE_DIL
#define NAIVE_DIL 0
#endif
#ifndef NAIVE_NSA
#define NAIVE_NSA 0
#endif
__device__ __forceinline__ void phase_mix_a(const Params& p, LAS unsigned char* lds) {
#if NAIVE_COMPRESS
    compress_naive(p, lds);
#endif
#if NAIVE_DIL
    dilated_naive(p, lds);
#endif
#if !NAIVE_COMPRESS || !NAIVE_DIL
    unsigned* ctr = (unsigned*)(p.ws + OFF_CTL) + 0;
    constexpr int NC = NAIVE_COMPRESS ? 0 : 128, ND = NAIVE_DIL ? 0 : 1152;
    for (;;) { const int u = att::next_unit(ctr, lds); if (u >= NC + ND) break;
        if (u < NC) att::compress_unit(p, lds, u); else att::dil_unit(p, lds, u - NC); }
#endif
}
__device__ __forceinline__ void phase_mix_b(const Params& p, LAS unsigned char* lds) {
#if !NAIVE_NSA
    unsigned* ctr = (unsigned*)(p.ws + OFF_CTL) + 1;
    for (;;) { const int u = att::next_unit(ctr, lds); if (u >= 1024) break; att::cmp_unit(p, lds, u); }
#endif
#if !NAIVE_DIL
    att::dil_merge(p);
#endif
}
__device__ __forceinline__ void phase_mix_c(const Params& p, LAS unsigned char* lds) {
#if NAIVE_NSA
    nsa_naive(p, lds);
#else
    unsigned* ctr = (unsigned*)(p.ws + OFF_CTL) + 2;
    for (;;) { const int u = att::next_unit(ctr, lds); if (u >= 640) break; att::slcwin_unit(p, lds, u); }
#endif
}


#define XB_TMO      128
#define XB_XCNT(j)  (256  + 64 * (j))
#define XB_XSUB(j)  (1280 + 64 * (j))
#define XB_XGEN(j)  (2304 + 64 * (j))
#define XB_TOP      3328
#define XB_TOPGEN   3392
#define XCD_BAR_WORDS 3456
#define XB_SPIN_CAP (1u << 22)
constexpr int CW_BAR = 4096;
constexpr int L_BARST = 143376;
__device__ __forceinline__ unsigned xb_ld(unsigned* p)              { return __hip_atomic_load(p, __ATOMIC_RELAXED, __HIP_MEMORY_SCOPE_AGENT); }
__device__ __forceinline__ unsigned xb_add(unsigned* p, unsigned v) { return __hip_atomic_fetch_add(p, v, __ATOMIC_RELAXED, __HIP_MEMORY_SCOPE_AGENT); }
__device__ __forceinline__ unsigned xb_xcc_id() { return (unsigned)__builtin_amdgcn_s_getreg((3 << 11) | 20) & 0xFu; }
#define XB_SPIN(cond, bar) do { unsigned _sp = 0; while (cond) { __builtin_amdgcn_s_sleep(1); \
    if ((++_sp & 255u) == 0u) { if (xb_ld(&(bar)[XB_TMO])) break; if (_sp > XB_SPIN_CAP) { atomicAdd(&(bar)[XB_TMO], 1u); break; } } } } while (0)
struct XcdBarrier { unsigned* bar; unsigned x; volatile LAS unsigned* st; };
__device__ __forceinline__ XcdBarrier xcd_barrier_post(unsigned* bar, volatile LAS unsigned* st) {
    XcdBarrier b; b.bar = bar; b.x = xb_xcc_id(); b.st = st;
    if (threadIdx.x == 0) (void)xb_add(&bar[XB_XCNT(b.x)], 1u);
    return b;
}
__device__ __forceinline__ void xcd_barrier_complete(unsigned* bar, unsigned x, unsigned& nloc, unsigned& nx) {
    const unsigned G = gridDim.x * gridDim.y * gridDim.z;
    unsigned sum, cnt, mine, sp = 0u;
    for (;;) {
        sum = 0u; cnt = 0u; mine = 0u;
#pragma unroll
        for (unsigned j = 0; j < 16; ++j) { const unsigned c = xb_ld(&bar[XB_XCNT(j)]); sum += c; cnt += (c > 0u) ? 1u : 0u; mine = (j == x) ? c : mine; }
        if (sum == G) break;
        __builtin_amdgcn_s_sleep(1);
        if ((++sp & 255u) == 0u) { if (xb_ld(&bar[XB_TMO])) break; if (sp > XB_SPIN_CAP) { atomicAdd(&bar[XB_TMO], 1u); break; } }
    }
    nloc = mine > 0u ? mine : 1u; nx = cnt > 0u ? cnt : 1u;
}
__device__ __forceinline__ void xcd_barrier(const XcdBarrier& b) {
    asm volatile("s_waitcnt vmcnt(0)" ::: "memory");
    __syncthreads();
    if (threadIdx.x == 0) {
        unsigned* bar = b.bar;
        __builtin_amdgcn_s_waitcnt(0);
        unsigned nloc = b.st[0], nx = b.st[1];
        if (nloc == 0u) { xcd_barrier_complete(bar, b.x, nloc, nx); b.st[0] = nloc; b.st[1] = nx; }
        const unsigned old = xb_add(&bar[XB_XSUB(b.x)], 1u);
        const unsigned gen = old / nloc;
        if (old + 1u == (gen + 1u) * nloc) {
            __builtin_amdgcn_fence(__ATOMIC_RELEASE, "agent");
            asm volatile("s_waitcnt vmcnt(0)" ::: "memory");
            const unsigned og = xb_add(&bar[XB_TOP], 1u);
            const unsigned tg = og / nx;
            if (og + 1u == (tg + 1u) * nx) xb_add(&bar[XB_TOPGEN], 1u);
            else XB_SPIN(xb_ld(&bar[XB_TOPGEN]) == tg, bar);
            __builtin_amdgcn_fence(__ATOMIC_ACQUIRE, "agent");
            xb_add(&bar[XB_XGEN(b.x)], 1u);
            asm volatile("s_waitcnt vmcnt(0)" ::: "memory");
        } else {
            XB_SPIN(xb_ld(&bar[XB_XGEN(b.x)]) == gen, bar);
            __builtin_amdgcn_fence(__ATOMIC_ACQUIRE, "agent");
            asm volatile("s_waitcnt vmcnt(0)" ::: "memory");
        }
    }
    __syncthreads();
}

constexpr int N_PHASES = 13;
__global__ void __launch_bounds__(NTHREADS, 2) fwd_kernel(Params p) {
    extern __shared__ __attribute__((aligned(16))) unsigned char lds_raw[];
    LAS unsigned char* lds = (LAS unsigned char*)lds_raw;
    cg::grid_group grid = cg::this_grid();
    unsigned char* ws = p.ws;
    bf16_t* XB = (bf16_t*)(ws + OFF_XB); bf16_t* HID = (bf16_t*)(ws + OFF_HID);
    const int lo = p.ph_lo, hi = p.ph_hi;
    if (threadIdx.x < 2) ((volatile LAS unsigned*)(lds + L_BARST))[threadIdx.x] = 0u;
    __syncthreads();
    XcdBarrier bar; bar.bar = nullptr; bar.x = 0; bar.st = nullptr; bool bar_up = false;
#define IN(k) (lo <= (k) && (k) < hi)
#define SEAM(k) do { if (IN(k) && IN((k) + 1)) { if (!bar_up) { grid.sync(); bar = xcd_barrier_post((unsigned*)(ws + OFF_CTL) + CW_BAR, (volatile LAS unsigned*)(lds + L_BARST)); bar_up = true; } else xcd_barrier(bar); } } while (0)
    if (IN(0)) { p0_prologue(p, lds); }
    SEAM(0);
    if (IN(1)) { pg8::Gemm g{XB, (const bf16_t*)(ws + OFF_W13A), S, 2 * DFF, DM}; pg8::StaticOrder so; so.init(S, 2 * DFF, gridDim.x, blockIdx.x);
        pg8::EpiSwiglu E{HID}; pg8::gemm_phase<pg8::EpiSwiglu, pg8::StaticOrder, true, true>(lds, g, so, E); }
    SEAM(1);
    if (IN(2)) { pg8::Gemm g{HID, (const bf16_t*)(ws + OFF_W2A), S, DM, DFF}; pg8::StaticOrder so; so.init(S, DM, gridDim.x, blockIdx.x);
        pg8::EpiResid E{p.x, p.out, ALPHA, 0.5f}; pg8::gemm_phase<pg8::EpiResid, pg8::StaticOrder, true, true>(lds, g, so, E); }
    SEAM(2);
    if (IN(3)) { ln_phase(p.out, p.out, XB, p.ln1g, p.ln1b); }
    SEAM(3);
    if (IN(4)) { pg8::Gemm g{XB, (const bf16_t*)(ws + OFF_WIN), S, IN_PAD, DM}; pg8::StaticOrder so; so.init(S, IN_PAD, gridDim.x, blockIdx.x);
        pg8::EpiInProj E{(bf16_t*)(ws + OFF_QA), (bf16_t*)(ws + OFF_KA), (bf16_t*)(ws + OFF_VA), (bf16_t*)(ws + OFF_QN), (bf16_t*)(ws + OFF_KS), (bf16_t*)(ws + OFF_VS),
                         (bf16_t*)(ws + OFF_KW), (bf16_t*)(ws + OFF_VW), (float*)(ws + OFF_KCT), (float*)(ws + OFF_VCT), (float*)(ws + OFF_GT),
                         (const float*)(ws + OFF_ROPE), (const float*)(ws + OFF_ROPE) + (size_t)S * 64, p.gateb};
        pg8::gemm_phase<pg8::EpiInProj, pg8::StaticOrder, true, true>(lds, g, so, E); }
    SEAM(4);
    if (IN(5)) { phase_mix_a(p, lds); }
    SEAM(5);
    if (IN(6)) { phase_mix_b(p, lds); }
    SEAM(6);
    if (IN(7)) { phase_mix_c(p, lds); }
    SEAM(7);
    if (IN(8)) { pg8::Gemm g{XB, (const bf16_t*)(ws + OFF_WOUT), S, DM, DM}; pg8::StaticOrder so; so.init(S, DM, gridDim.x, blockIdx.x);
        pg8::EpiResid E{p.out, p.out, ALPHA, 1.0f}; pg8::gemm_phase<pg8::EpiResid, pg8::StaticOrder, true, true>(lds, g, so, E); }
    SEAM(8);
    if (IN(9)) { ln_phase(p.out, p.out, XB, p.ln2g, p.ln2b); }
    SEAM(9);
    if (IN(10)) { pg8::Gemm g{XB, (const bf16_t*)(ws + OFF_W13B), S, 2 * DFF, DM}; pg8::StaticOrder so; so.init(S, 2 * DFF, gridDim.x, blockIdx.x);
        pg8::EpiSwiglu E{HID}; pg8::gemm_phase<pg8::EpiSwiglu, pg8::StaticOrder, true, true>(lds, g, so, E); }
    SEAM(10);
    if (IN(11)) { pg8::Gemm g{HID, (const bf16_t*)(ws + OFF_W2B), S, DM, DFF}; pg8::StaticOrder so; so.init(S, DM, gridDim.x, blockIdx.x);
        pg8::EpiResid E{p.out, p.out, ALPHA, 0.5f}; pg8::gemm_phase<pg8::EpiResid, pg8::StaticOrder, true, true>(lds, g, so, E); }
    SEAM(11);
    if (IN(12)) { ln_phase(p.out, p.out, nullptr, p.ln3g, p.ln3b); }
#undef IN
#undef SEAM
}

extern "C" void kernel_launch(void* const* d_in, const int* in_sizes, int n_in, void* d_out, int out_size, void* d_ws, size_t ws_size, hipStream_t stream) {
    static int grid = 0;
    if (grid == 0) {
        if (n_in != 22 || in_sizes[0] != S * DM || out_size != S * DM || ws_size < WS_END) {
            fprintf(stderr, "kernel_launch: unexpected shapes: n_in %d in0 %d out %d ws %zu (need >= %zu)\n", n_in, n_in > 0 ? in_sizes[0] : -1, out_size, ws_size, (size_t)WS_END); grid = -1; return; }
        int dev = 0, cus = 0, per_cu = 0;
        if (hipGetDevice(&dev) != hipSuccess || hipDeviceGetAttribute(&cus, hipDeviceAttributeMultiprocessorCount, dev) != hipSuccess) { fprintf(stderr, "kernel_launch: device query failed\n"); grid = -1; return; }
        if (hipFuncSetAttribute((const void*)fwd_kernel, hipFuncAttributeMaxDynamicSharedMemorySize, LDS_BYTES) != hipSuccess) { fprintf(stderr, "kernel_launch: hipFuncSetAttribute failed\n"); grid = -1; return; }
        if (hipOccupancyMaxActiveBlocksPerMultiprocessor(&per_cu, (const void*)fwd_kernel, NTHREADS, LDS_BYTES) != hipSuccess || per_cu < 1) { fprintf(stderr, "kernel_launch: occupancy query gave %d\n", per_cu); per_cu = 1; }
        (void)hipGetLastError();
        grid = cus;
    }
    if (grid < 0) return;
    Params p{};
    p.x = (const float*)d_in[0]; p.pos = (const int*)d_in[1];
    p.ln1g = (const float*)d_in[2]; p.ln1b = (const float*)d_in[3]; p.f1w1 = (const float*)d_in[4]; p.f1w3 = (const float*)d_in[5]; p.f1w2 = (const float*)d_in[6];
    p.win = (const float*)d_in[7]; p.gateb = (const float*)d_in[8]; p.cpe = (const float*)d_in[9]; p.cw1 = (const float*)d_in[10]; p.cb1 = (const float*)d_in[11];
    p.cw2 = (const float*)d_in[12]; p.cb2 = (const float*)d_in[13]; p.wout = (const float*)d_in[14]; p.ln2g = (const float*)d_in[15]; p.ln2b = (const float*)d_in[16];
    p.f2w1 = (const float*)d_in[17]; p.f2w3 = (const float*)d_in[18]; p.f2w2 = (const float*)d_in[19]; p.ln3g = (const float*)d_in[20]; p.ln3b = (const float*)d_in[21];
    p.out = (float*)d_out; p.ws = (unsigned char*)d_ws;
#if N_LAUNCH_PER_PHASE
    for (int k = 0; k < N_PHASES; ++k) {
        p.ph_lo = k; p.ph_hi = k + 1;
        void* args[] = {&p};
        hipError_t e = hipLaunchCooperativeKernel((const void*)fwd_kernel, dim3(grid), dim3(NTHREADS), args, LDS_BYTES, stream);
        if (e != hipSuccess) { fprintf(stderr, "kernel_launch: launch of phase %d failed: %s\n", k, hipGetErrorString(e)); break; }
    }
#else
    p.ph_lo = 0; p.ph_hi = N_PHASES;
    void* args[] = {&p};
    hipError_t e = hipLaunchCooperativeKernel((const void*)fwd_kernel, dim3(grid), dim3(NTHREADS), args, LDS_BYTES, stream);
    if (e != hipSuccess) fprintf(stderr, "kernel_launch: cooperative launch failed: %s (grid %d)\n", hipGetErrorString(e), grid);
#endif
}
```

```cpp
#include <hip/hip_runtime.h>
#include <hip/hip_cooperative_groups.h>
#include <cstdio>
#include <cstdint>
namespace cg = cooperative_groups;

#ifndef PROBE_REP_MASK
#define PROBE_REP_MASK 0
#endif
#ifndef N_LAUNCH_PER_PHASE
#define N_LAUNCH_PER_PHASE 0
#endif

#define LAS __attribute__((address_space(3)))
typedef unsigned short bf16_t;
typedef short bf16x8 __attribute__((ext_vector_type(8)));
typedef float f32x4 __attribute__((ext_vector_type(4)));
typedef float f32x2 __attribute__((ext_vector_type(2)));
typedef unsigned u32x4 __attribute__((ext_vector_type(4)));
typedef unsigned u32x2 __attribute__((ext_vector_type(2)));

constexpr int S = 8192, DM = 2048, DFF = 5632, HD = 128;
constexpr int NH_DIL = 6, NH_NSA = 10, NG = 2, HG = 5;
constexpr int D_DIL = 768, D_NSA = 1280;
constexpr int IN_COLS = 5150, IN_PAD = 5376;
constexpr int NCMP = 511;
constexpr float LN_EPS = 1e-5f;
constexpr float ALPHA = 1.189207115002721f;
constexpr float QSCALE = 0.08838834764831845f * 1.4426950408889634f;
constexpr int NTHREADS = 512, NWAVES = 8;

constexpr size_t MiB = 1u << 20;
constexpr size_t OFF_CTL = 0;
constexpr size_t OFF_W13A = 1 * MiB, OFF_W2A = 45 * MiB, OFF_W13B = 67 * MiB, OFF_W2B = 111 * MiB;
constexpr size_t OFF_WIN = 133 * MiB, OFF_WOUT = 154 * MiB, OFF_CW1T = 162 * MiB, OFF_CW2T = 166 * MiB;
constexpr size_t OFF_ROPE = 167 * MiB;
constexpr size_t OFF_XB = 171 * MiB;
constexpr size_t OFF_HID = 203 * MiB;
constexpr size_t OFF_QA = 291 * MiB, OFF_KA = 303 * MiB, OFF_VA = 315 * MiB, OFF_QN = 327 * MiB;
constexpr size_t OFF_KCT = 347 * MiB, OFF_VCT = 355 * MiB;
constexpr size_t OFF_KS = 363 * MiB, OFF_VS = 367 * MiB, OFF_KW = 371 * MiB, OFF_VW = 375 * MiB;
constexpr size_t OFF_GT = 379 * MiB;
constexpr size_t OFF_KC = 380 * MiB;
constexpr size_t OFF_VC = OFF_KC + 256 * 1024;
constexpr size_t WS_END = 381 * MiB;

constexpr int LDS_BYTES = 147456;
constexpr int XCD_BAR_WORDS_C = 3456, CW_BAR_C = 4096;

__constant__ double INV_FREQ[64] = {
1.0, 0.8659643233600653, 0.7498942093324559, 0.6493816315762113,
0.5623413251903491, 0.4869675251658631, 0.4216965034285822, 0.3651741272548377,
0.31622776601683794, 0.27384196342643613, 0.23713737056616552, 0.2053525026457146,
0.1778279410038923, 0.1539926526059492, 0.1333521432163324, 0.11547819846894582,
0.1, 0.08659643233600653, 0.07498942093324558, 0.06493816315762113,
0.05623413251903491, 0.04869675251658631, 0.042169650342858224, 0.03651741272548377,
0.03162277660168379, 0.027384196342643614, 0.023713737056616554, 0.02053525026457146,
0.01778279410038923, 0.01539926526059492, 0.01333521432163324, 0.011547819846894581,
0.01, 0.008659643233600654, 0.007498942093324558, 0.006493816315762113,
0.005623413251903491, 0.004869675251658631, 0.004216965034285823, 0.003651741272548377,
0.0031622776601683794, 0.0027384196342643613, 0.0023713737056616554, 0.002053525026457146,
0.0017782794100389228, 0.001539926526059492, 0.001333521432163324, 0.0011547819846894581,
0.001, 0.0008659643233600654, 0.0007498942093324559, 0.0006493816315762113,
0.0005623413251903491, 0.0004869675251658631, 0.00042169650342858224, 0.0003651741272548377,
0.00031622776601683794, 0.0002738419634264361, 0.00023713737056616554, 0.0002053525026457146,
0.00017782794100389227, 0.0001539926526059492, 0.0001333521432163324, 0.00011547819846894582 };

__device__ __forceinline__ unsigned f2bf(float f) { unsigned u = __builtin_bit_cast(unsigned, f); return (u + 0x7fffu + ((u >> 16) & 1u)) >> 16; }
__device__ __forceinline__ unsigned pk2(float lo, float hi) { return f2bf(lo) | (f2bf(hi) << 16); }
__device__ __forceinline__ float bflo(unsigned u) { return __uint_as_float(u << 16); }
__device__ __forceinline__ float bfhi(unsigned u) { return __uint_as_float(u & 0xffff0000u); }
__device__ __forceinline__ float wave_sum(float v) {
#pragma unroll
    for (int o = 1; o < 64; o <<= 1) v += __shfl_xor(v, o);
    return v;
}
__device__ __forceinline__ float wave_max(float v) {
#pragma unroll
    for (int o = 1; o < 64; o <<= 1) v = fmaxf(v, __shfl_xor(v, o));
    return v;
}
__device__ __forceinline__ float fast_exp2(float x) { return __builtin_amdgcn_exp2f(x); }
__device__ __forceinline__ float fast_rcp(float x) { return __builtin_amdgcn_rcpf(x); }
__device__ __forceinline__ void rope_cs(double pos, int i, float& c, float& s) {
    const double rev = pos * INV_FREQ[i] * 0.15915494309189535;
    const double fr = rev - __builtin_rint(rev);
    const float f = (float)fr;
    c = __builtin_amdgcn_cosf(f); s = __builtin_amdgcn_sinf(f);
}

namespace pg8 {
constexpr int BM = 256, BK = 64, HALF = 128, HTB = HALF * BK * 2, STAGE_BYTES = 8 * HTB, NXCD = 8, WGM = 8;
__host__ __device__ __forceinline__ int lds_byte(int r, int c) { const int st = (r >> 4) * 2 + (c >> 5), rr = r & 15, cc = c & 31, ob = rr * 64 + cc * 2; return st * 1024 + (ob ^ (((ob >> 9) & 1) << 5)); }
__host__ __device__ __forceinline__ void stage_rc(int b, int& R, int& C) { const int st = b / 1024, sb = b % 1024, swz = sb ^ (((sb >> 9) & 1) << 5); R = (st >> 1) * 16 + swz / 64; C = (st & 1) * 32 + (swz % 64) / 2; }
__host__ __device__ __forceinline__ int perm32(int rho) { const int n = rho >> 4, i = rho & 15; return 8 * (i >> 2) + 4 * n + (i & 3); }
struct Unit { int pm, pn; };
struct Gemm { const bf16_t* A; const bf16_t* Bt; int M, N, K; };
struct StaticOrder {
    int nM, nN, nwg, G, c;
    __host__ __device__ void init(int M, int N, int G_, int c_) { nM = M / BM; nN = N / BM; nwg = nM * nN; G = G_; c = c_; }
    __host__ __device__ bool next(int i, Unit& u) const {
        const long L = (long)i * G + c; if (L >= nwg) return false;
        int wgid = (int)L; { const int q = nwg / NXCD, r = nwg % NXCD, xcd = wgid % NXCD, off = wgid / NXCD; wgid = (xcd < r ? xcd * (q + 1) : r * (q + 1) + (xcd - r) * q) + off; }
        const int nig = WGM * nN, gid = wgid / nig, fm = gid * WGM, gsz = (nM - fm) < WGM ? (nM - fm) : WGM;
        u.pm = fm + ((wgid % nig) % gsz); u.pn = (wgid % nig) / gsz; return true;
    }
    __device__ __forceinline__ void a_ready(const Unit&) const {}
    __device__ __forceinline__ void done(const Unit&) const {}
};
__device__ __forceinline__ unsigned cvt_pk_bf16(float lo, float hi) { unsigned r; asm volatile("v_cvt_pk_bf16_f32 %0, %1, %2" : "=v"(r) : "v"(lo), "v"(hi)); return r; }

template <class Epi, class Sched, bool ALIGN_EPI = false, bool SP2 = false>
__device__ __forceinline__ void gemm_phase(LAS unsigned char* lds, const Gemm g, const Sched& S, const Epi& E) {
    const int tid = threadIdx.x, wid = __builtin_amdgcn_readfirstlane(tid >> 6), lane = tid & 63, wr = wid >> 2, wc = wid & 3, fr = lane & 15, fq = lane >> 4;
    const int K = g.K, nt = K / BK;
    unsigned voffA[2], voffB[2];
#pragma unroll
    for (int i = 0; i < 2; ++i) { int R, C; stage_rc(tid * 16 + i * 8192, R, C); const int Rb = Epi::PERM ? ((R & ~31) + perm32(R & 31)) : R;
        voffA[i] = (unsigned)(R * K + C) * 2u; voffB[i] = (unsigned)(Rb * K + C) * 2u; }
    const size_t kstep = (size_t)(BK * 2);
    const size_t hstep = (size_t)HALF * K * 2;
    const size_t tstep = 2 * hstep;
    const unsigned ldsw = (unsigned)wid * 1024u;
    const int aoff = lds_byte(wr * 64 + fr, fq * 8), boff = lds_byte(wc * 32 + fr, fq * 8);
#define PG8_SA(b, h) (((b) * 2 + (h)) * HTB)
#define PG8_SB(b, h) ((4 + (b) * 2 + (h)) * HTB)
#define PG8_STAGE(bufoff, gbase, voff) do { _Pragma("unroll") for (int _i = 0; _i < 2; ++_i) \
        __builtin_amdgcn_global_load_lds((const unsigned*)((const char*)(gbase) + (voff)[_i]), (LAS unsigned*)(lds + (bufoff) + ldsw + _i * 8192), 16, 0, 0); } while (0)
#define PG8_LDA(dst, b, h) do { _Pragma("unroll") for (int m = 0; m < 4; ++m) _Pragma("unroll") for (int k = 0; k < 2; ++k) dst[m][k] = *(const LAS bf16x8*)(lds + PG8_SA(b, h) + aoff + m * 2048 + k * 1024); } while (0)
#define PG8_LDB(dst, b, h) do { _Pragma("unroll") for (int n = 0; n < 2; ++n) _Pragma("unroll") for (int k = 0; k < 2; ++k) dst[n][k] = *(const LAS bf16x8*)(lds + PG8_SB(b, h) + boff + n * 2048 + k * 1024); } while (0)
#define PG8_MMA(ai, bj, At, Bt) do { __builtin_amdgcn_s_setprio(1); _Pragma("unroll") for (int m = 0; m < 4; ++m) _Pragma("unroll") for (int n = 0; n < 2; ++n) _Pragma("unroll") for (int k = 0; k < 2; ++k) \
        acc[ai][bj][m][n] = __builtin_amdgcn_mfma_f32_16x16x32_bf16(Bt[n][k], At[m][k], acc[ai][bj][m][n], 0, 0, 0); __builtin_amdgcn_s_setprio(0); } while (0)
#define PG8_WAIT_V(n) asm volatile("s_waitcnt vmcnt(" #n ")" ::: "memory")
#define PG8_WAIT_L(n) asm volatile("s_waitcnt lgkmcnt(" #n ")" ::: "memory")
#define PG8_BAR __builtin_amdgcn_s_barrier()
#define PG8_SCHED __builtin_amdgcn_sched_barrier(0)
    Unit cur, nxt; int ui = 0;
    if (!S.next(0, cur)) return;
    f32x4 acc[2][2][4][2];
#pragma unroll
    for (int a = 0; a < 2; ++a)
#pragma unroll
        for (int b = 0; b < 2; ++b)
#pragma unroll
            for (int m = 0; m < 4; ++m)
#pragma unroll
                for (int n = 0; n < 2; ++n) acc[a][b][m][n] = (f32x4){0.f, 0.f, 0.f, 0.f};
    bf16x8 At[4][2], B0[2][2], B1[2][2];
    const char* cA = (const char*)g.A + (size_t)cur.pm * tstep; const char* cB = (const char*)g.Bt + (size_t)cur.pn * tstep;
    S.a_ready(cur);
    if constexpr (SP2) {
        PG8_STAGE(PG8_SB(0, 0), cB, voffB); PG8_STAGE(PG8_SB(0, 1), cB + hstep, voffB); PG8_STAGE(PG8_SA(0, 0), cA, voffA); PG8_STAGE(PG8_SA(0, 1), cA + hstep, voffA);
        if (wr == 1) PG8_BAR;
        PG8_WAIT_V(2); PG8_BAR;
        PG8_STAGE(PG8_SB(1, 0), cB + kstep, voffB); PG8_STAGE(PG8_SA(1, 0), cA + kstep, voffA); PG8_STAGE(PG8_SB(1, 1), cB + hstep + kstep, voffB);
        PG8_WAIT_V(6); PG8_BAR;
    } else {
        PG8_STAGE(PG8_SB(0, 0), cB, voffB); PG8_STAGE(PG8_SA(0, 0), cA, voffA); PG8_STAGE(PG8_SB(0, 1), cB + hstep, voffB); PG8_STAGE(PG8_SA(0, 1), cA + hstep, voffA);
        if (wr == 1) PG8_BAR;
        PG8_WAIT_V(4); PG8_BAR;
        PG8_STAGE(PG8_SB(1, 0), cB + kstep, voffB); PG8_STAGE(PG8_SA(1, 0), cA + kstep, voffA); PG8_STAGE(PG8_SB(1, 1), cB + hstep + kstep, voffB);
        PG8_WAIT_V(6); PG8_BAR;
    }
    for (;;) {
        const bool has_next = S.next(ui + 1, nxt);
        const char* nA = has_next ? (const char*)g.A + (size_t)nxt.pm * tstep : cA; const char* nB = has_next ? (const char*)g.Bt + (size_t)nxt.pn * tstep : cB;
        for (int t = 0; t < nt; t += 2) {
            const bool last = (t == nt - 2);
            const char* a1 = cA + (size_t)(t + 1) * kstep;
            const char* a2 = last ? nA : cA + (size_t)(t + 2) * kstep; const char* b2 = last ? nB : cB + (size_t)(t + 2) * kstep;
            const char* a3 = a2 + kstep; const char* b3 = b2 + kstep;
            if (last && has_next) S.a_ready(nxt);
            if constexpr (SP2) {
            PG8_LDB(B0, 0, 0); PG8_LDB(B1, 0, 1); PG8_SCHED; PG8_LDA(At, 0, 0); PG8_STAGE(PG8_SA(1, 1), a1 + hstep, voffA);
            PG8_WAIT_V(8); PG8_WAIT_L(0); PG8_BAR; PG8_MMA(0, 0, At, B0); PG8_MMA(0, 1, At, B1); PG8_BAR; PG8_SCHED;
            PG8_LDA(At, 0, 1); PG8_STAGE(PG8_SB(0, 0), b2, voffB); PG8_STAGE(PG8_SB(0, 1), b2 + hstep, voffB); PG8_STAGE(PG8_SA(0, 0), a2, voffA);
            PG8_WAIT_V(8); PG8_WAIT_L(0); PG8_BAR; PG8_MMA(1, 0, At, B0); PG8_MMA(1, 1, At, B1); PG8_BAR; PG8_SCHED;
            PG8_LDB(B0, 1, 0); PG8_LDB(B1, 1, 1); PG8_SCHED; PG8_LDA(At, 1, 0); PG8_STAGE(PG8_SA(0, 1), a2 + hstep, voffA);
            PG8_WAIT_V(8); PG8_WAIT_L(0); PG8_BAR; PG8_MMA(0, 0, At, B0); PG8_MMA(0, 1, At, B1); PG8_BAR; PG8_SCHED;
            PG8_LDA(At, 1, 1); PG8_STAGE(PG8_SB(1, 0), b3, voffB); PG8_STAGE(PG8_SB(1, 1), b3 + hstep, voffB); PG8_STAGE(PG8_SA(1, 0), a3, voffA);
            PG8_WAIT_V(8); PG8_WAIT_L(0); PG8_BAR; PG8_MMA(1, 0, At, B0); PG8_MMA(1, 1, At, B1); PG8_BAR; PG8_SCHED;
            } else {
            PG8_LDB(B0, 0, 0); PG8_SCHED; PG8_LDA(At, 0, 0); PG8_STAGE(PG8_SA(1, 1), a1 + hstep, voffA);
            PG8_WAIT_L(8); PG8_BAR; PG8_WAIT_L(0); PG8_MMA(0, 0, At, B0); PG8_BAR; PG8_SCHED;
            PG8_LDB(B1, 0, 1); PG8_STAGE(PG8_SB(0, 0), b2, voffB);
            PG8_BAR; PG8_WAIT_L(0); PG8_MMA(0, 1, At, B1); PG8_BAR;
            PG8_LDA(At, 0, 1); PG8_STAGE(PG8_SA(0, 0), a2, voffA);
            PG8_BAR; PG8_WAIT_L(0); PG8_MMA(1, 0, At, B0); PG8_BAR; PG8_SCHED;
            PG8_STAGE(PG8_SB(0, 1), b2 + hstep, voffB);
            PG8_WAIT_V(6); PG8_BAR; PG8_MMA(1, 1, At, B1); PG8_BAR;
            PG8_LDB(B0, 1, 0); PG8_SCHED; PG8_LDA(At, 1, 0); PG8_STAGE(PG8_SA(0, 1), a2 + hstep, voffA);
            PG8_WAIT_L(8); PG8_BAR; PG8_WAIT_L(0); PG8_MMA(0, 0, At, B0); PG8_BAR; PG8_SCHED;
            PG8_LDB(B1, 1, 1); PG8_STAGE(PG8_SB(1, 0), b3, voffB);
            PG8_BAR; PG8_WAIT_L(0); PG8_MMA(0, 1, At, B1); PG8_BAR;
            PG8_LDA(At, 1, 1); PG8_STAGE(PG8_SA(1, 0), a3, voffA);
            PG8_BAR; PG8_WAIT_L(0); PG8_MMA(1, 0, At, B0); PG8_BAR; PG8_SCHED;
            PG8_STAGE(PG8_SB(1, 1), b3 + hstep, voffB);
            PG8_WAIT_V(6); PG8_BAR; PG8_MMA(1, 1, At, B1); PG8_BAR;
            }
        }
        if constexpr (ALIGN_EPI) { if (wr == 0) PG8_BAR; }
        E(acc, cur, wr, wc, fr, fq);
        if (!has_next) break;
#pragma unroll
        for (int a = 0; a < 2; ++a)
#pragma unroll
            for (int b = 0; b < 2; ++b)
#pragma unroll
                for (int m = 0; m < 4; ++m)
#pragma unroll
                    for (int n = 0; n < 2; ++n) acc[a][b][m][n] = (f32x4){0.f, 0.f, 0.f, 0.f};
        cur = nxt; cA = nA; cB = nB; ++ui;
        if constexpr (ALIGN_EPI) { if (wr == 1) PG8_BAR; }
    }
    PG8_WAIT_V(0);
    if constexpr (!ALIGN_EPI) { if (wr == 0) PG8_BAR; }
    PG8_BAR;
#undef PG8_SA
#undef PG8_SB
#undef PG8_STAGE
#undef PG8_LDA
#undef PG8_LDB
#undef PG8_MMA
#undef PG8_WAIT_V
#undef PG8_WAIT_L
#undef PG8_BAR
#undef PG8_SCHED
}

struct EpiSwiglu {
    static constexpr bool PERM = true;
    bf16_t* H;
    __device__ __forceinline__ void operator()(const f32x4 (&acc)[2][2][4][2], const Unit& u, int wr, int wc, int fr, int fq) const {
        const int row0 = u.pm * BM + wr * 64 + fr, col0 = u.pn * HALF + wc * 32 + 8 * fq;
#pragma unroll
        for (int ai = 0; ai < 2; ++ai)
#pragma unroll
            for (int m = 0; m < 4; ++m) {
                bf16_t* rowp = H + (size_t)(row0 + ai * HALF + m * 16) * DFF + col0;
                float o[8];
#pragma unroll
                for (int n = 0; n < 2; ++n)
#pragma unroll
                    for (int j = 0; j < 4; ++j) { const float a = acc[ai][0][m][n][j], b = acc[ai][1][m][n][j];
                        const float sg = fast_rcp(1.0f + fast_exp2(-1.4426950408889634f * a)); o[n * 4 + j] = a * sg * b; }
                u32x4 w; w.x = cvt_pk_bf16(o[0], o[1]); w.y = cvt_pk_bf16(o[2], o[3]); w.z = cvt_pk_bf16(o[4], o[5]); w.w = cvt_pk_bf16(o[6], o[7]);
                *(u32x4*)rowp = w;
            }
    }
};
struct EpiResid {
    static constexpr bool PERM = false;
    const float* resid; float* out; float alpha, beta;
    __device__ __forceinline__ void operator()(const f32x4 (&acc)[2][2][4][2], const Unit& u, int wr, int wc, int fr, int fq) const {
        const int col0 = u.pn * BM + wc * 32 + 4 * fq;
#pragma unroll
        for (int ai = 0; ai < 2; ++ai)
#pragma unroll
            for (int m = 0; m < 4; ++m) { const size_t off = (size_t)(u.pm * BM + ai * HALF + wr * 64 + m * 16 + fr) * DM + col0;
#pragma unroll
                for (int bj = 0; bj < 2; ++bj)
#pragma unroll
                    for (int n = 0; n < 2; ++n) { const size_t c = off + bj * HALF + n * 16; const f32x4 r = *(const f32x4*)(resid + c);
                        *(f32x4*)(out + c) = r * alpha + acc[ai][bj][m][n] * beta; } }
    }
};
struct EpiInProj {
    static constexpr bool PERM = false;
    bf16_t *QA, *KA, *VA, *QN, *KS, *VS, *KW, *VW; float *KCT, *VCT, *GT; const float *cosT, *sinT, *gateb;
    __device__ __forceinline__ void operator()(const f32x4 (&acc)[2][2][4][2], const Unit& u, int wr, int wc, int fr, int fq) const {
        const int pn = u.pn;
        const int d0 = 16 * wc + 4 * fq;
        if (pn == 20) {
#pragma unroll
            for (int ai = 0; ai < 2; ++ai)
#pragma unroll
                for (int m = 0; m < 4; ++m) { const int row = u.pm * BM + ai * HALF + wr * 64 + m * 16 + fr;
#pragma unroll
                    for (int j = 0; j < 4; ++j) { const int gc = d0 + j; if (gc < 30) { const float v = acc[ai][0][m][0][j] + gateb[gc]; GT[(size_t)row * 32 + gc] = fast_rcp(1.0f + fast_exp2(-1.4426950408889634f * v)); } } }
            return;
        }
        bool rope = false, isf32 = false; float sc = 1.f; bf16_t* bb = nullptr; float* fb = nullptr; int pitch = 128; size_t bjs = (size_t)S * 128; int colbase = 0;
        if (pn < 3)       { rope = true; sc = QSCALE; bb = QA; pitch = D_DIL; bjs = 128; colbase = 256 * pn; }
        else if (pn < 6)  { rope = true; bb = KA; pitch = D_DIL; bjs = 128; colbase = 256 * (pn - 3); }
        else if (pn < 9)  { bb = VA; pitch = D_DIL; bjs = 128; colbase = 256 * (pn - 6); }
        else if (pn < 14) { rope = true; sc = QSCALE; bb = QN; pitch = D_NSA; bjs = 128; colbase = 256 * (pn - 9); }
        else if (pn == 14) { isf32 = true; fb = KCT; }
        else if (pn == 15) { isf32 = true; fb = VCT; }
        else if (pn == 16) { rope = true; bb = KS; }
        else if (pn == 17) { bb = VS; }
        else if (pn == 18) { rope = true; bb = KW; }
        else               { bb = VW; }
#pragma unroll
        for (int ai = 0; ai < 2; ++ai)
#pragma unroll
            for (int m = 0; m < 4; ++m) {
                const int row = u.pm * BM + ai * HALF + wr * 64 + m * 16 + fr;
                f32x4 cs = (f32x4){1.f, 1.f, 1.f, 1.f}, sn = (f32x4){0.f, 0.f, 0.f, 0.f};
                if (rope) { cs = *(const f32x4*)(cosT + (size_t)row * 64 + d0); sn = *(const f32x4*)(sinT + (size_t)row * 64 + d0); }
#pragma unroll
                for (int bj = 0; bj < 2; ++bj) {
                    const f32x4 x1 = acc[ai][bj][m][0], x2 = acc[ai][bj][m][1];
                    const f32x4 o1 = (x1 * cs - x2 * sn) * sc, o2 = (x2 * cs + x1 * sn) * sc;
                    const size_t off = (size_t)row * pitch + bj * bjs + colbase + d0;
                    if (isf32) { *(f32x4*)(fb + off) = o1; *(f32x4*)(fb + off + 64) = o2; }
                    else { u32x2 w1, w2; w1.x = cvt_pk_bf16(o1[0], o1[1]); w1.y = cvt_pk_bf16(o1[2], o1[3]); w2.x = cvt_pk_bf16(o2[0], o2[1]); w2.y = cvt_pk_bf16(o2[2], o2[3]);
                        *(u32x2*)(bb + off) = w1; *(u32x2*)(bb + off + 64) = w2; }
                }
            }
    }
};
}

struct Params {
    const float* x; const int* pos;
    const float *ln1g, *ln1b, *f1w1, *f1w3, *f1w2, *win, *gateb, *cpe, *cw1, *cb1, *cw2, *cb2, *wout, *ln2g, *ln2b, *f2w1, *f2w3, *f2w2, *ln3g, *ln3b;
    float* out; unsigned char* ws; int ph_lo, ph_hi;
};

template <class SrcFn>
__device__ __forceinline__ void tr_item64(int K, int k0, bf16_t* WT, int dr0, const SrcFn& src, LAS float* scr, int lane) {
    const int n4 = lane & 15, kr = lane >> 4;
    const float* sp = src(dr0 + 4 * n4) + (size_t)(k0 + kr) * src.pitch;
    const int nv = src.nvalid(dr0 + 4 * n4);
    const size_t rs = (size_t)4 * src.pitch;
    f32x4 v[16];
    if (nv == 4) {
#pragma unroll
        for (int i = 0; i < 16; ++i) v[i] = *(const f32x4*)(sp + i * rs);
    } else {
#pragma unroll
        for (int i = 0; i < 16; ++i) { v[i] = (f32x4){0.f, 0.f, 0.f, 0.f}; if (nv > 0) v[i][0] = sp[i * rs]; if (nv > 1) v[i][1] = sp[i * rs + 1]; if (nv > 2) v[i][2] = sp[i * rs + 2]; }
    }
#pragma unroll
    for (int i = 0; i < 16; ++i) { const int k = 4 * i + kr; *(LAS f32x4*)(scr + k * 64 + ((4 * n4 + 4 * (k >> 3)) & 63)) = v[i]; }
    asm volatile("s_waitcnt lgkmcnt(0)" ::: "memory");
    const int c = lane & 7;
#pragma unroll
    for (int j = 0; j < 8; ++j) { const int n = (lane >> 3) + 8 * j; const LAS float* s = scr + (8 * c) * 64 + ((n + 4 * c) & 63);
        u32x4 o; o.x = pg8::cvt_pk_bf16(s[0 * 64], s[1 * 64]); o.y = pg8::cvt_pk_bf16(s[2 * 64], s[3 * 64]); o.z = pg8::cvt_pk_bf16(s[4 * 64], s[5 * 64]); o.w = pg8::cvt_pk_bf16(s[6 * 64], s[7 * 64]);
        *(u32x4*)(WT + (size_t)(dr0 + n) * K + k0 + 8 * c) = o; }
    asm volatile("s_waitcnt lgkmcnt(0)" ::: "memory");
}
struct SrcPlain { const float* W; int pitch; __device__ __forceinline__ const float* operator()(int r) const { return W + r; } __device__ __forceinline__ int nvalid(int) const { return 4; } };
struct SrcW13 { const float* W; int pitch; __device__ __forceinline__ const float* operator()(int r) const { const int pn = r >> 8, i = r & 127; return W + 128 * pn + i; } __device__ __forceinline__ int nvalid(int) const { return 4; } };
struct SrcWin { const float* W; int pitch;
    __device__ __forceinline__ int col(int r) const { const int p = r & 127, wc = (p >> 5) & 3, n = (p >> 4) & 1, d = 64 * n + 16 * wc + (p & 15); return (r & ~127) + d; }
    __device__ __forceinline__ const float* operator()(int r) const { return W + col(r); }
    __device__ __forceinline__ int nvalid(int r) const { const int left = IN_COLS - col(r); return left >= 4 ? 4 : (left > 0 ? left : 0); } };

__device__ __forceinline__ void p0_prologue(const Params& p, LAS unsigned char* lds) {
    const int tid = threadIdx.x, lane = tid & 63, wave = __builtin_amdgcn_readfirstlane(tid >> 6);
    LAS float* scr = (LAS float*)(lds + wave * 16384);
    const int gw = blockIdx.x * NWAVES + wave, NGW = gridDim.x * NWAVES;
    unsigned char* ws = p.ws;
    constexpr int I13 = (DM / 64) * (2 * DFF / 64), I2 = (DFF / 64) * (DM / 64), IIN = (DM / 64) * (IN_PAD / 64), IOUT = (DM / 64) * (DM / 64);
    constexpr int ICW1 = (4096 / 64) * (256 / 64), ICW2 = (256 / 64) * (128 / 64);
    constexpr int NITEMS = 2 * I13 + 2 * I2 + IIN + IOUT + 2 * ICW1 + 2 * ICW2;
    if (blockIdx.x == 0) { if (tid < 16) ((unsigned*)(ws + OFF_CTL))[tid] = 0u;
        for (int i = tid; i < XCD_BAR_WORDS_C; i += NTHREADS) ((unsigned*)(ws + OFF_CTL))[CW_BAR_C + i] = 0u; }
    for (int it = gw; it < NITEMS; it += NGW) {
        int r = it;
        if (r < I13) { const int nb = 2 * DFF / 64; const int dr = 64 * (r % nb); const float* W = p.f1w1; if ((dr >> 7) & 1) W = p.f1w3; SrcW13 s{W, DFF}; tr_item64(DM, 64 * (r / nb), (bf16_t*)(ws + OFF_W13A), dr, s, scr, lane); continue; } r -= I13;
        if (r < I2)  { const int nb = DM / 64; SrcPlain s{p.f1w2, DM}; tr_item64(DFF, 64 * (r / nb), (bf16_t*)(ws + OFF_W2A), 64 * (r % nb), s, scr, lane); continue; } r -= I2;
        if (r < I13) { const int nb = 2 * DFF / 64; const int dr = 64 * (r % nb); const float* W = p.f2w1; if ((dr >> 7) & 1) W = p.f2w3; SrcW13 s{W, DFF}; tr_item64(DM, 64 * (r / nb), (bf16_t*)(ws + OFF_W13B), dr, s, scr, lane); continue; } r -= I13;
        if (r < I2)  { const int nb = DM / 64; SrcPlain s{p.f2w2, DM}; tr_item64(DFF, 64 * (r / nb), (bf16_t*)(ws + OFF_W2B), 64 * (r % nb), s, scr, lane); continue; } r -= I2;
        if (r < IIN) { const int nb = IN_PAD / 64; SrcWin s{p.win, IN_COLS}; tr_item64(DM, 64 * (r / nb), (bf16_t*)(ws + OFF_WIN), 64 * (r % nb), s, scr, lane); continue; } r -= IIN;
        if (r < IOUT) { const int nb = DM / 64; SrcPlain s{p.wout, DM}; tr_item64(DM, 64 * (r / nb), (bf16_t*)(ws + OFF_WOUT), 64 * (r % nb), s, scr, lane); continue; } r -= IOUT;
        if (r < 2 * ICW1) { const int j = r / ICW1, q = r % ICW1, nb = 256 / 64; SrcPlain s{p.cw1 + (size_t)j * 4096 * 256, 256}; tr_item64(4096, 64 * (q / nb), (bf16_t*)(ws + OFF_CW1T) + (size_t)j * 256 * 4096, 64 * (q % nb), s, scr, lane); continue; } r -= 2 * ICW1;
        { const int j = r / ICW2, q = r % ICW2, nb = 128 / 64; SrcPlain s{p.cw2 + (size_t)j * 256 * 128, 128}; tr_item64(256, 64 * (q / nb), (bf16_t*)(ws + OFF_CW2T) + (size_t)j * 128 * 256, 64 * (q % nb), s, scr, lane); }
    }
    {
        const size_t n8 = (size_t)S * DM / 8, gt = (size_t)blockIdx.x * NTHREADS + tid, GT_ = (size_t)gridDim.x * NTHREADS;
        bf16_t* XB = (bf16_t*)(ws + OFF_XB);
        for (size_t i = gt; i < n8; i += 4 * GT_) {
            f32x4 a[4], b[4];
#pragma unroll
            for (int e = 0; e < 4; ++e) { const size_t ii = i + e * GT_; if (ii < n8) { a[e] = *(const f32x4*)(p.x + ii * 8); b[e] = *(const f32x4*)(p.x + ii * 8 + 4); } }
#pragma unroll
            for (int e = 0; e < 4; ++e) { const size_t ii = i + e * GT_; if (ii < n8) { u32x4 o; o.x = pg8::cvt_pk_bf16(a[e][0], a[e][1]); o.y = pg8::cvt_pk_bf16(a[e][2], a[e][3]); o.z = pg8::cvt_pk_bf16(b[e][0], b[e][1]); o.w = pg8::cvt_pk_bf16(b[e][2], b[e][3]); *(u32x4*)(XB + ii * 8) = o; } }
        }
    }
    {
        float* cosT = (float*)(ws + OFF_ROPE); float* sinT = cosT + (size_t)S * 64;
        const int gt = blockIdx.x * NTHREADS + tid, GT_ = gridDim.x * NTHREADS;
        for (int i = gt; i < S * 64; i += GT_) { float c, s; rope_cs((double)p.pos[i >> 6], i & 63, c, s); cosT[i] = c; sinT[i] = s; }
    }
}

__device__ __forceinline__ void ln_phase(const float* in, float* outf, bf16_t* outb, const float* g, const float* b) {
    const int tid = threadIdx.x, lane = tid & 63, wave = __builtin_amdgcn_readfirstlane(tid >> 6);
    const int gw = blockIdx.x * NWAVES + wave, NGW = gridDim.x * NWAVES;
    for (int row = gw; row < S; row += NGW) {
        const f32x4* xr = (const f32x4*)(in + (size_t)row * DM) + lane;
        f32x4 v[8]; float s = 0.f;
#pragma unroll
        for (int j = 0; j < 8; ++j) { v[j] = xr[64 * j]; s += (v[j][0] + v[j][1]) + (v[j][2] + v[j][3]); }
        const float mean = wave_sum(s) * (1.f / DM); float s2 = 0.f;
#pragma unroll
        for (int j = 0; j < 8; ++j) { v[j] = v[j] - mean; s2 += (v[j][0] * v[j][0] + v[j][1] * v[j][1]) + (v[j][2] * v[j][2] + v[j][3] * v[j][3]); }
        const float rstd = 1.0f / sqrtf(wave_sum(s2) * (1.f / DM) + LN_EPS);
#pragma unroll
        for (int j = 0; j < 8; ++j) {
            const f32x4 gg = *((const f32x4*)g + lane + 64 * j), bb = *((const f32x4*)b + lane + 64 * j);
            const f32x4 o = v[j] * rstd * gg + bb;
            *((f32x4*)(outf + (size_t)row * DM) + lane + 64 * j) = o;
            if (outb) { u32x2 w; w.x = pk2(o[0], o[1]); w.y = pk2(o[2], o[3]); *((u32x2*)(outb + (size_t)row * DM) + lane + 64 * j) = w; }
        }
    }
}

__device__ __forceinline__ float dot128(const LAS bf16_t* q, const bf16_t* k) {
    float a0 = 0.f, a1 = 0.f;
#pragma unroll
    for (int c = 0; c < 16; ++c) { const u32x4 qv = *(const LAS u32x4*)(q + 8 * c); const u32x4 kv = *(const u32x4*)(k + 8 * c);
#pragma unroll
        for (int e = 0; e < 4; ++e) { a0 += bflo(qv[e]) * bflo(kv[e]); a1 += bfhi(qv[e]) * bfhi(kv[e]); } }
    return a0 + a1;
}
__device__ __forceinline__ float gelu_tanh(float x) {
    const float u = 0.7978845608028654f * (x + 0.044715f * x * x * x);
    const float e = __expf(2.f * u);
    const float th = 1.f - 2.f / (e + 1.f);
    return 0.5f * x * (1.f + th);
}

__device__ __forceinline__ void compress_naive(const Params& p, LAS unsigned char* lds) {
    const int tid = threadIdx.x;
    LAS float* A = (LAS float*)lds; LAS float* part = A + 4096; LAS float* hdn = part + 512; LAS float* outv = hdn + 256;
    unsigned char* ws = p.ws;
    bf16_t* KC = (bf16_t*)(ws + OFF_KC); bf16_t* VC = (bf16_t*)(ws + OFF_VC);
    for (int u = blockIdx.x; u < 2 * NG * 512; u += gridDim.x) {
        const int n = u & 511, g = (u >> 9) & 1, j = u >> 10;
        bf16_t* dst = (j ? VC : KC) + ((size_t)g * 512 + n) * 128;
        if (n >= NCMP) { if (tid < 128) dst[tid] = 0; continue; }
        const float* tok = (const float*)(ws + (j ? OFF_VCT : OFF_KCT)) + ((size_t)g * S + 16 * n) * 128;
        const float* pe = p.cpe + (size_t)j * 32 * 128;
        for (int i = tid; i < 4096; i += NTHREADS) A[i] = tok[i] + pe[i];
        __syncthreads();
        { const int h = tid & 255, half = tid >> 8; const float* w = p.cw1 + ((size_t)j * 4096 + 2048 * half) * 256 + h; const LAS float* a = A + 2048 * half;
          float acc = 0.f;
#pragma unroll 8
          for (int k = 0; k < 2048; ++k) acc += a[k] * w[(size_t)k * 256];
          part[tid] = acc; }
        __syncthreads();
        if (tid < 256) hdn[tid] = gelu_tanh(part[tid] + part[tid + 256] + p.cb1[j * 256 + tid]);
        __syncthreads();
        if (tid < 128) { const float* w = p.cw2 + (size_t)j * 256 * 128 + tid; float acc = p.cb2[j * 128 + tid];
#pragma unroll 8
            for (int h = 0; h < 256; ++h) acc += hdn[h] * w[(size_t)h * 128];
            outv[tid] = acc; }
        __syncthreads();
        if (j == 0) { if (tid < 64) { const double pc = 0.5 * ((double)p.pos[16 * n] + (double)p.pos[16 * n + 31]); float c, s; rope_cs(pc, tid, c, s);
                const float x1 = outv[tid], x2 = outv[tid + 64]; dst[tid] = (bf16_t)f2bf(x1 * c - x2 * s); dst[tid + 64] = (bf16_t)f2bf(x2 * c + x1 * s); } }
        else { if (tid < 128) dst[tid] = (bf16_t)f2bf(outv[tid]); }
        __syncthreads();
    }
}

__device__ __forceinline__ void dilated_naive(const Params& p, LAS unsigned char* lds) {
    const int tid = threadIdx.x, lane = tid & 63, wave = __builtin_amdgcn_readfirstlane(tid >> 6);
    LAS bf16_t* qs = (LAS bf16_t*)(lds + 32768) + wave * 128;
    unsigned char* ws = p.ws;
    const bf16_t* QA = (const bf16_t*)(ws + OFF_QA); const bf16_t* KA = (const bf16_t*)(ws + OFF_KA); const bf16_t* VA = (const bf16_t*)(ws + OFF_VA);
    bf16_t* MX = (bf16_t*)(ws + OFF_XB);
    const int gw = blockIdx.x * NWAVES + wave, NGW = gridDim.x * NWAVES;
    for (int u = gw; u < S * NH_DIL; u += NGW) {
        const int t = u / NH_DIL, h = u % NH_DIL;
        *(LAS unsigned*)(qs + 2 * lane) = *(const unsigned*)(QA + (size_t)t * D_DIL + h * 128 + 2 * lane);
        asm volatile("s_waitcnt lgkmcnt(0)" ::: "memory");
        float sc[3][3]; float m = -INFINITY;
#pragma unroll
        for (int c = 0; c < 3; ++c) { const int dil = c == 0 ? 1 : (c == 1 ? 4 : 16);
#pragma unroll
            for (int it = 0; it < 3; ++it) { const int k = lane + 64 * it; const int tk = t - dil * k; const bool valid = (k <= 128) && (tk >= 0);
                float s = -INFINITY; if (valid) s = dot128(qs, KA + (size_t)tk * D_DIL + h * 128); sc[c][it] = s; m = fmaxf(m, s); } }
        m = wave_max(m);
        float l = 0.f;
#pragma unroll
        for (int c = 0; c < 3; ++c)
#pragma unroll
            for (int it = 0; it < 3; ++it) { const float e = fast_exp2(sc[c][it] - m); sc[c][it] = e; l += e; }
        l = wave_sum(l);
        float o0 = 0.f, o1 = 0.f;
#pragma unroll
        for (int c = 0; c < 3; ++c) { const int dil = c == 0 ? 1 : (c == 1 ? 4 : 16);
#pragma unroll
            for (int it = 0; it < 3; ++it) { int cnt = 129 - 64 * it; cnt = cnt > 64 ? 64 : cnt; const int kmax = t / dil - 64 * it + 1; cnt = cnt < kmax ? cnt : kmax;
                for (int kk = 0; kk < cnt; ++kk) { const float pk = __uint_as_float(__builtin_amdgcn_readlane(__float_as_uint(sc[c][it]), kk));
                    const unsigned v = *(const unsigned*)(VA + (size_t)(t - dil * (kk + 64 * it)) * D_DIL + h * 128 + 2 * lane); o0 += pk * bflo(v); o1 += pk * bfhi(v); } } }
        const float inv = 1.f / l;
        *(unsigned*)(MX + (size_t)t * DM + h * 128 + 2 * lane) = pk2(o0 * inv, o1 * inv);
    }
}

__device__ __forceinline__ void nsa_naive(const Params& p, LAS unsigned char* lds) {
    const int tid = threadIdx.x, lane = tid & 63, wave = __builtin_amdgcn_readfirstlane(tid >> 6);
    LAS bf16_t* qsh = (LAS bf16_t*)lds;
    LAS float* Pc = (LAS float*)(lds + 2048);
    LAS int* sel = (LAS int*)(lds + 2048 + 10240);
    unsigned char* ws = p.ws;
    const bf16_t* QN = (const bf16_t*)(ws + OFF_QN);
    const bf16_t* KC = (const bf16_t*)(ws + OFF_KC); const bf16_t* VC = (const bf16_t*)(ws + OFF_VC);
    const bf16_t* KS = (const bf16_t*)(ws + OFF_KS); const bf16_t* VS = (const bf16_t*)(ws + OFF_VS);
    const bf16_t* KW = (const bf16_t*)(ws + OFF_KW); const bf16_t* VW = (const bf16_t*)(ws + OFF_VW);
    const float* GT = (const float*)(ws + OFF_GT);
    bf16_t* MX = (bf16_t*)(ws + OFF_XB);
    for (int u = blockIdx.x; u < S * NG; u += gridDim.x) {
        const int t = u >> 1, g = u & 1;
        const int h = HG * g + wave;
        LAS bf16_t* qs = qsh + wave * 128;
        float oc0 = 0.f, oc1 = 0.f;
        if (wave < HG) {
            *(LAS unsigned*)(qs + 2 * lane) = *(const unsigned*)(QN + (size_t)t * D_NSA + h * 128 + 2 * lane);
            asm volatile("s_waitcnt lgkmcnt(0)" ::: "memory");
            const int ncnt = (t >= 31) ? (t - 31) / 16 + 1 : 0;
            float s[8]; float m = -INFINITY;
#pragma unroll
            for (int it = 0; it < 8; ++it) { const int n = lane + 64 * it; float v = -INFINITY; if (n < ncnt) v = dot128(qs, KC + ((size_t)g * 512 + n) * 128); s[it] = v; m = fmaxf(m, v); }
            m = wave_max(m);
            float l = 0.f;
#pragma unroll
            for (int it = 0; it < 8; ++it) { const int n = lane + 64 * it; const float e = (n < ncnt) ? fast_exp2(s[it] - m) : 0.f; s[it] = e; l += e; }
            l = wave_sum(l);
            const float inv = l > 0.f ? 1.f / l : 0.f;
#pragma unroll
            for (int it = 0; it < 8; ++it) { s[it] *= inv; Pc[wave * 512 + lane + 64 * it] = s[it]; }
#pragma unroll
            for (int it = 0; it < 8; ++it) { int cnt = ncnt - 64 * it; cnt = cnt > 64 ? 64 : cnt;
                for (int kk = 0; kk < cnt; ++kk) { const float pk = __uint_as_float(__builtin_amdgcn_readlane(__float_as_uint(s[it]), kk));
                    const unsigned v = *(const unsigned*)(VC + ((size_t)g * 512 + 64 * it + kk) * 128 + 2 * lane); oc0 += pk * bflo(v); oc1 += pk * bfhi(v); } }
        }
        __syncthreads();
        if (wave == 0) {
            const int cur = t >> 6;
            float sc0, sc1;
            { const int jj = lane; float imp = 0.f;
              for (int n = 4 * jj - 1; n <= 4 * jj + 3; ++n) if (n >= 0 && n < NCMP) { for (int w = 0; w < HG; ++w) imp += Pc[w * 512 + n]; }
              const bool forced = (jj == 0) || (jj == cur) || (jj == cur - 1);
              sc0 = (jj <= cur) ? imp + (forced ? 1e4f : 0.f) : -1e30f; }
            { const int jj = lane + 64; float imp = 0.f;
              for (int n = 4 * jj - 1; n <= 4 * jj + 3; ++n) if (n >= 0 && n < NCMP) { for (int w = 0; w < HG; ++w) imp += Pc[w * 512 + n]; }
              const bool forced = (jj == 0) || (jj == cur) || (jj == cur - 1);
              sc1 = (jj <= cur) ? imp + (forced ? 1e4f : 0.f) : -1e30f; }
            for (int r = 0; r < 16; ++r) {
                const float mx = wave_max(fmaxf(sc0, sc1));
                const unsigned long long b0 = __ballot(sc0 == mx);
                int idx;
                if (b0) idx = __builtin_ctzll(b0); else { const unsigned long long b1 = __ballot(sc1 == mx); idx = 64 + __builtin_ctzll(b1); }
                if (lane == 0) sel[r] = (mx > -1e29f) ? idx : -1;
                if (idx < 64) { if (lane == idx) sc0 = -INFINITY; } else { if (lane == idx - 64) sc1 = -INFINITY; }
            }
        }
        __syncthreads();
        if (wave < HG) {
            float ss[16]; float m = -INFINITY;
#pragma unroll
            for (int r = 0; r < 16; ++r) { const int j = __builtin_amdgcn_readfirstlane(sel[r]); float v = -INFINITY;
                if (j >= 0) { const int kp = 64 * j + lane; if (kp <= t) v = dot128(qs, KS + ((size_t)g * S + kp) * 128); }
                ss[r] = v; m = fmaxf(m, v); }
            m = wave_max(m);
            float l = 0.f;
#pragma unroll
            for (int r = 0; r < 16; ++r) { const float e = fast_exp2(ss[r] - m); ss[r] = e; l += e; }
            l = wave_sum(l);
            float os0 = 0.f, os1 = 0.f;
#pragma unroll
            for (int r = 0; r < 16; ++r) { const int j = __builtin_amdgcn_readfirstlane(sel[r]); if (j >= 0) { int cnt = t - 64 * j + 1; cnt = cnt > 64 ? 64 : cnt;
                for (int kk = 0; kk < cnt; ++kk) { const float pk = __uint_as_float(__builtin_amdgcn_readlane(__float_as_uint(ss[r]), kk));
                    const unsigned v = *(const unsigned*)(VS + ((size_t)g * S + 64 * j + kk) * 128 + 2 * lane); os0 += pk * bflo(v); os1 += pk * bfhi(v); } } }
            const float invs = 1.f / l;
            float sw[8]; float mw = -INFINITY;
#pragma unroll
            for (int it = 0; it < 8; ++it) { const int kp = t - 511 + lane + 64 * it; float v = -INFINITY; if (kp >= 0) v = dot128(qs, KW + ((size_t)g * S + kp) * 128); sw[it] = v; mw = fmaxf(mw, v); }
            mw = wave_max(mw);
            float lw = 0.f;
#pragma unroll
            for (int it = 0; it < 8; ++it) { const float e = fast_exp2(sw[it] - mw); sw[it] = e; lw += e; }
            lw = wave_sum(lw);
            float ow0 = 0.f, ow1 = 0.f;
#pragma unroll
            for (int it = 0; it < 8; ++it) { const int kp0 = t - 511 + 64 * it; int k0 = kp0 < 0 ? -kp0 : 0; k0 = k0 > 64 ? 64 : k0;
                for (int kk = k0; kk < 64; ++kk) { const float pk = __uint_as_float(__builtin_amdgcn_readlane(__float_as_uint(sw[it]), kk));
                    const unsigned v = *(const unsigned*)(VW + ((size_t)g * S + kp0 + kk) * 128 + 2 * lane); ow0 += pk * bflo(v); ow1 += pk * bfhi(v); } }
            const float invw = 1.f / lw;
            const float g0 = GT[(size_t)t * 32 + h * 3 + 0], g1 = GT[(size_t)t * 32 + h * 3 + 1], g2 = GT[(size_t)t * 32 + h * 3 + 2];
            const float r0 = g0 * oc0 + g1 * os0 * invs + g2 * ow0 * invw, r1 = g0 * oc1 + g1 * os1 * invs + g2 * ow1 * invw;
            *(unsigned*)(MX + (size_t)t * DM + D_DIL + h * 128 + 2 * lane) = pk2(r0, r1);
        }
        __syncthreads();
    }
}

namespace att {
typedef short s16x4 __attribute__((ext_vector_type(4)));
constexpr int KP = 272, VP = 288;
constexpr int KT_BYTES = 64 * KP, VT_BYTES = 64 * VP;
constexpr int L_K0 = 0, L_K1 = KT_BYTES, L_V0 = 2 * KT_BYTES, L_V1 = 2 * KT_BYTES + VT_BYTES;
constexpr int L_MISC = 73728;
constexpr int L_SLOT = 143360;
constexpr unsigned W_CAUSAL = 0x80000000u;
constexpr size_t OV_OD = 0, OV_LSE = 40 * MiB, OV_OC = 41 * MiB, OV_SEL = 82 * MiB;

struct TileSrc { const char* K; const char* V; size_t kst, vst; };

__device__ __forceinline__ void tile_load(u32x4 (&r)[4], const TileSrc& s, int key0, int tid) {
    const int k = tid >> 4, cc = (tid & 15) * 16;
    const char* kp = s.K + (size_t)(key0 + k) * s.kst + cc; const char* vp = s.V + (size_t)(key0 + k) * s.vst + cc;
    r[0] = *(const u32x4*)kp; r[1] = *(const u32x4*)(kp + 32 * s.kst); r[2] = *(const u32x4*)vp; r[3] = *(const u32x4*)(vp + 32 * s.vst);
}
__device__ __forceinline__ void tile_store(LAS unsigned char* lds, int buf, const u32x4 (&r)[4], int tid) {
    const int k = tid >> 4, cc = (tid & 15) * 16;
    const int lam = 16 * ((k >> 2) & 1) + 4 * ((k >> 3) & 3) + (k & 3);
    const int lv = (k & 16) + 8 * ((k >> 2) & 1) + 4 * ((k >> 3) & 1) + (k & 3);
    LAS unsigned char* Kt = lds + (buf ? L_K1 : L_K0); LAS unsigned char* Vt = lds + (buf ? L_V1 : L_V0);
    *(LAS u32x4*)(Kt + lam * KP + cc) = r[0]; *(LAS u32x4*)(Kt + (lam + 32) * KP + cc) = r[1];
    *(LAS u32x4*)(Vt + lv * VP + cc) = r[2]; *(LAS u32x4*)(Vt + (lv + 32) * VP + cc) = r[3];
}
struct QState { bf16x8 qf[4]; f32x4 o[8]; float m, l; };
__device__ __forceinline__ void q_reset(QState& st) {
#pragma unroll
    for (int i = 0; i < 8; ++i) st.o[i] = (f32x4){0.f, 0.f, 0.f, 0.f};
    st.m = -1e30f; st.l = 0.f;
}
__device__ __forceinline__ void q_load(QState& st, const bf16_t* qrow, int g) {
#pragma unroll
    for (int ds = 0; ds < 4; ++ds) st.qf[ds] = *(const bf16x8*)(qrow + 32 * ds + 8 * g);
    q_reset(st);
}
__device__ __forceinline__ void qk_tile(f32x4 (&s)[4], const LAS unsigned char* Kt, const QState& st, int c, int g) {
    const LAS unsigned char* kb = Kt + c * KP + g * 16;
#pragma unroll
    for (int T = 0; T < 4; ++T) { s[T] = (f32x4){0.f, 0.f, 0.f, 0.f};
#pragma unroll
        for (int ds = 0; ds < 4; ++ds) { const bf16x8 kf = *(const LAS bf16x8*)(kb + T * 16 * KP + ds * 64); s[T] = __builtin_amdgcn_mfma_f32_16x16x32_bf16(kf, st.qf[ds], s[T], 0, 0, 0); } }
}
__device__ __forceinline__ void mask_tile(f32x4 (&s)[4], int dq, unsigned W, bool en, int g) {
#pragma unroll
    for (int T = 0; T < 4; ++T)
#pragma unroll
        for (int r = 0; r < 4; ++r) { const int kt = 32 * (T >> 1) + 8 * g + 4 * (T & 1) + r; if (!(en && (unsigned)(dq - kt) < W)) s[T][r] = -INFINITY; }
}
__device__ __forceinline__ float group_max(float v) { v = fmaxf(v, __shfl_xor(v, 16)); v = fmaxf(v, __shfl_xor(v, 32)); return v; }
__device__ __forceinline__ float group_sum(float v) { v += __shfl_xor(v, 16); v += __shfl_xor(v, 32); return v; }
template <bool PV> __device__ __forceinline__ void softmax_online(f32x4 (&s)[4], QState& st) {
    float mx = -INFINITY;
#pragma unroll
    for (int T = 0; T < 4; ++T)
#pragma unroll
        for (int r = 0; r < 4; ++r) mx = fmaxf(mx, s[T][r]);
    mx = group_max(mx);
    const float mn = fmaxf(st.m, mx), alpha = fast_exp2(st.m - mn); st.m = mn;
    float sum = 0.f;
#pragma unroll
    for (int T = 0; T < 4; ++T)
#pragma unroll
        for (int r = 0; r < 4; ++r) { const float e = fast_exp2(s[T][r] - mn); s[T][r] = e; sum += e; }
    st.l = st.l * alpha + sum;
    if (PV) {
#pragma unroll
        for (int i = 0; i < 8; ++i) st.o[i] = st.o[i] * alpha;
    }
}
__device__ __forceinline__ s16x4 tr_read(const LAS unsigned char* p) { return __builtin_bit_cast(s16x4, __builtin_amdgcn_ds_read_tr16_b64_v4i16((LAS s16x4*)p)); }
__device__ __forceinline__ void pv_tile(const f32x4 (&s)[4], const LAS unsigned char* Vt, QState& st, int c, int g) {
    const LAS unsigned char* vb = Vt + (16 * (g >> 1) + 4 * (g & 1) + (c >> 2)) * VP + (c & 3) * 8;
#pragma unroll
    for (int ch = 0; ch < 2; ++ch) {
        u32x4 pw; pw.x = pg8::cvt_pk_bf16(s[2 * ch][0], s[2 * ch][1]); pw.y = pg8::cvt_pk_bf16(s[2 * ch][2], s[2 * ch][3]);
        pw.z = pg8::cvt_pk_bf16(s[2 * ch + 1][0], s[2 * ch + 1][1]); pw.w = pg8::cvt_pk_bf16(s[2 * ch + 1][2], s[2 * ch + 1][3]);
        const bf16x8 pf = __builtin_bit_cast(bf16x8, pw);
#pragma unroll
        for (int dt = 0; dt < 8; ++dt) {
            const s16x4 lo = tr_read(vb + ch * 32 * VP + dt * 32), hi = tr_read(vb + ch * 32 * VP + 8 * VP + dt * 32);
            const bf16x8 vf = (bf16x8){lo[0], lo[1], lo[2], lo[3], hi[0], hi[1], hi[2], hi[3]};
            st.o[dt] = __builtin_amdgcn_mfma_f32_16x16x32_bf16(vf, pf, st.o[dt], 0, 0, 0);
        }
    }
}
template <bool PV, class F>
__device__ __forceinline__ void attn_pass(LAS unsigned char* lds, const TileSrc& src, int t0, int t1, QState& st, const F& f, int tid, int c, int g) {
    if (t0 >= t1) return;
    u32x4 r[4];
    tile_load(r, src, 64 * t0, tid); tile_store(lds, 0, r, tid); __syncthreads();
    for (int t = t0; t < t1; ++t) {
        const int buf = (t - t0) & 1;
        if (t + 1 < t1) tile_load(r, src, 64 * (t + 1), tid);
        if (f.relevant(t)) {
            f32x4 s[4]; qk_tile(s, lds + (buf ? L_K1 : L_K0), st, c, g); mask_tile(s, f.dq(t), f.W(), f.en(t), g); softmax_online<PV>(s, st);
            if (PV) pv_tile(s, lds + (buf ? L_V1 : L_V0), st, c, g);
        }
        if (t + 1 < t1) tile_store(lds, buf ^ 1, r, tid);
        __syncthreads();
    }
}
__device__ __forceinline__ int next_unit(unsigned* ctr, LAS unsigned char* lds) {
    LAS int* slot = (LAS int*)(lds + L_SLOT);
    __syncthreads();
    if (threadIdx.x == 0) *slot = (int)atomicAdd(ctr, 1u);
    __syncthreads();
    return *slot;
}

struct DilF { int iq, iw;
    __device__ __forceinline__ bool relevant(int t) const { return 64 * t <= iw + 15 && 64 * t + 63 >= iw - 128; }
    __device__ __forceinline__ int dq(int t) const { return iq - 64 * t; }
    __device__ __forceinline__ unsigned W() const { return 129u; }
    __device__ __forceinline__ bool en(int) const { return true; } };
__device__ __forceinline__ void dil_unit(const Params& p, LAS unsigned char* lds, int u) {
    const int tid = threadIdx.x, lane = tid & 63, wave = __builtin_amdgcn_readfirstlane(tid >> 6), c = lane & 15, g = lane >> 4;
    const int cfg = u / 384, v = u % 384, h = v % NH_DIL, rb = v / NH_DIL;
    const int dil = cfg == 0 ? 1 : (cfg == 1 ? 4 : 16), nb = (S / dil) / 128, r = rb / nb, b = rb % nb;
    unsigned char* ws = p.ws;
    const int iw = 128 * b + 16 * wave, iq = iw + c, tok = dil * iq + r;
    QState st; q_load(st, (const bf16_t*)(ws + OFF_QA) + (size_t)tok * D_DIL + h * 128, g);
    TileSrc src{(const char*)(ws + OFF_KA) + ((size_t)r * D_DIL + h * 128) * 2, (const char*)(ws + OFF_VA) + ((size_t)r * D_DIL + h * 128) * 2, (size_t)dil * D_DIL * 2, (size_t)dil * D_DIL * 2};
    DilF f{iq, iw};
    attn_pass<true>(lds, src, b == 0 ? 0 : 2 * (b - 1), 2 * b + 2, st, f, tid, c, g);
    const float lt = group_sum(st.l), inv = 1.f / lt;
    bf16_t* od = (bf16_t*)(ws + OFF_HID + OV_OD) + ((size_t)cfg * S + tok) * D_DIL + h * 128 + 4 * g;
#pragma unroll
    for (int dt = 0; dt < 8; ++dt) { u32x2 w; w.x = pg8::cvt_pk_bf16(st.o[dt][0] * inv, st.o[dt][1] * inv); w.y = pg8::cvt_pk_bf16(st.o[dt][2] * inv, st.o[dt][3] * inv); *(u32x2*)(od + 16 * dt) = w; }
    if (g == 0) ((float*)(ws + OFF_HID + OV_LSE))[((size_t)cfg * S + tok) * 8 + h] = st.m + __log2f(lt);
}
__device__ __forceinline__ void dil_merge(const Params& p) {
    unsigned char* ws = p.ws;
    const bf16_t* OD = (const bf16_t*)(ws + OFF_HID + OV_OD); const float* LSE = (const float*)(ws + OFF_HID + OV_LSE); bf16_t* MX = (bf16_t*)(ws + OFF_XB);
    const int gt = blockIdx.x * NTHREADS + threadIdx.x, GT_ = gridDim.x * NTHREADS;
    for (int i = gt; i < S * NH_DIL * 16; i += GT_) {
        const int ch = i & 15, th = i >> 4, h = th % NH_DIL, t = th / NH_DIL;
        const float l0 = LSE[((size_t)0 * S + t) * 8 + h], l1 = LSE[((size_t)1 * S + t) * 8 + h], l2 = LSE[((size_t)2 * S + t) * 8 + h];
        const float mx = fmaxf(l0, fmaxf(l1, l2)); float w0 = fast_exp2(l0 - mx), w1 = fast_exp2(l1 - mx), w2 = fast_exp2(l2 - mx);
        const float inv = 1.f / (w0 + w1 + w2); w0 *= inv; w1 *= inv; w2 *= inv;
        const size_t off = (size_t)t * D_DIL + h * 128 + 8 * ch;
        const u32x4 a = *(const u32x4*)(OD + off), b = *(const u32x4*)(OD + (size_t)S * D_DIL + off), cc = *(const u32x4*)(OD + (size_t)2 * S * D_DIL + off);
        u32x4 o;
#pragma unroll
        for (int e = 0; e < 4; ++e) o[e] = pk2(w0 * bflo(a[e]) + w1 * bflo(b[e]) + w2 * bflo(cc[e]), w0 * bfhi(a[e]) + w1 * bfhi(b[e]) + w2 * bfhi(cc[e]));
        *(u32x4*)(MX + (size_t)t * DM + h * 128 + 8 * ch) = o;
    }
}

__device__ __forceinline__ void compress_unit(const Params& p, LAS unsigned char* lds, int u) {
    const int tid = threadIdx.x, lane = tid & 63, wave = __builtin_amdgcn_readfirstlane(tid >> 6), c = lane & 15, g4 = lane >> 4;
    const int nb = u & 31, grp = (u >> 5) & 1, j = u >> 6, n0 = 16 * nb;
    unsigned char* ws = p.ws;
    constexpr int AP = 1040, HP = 528, OP = 132;
    LAS unsigned char* Ach = lds; LAS unsigned char* HDl = lds + 16 * AP; LAS float* OUTF = (LAS float*)(lds + 16 * AP + 16 * HP);
    const float* TOK = (const float*)(ws + (j ? OFF_VCT : OFF_KCT)) + ((size_t)grp * S + n0 * 16) * 128;
    const float* pe = p.cpe + (size_t)j * 32 * 128;
    const bf16_t* W1T = (const bf16_t*)(ws + OFF_CW1T) + (size_t)j * 256 * 4096; const bf16_t* W2T = (const bf16_t*)(ws + OFF_CW2T) + (size_t)j * 128 * 256;
    f32x4 acc[2]; acc[0] = (f32x4){0.f, 0.f, 0.f, 0.f}; acc[1] = acc[0];
    for (int kc = 0; kc < 8; ++kc) {
        { const int n = tid >> 5, kl = (tid & 31) * 16, l = 4 * kc + (kl >> 7), d = kl & 127;
          const float* sp = TOK + ((size_t)(16 * n + l)) * 128 + d; const float* pp = pe + l * 128 + d;
          f32x4 a[4];
#pragma unroll
          for (int e = 0; e < 4; ++e) a[e] = *(const f32x4*)(sp + 4 * e) + *(const f32x4*)(pp + 4 * e);
          u32x4 w0, w1; w0.x = pk2(a[0][0], a[0][1]); w0.y = pk2(a[0][2], a[0][3]); w0.z = pk2(a[1][0], a[1][1]); w0.w = pk2(a[1][2], a[1][3]);
          w1.x = pk2(a[2][0], a[2][1]); w1.y = pk2(a[2][2], a[2][3]); w1.z = pk2(a[3][0], a[3][1]); w1.w = pk2(a[3][2], a[3][3]);
          *(LAS u32x4*)(Ach + n * AP + kl * 2) = w0; *(LAS u32x4*)(Ach + n * AP + kl * 2 + 16) = w1; }
        __syncthreads();
#pragma unroll 4
        for (int ks = 0; ks < 16; ++ks) {
            const bf16x8 bfr = *(const LAS bf16x8*)(Ach + c * AP + (32 * ks + 8 * g4) * 2);
#pragma unroll
            for (int nn = 0; nn < 2; ++nn) { const bf16x8 afr = *(const bf16x8*)(W1T + (size_t)(32 * wave + 16 * nn + c) * 4096 + 512 * kc + 32 * ks + 8 * g4);
                acc[nn] = __builtin_amdgcn_mfma_f32_16x16x32_bf16(afr, bfr, acc[nn], 0, 0, 0); }
        }
        __syncthreads();
    }
#pragma unroll
    for (int nn = 0; nn < 2; ++nn) { const int hb = 32 * wave + 16 * nn + 4 * g4; const f32x4 bb = *(const f32x4*)(p.cb1 + j * 256 + hb);
        u32x2 w; w.x = pk2(gelu_tanh(acc[nn][0] + bb[0]), gelu_tanh(acc[nn][1] + bb[1])); w.y = pk2(gelu_tanh(acc[nn][2] + bb[2]), gelu_tanh(acc[nn][3] + bb[3]));
        *(LAS u32x2*)(HDl + c * HP + hb * 2) = w; }
    __syncthreads();
    { f32x4 a2 = (f32x4){0.f, 0.f, 0.f, 0.f};
#pragma unroll
      for (int ks = 0; ks < 8; ++ks) { const bf16x8 afr = *(const bf16x8*)(W2T + (size_t)(16 * wave + c) * 256 + 32 * ks + 8 * g4); const bf16x8 bfr = *(const LAS bf16x8*)(HDl + c * HP + (32 * ks + 8 * g4) * 2);
          a2 = __builtin_amdgcn_mfma_f32_16x16x32_bf16(afr, bfr, a2, 0, 0, 0); }
      const int d = 16 * wave + 4 * g4; const f32x4 bb = *(const f32x4*)(p.cb2 + j * 128 + d);
      *(LAS f32x4*)(OUTF + c * OP + d) = a2 + bb; }
    __syncthreads();
    if (j == 0) {
        bf16_t* KC = (bf16_t*)(ws + OFF_KC) + ((size_t)grp * 512 + n0) * 128;
#pragma unroll
        for (int e = 0; e < 2; ++e) { const int idx = tid + 512 * e, n = idx >> 6, d = idx & 63;
            if (n0 + n >= NCMP) { KC[n * 128 + d] = 0; KC[n * 128 + d + 64] = 0; }
            else { const int nn = n0 + n; const double pc = 0.5 * ((double)p.pos[16 * nn] + (double)p.pos[16 * nn + 31]); float cs, sn; rope_cs(pc, d, cs, sn);
                const float x1 = OUTF[n * OP + d], x2 = OUTF[n * OP + d + 64]; KC[n * 128 + d] = (bf16_t)f2bf(x1 * cs - x2 * sn); KC[n * 128 + d + 64] = (bf16_t)f2bf(x2 * cs + x1 * sn); } }
    } else {
        bf16_t* VC = (bf16_t*)(ws + OFF_VC) + ((size_t)grp * 512 + n0) * 128;
#pragma unroll
        for (int e = 0; e < 4; ++e) { const int idx = tid + 512 * e, n = idx >> 7, d = idx & 127; VC[n * 128 + d] = (n0 + n >= NCMP) ? (bf16_t)0 : (bf16_t)f2bf(OUTF[n * OP + d]); }
    }
}

struct CmpF { int dq0; bool act;
    __device__ __forceinline__ bool relevant(int) const { return act; }
    __device__ __forceinline__ int dq(int t) const { return dq0 - 64 * t; }
    __device__ __forceinline__ unsigned W() const { return W_CAUSAL; }
    __device__ __forceinline__ bool en(int) const { return true; } };
__device__ __forceinline__ void cmp_unit(const Params& p, LAS unsigned char* lds, int u) {
    const int tid = threadIdx.x, lane = tid & 63, wave = __builtin_amdgcn_readfirstlane(tid >> 6), c = lane & 15, g = lane >> 4;
    const int qb = 511 - (u >> 1), grp = u & 1;
    unsigned char* ws = p.ws;
    constexpr int PP = 513;
    LAS float* Psum = (LAS float*)(lds + L_MISC);
    const int tw = 16 * qb, tq = tw + c;
    const bool act = wave < HG;
    const int h = HG * grp + (act ? wave : 0);
    for (int i = tid; i < 16 * PP; i += NTHREADS) Psum[i] = 0.f;
    __syncthreads();
    const int ncq = tq >= 31 ? (tq - 31) / 16 + 1 : 0;
    const int ncw = (tw + 15 >= 31) ? (tw + 15 - 31) / 16 + 1 : 0;
    const int nt = (ncw + 63) >> 6;
    QState st; q_load(st, (const bf16_t*)(ws + OFF_QN) + (size_t)tq * D_NSA + h * 128, g);
    TileSrc src{(const char*)(ws + OFF_KC) + (size_t)grp * 512 * 256, (const char*)(ws + OFF_VC) + (size_t)grp * 512 * 256, 256, 256};
    CmpF f{ncq - 1, act};
    attn_pass<false>(lds, src, 0, nt, st, f, tid, c, g);
    const float mfin = st.m, lt = group_sum(st.l), invl = lt > 0.f ? 1.f / lt : 0.f;
    if (nt > 0) {
        u32x4 r[4];
        tile_load(r, src, 0, tid); tile_store(lds, 0, r, tid); __syncthreads();
        for (int t = 0; t < nt; ++t) {
            const int buf = t & 1;
            if (t + 1 < nt) tile_load(r, src, 64 * (t + 1), tid);
            if (act) {
                f32x4 s[4]; qk_tile(s, lds + (buf ? L_K1 : L_K0), st, c, g); mask_tile(s, f.dq(t), W_CAUSAL, true, g);
#pragma unroll
                for (int T = 0; T < 4; ++T)
#pragma unroll
                    for (int rr = 0; rr < 4; ++rr) { const float e = fast_exp2(s[T][rr] - mfin) * invl; s[T][rr] = e;
                        const int kt = 32 * (T >> 1) + 8 * g + 4 * (T & 1) + rr;
                        __hip_atomic_fetch_add(Psum + c * PP + 64 * t + kt, e, __ATOMIC_RELAXED, __HIP_MEMORY_SCOPE_WORKGROUP); }
                pv_tile(s, lds + (buf ? L_V1 : L_V0), st, c, g);
            }
            if (t + 1 < nt) tile_store(lds, buf ^ 1, r, tid);
            __syncthreads();
        }
    }
    if (act) { const float g0 = ((const float*)(ws + OFF_GT))[(size_t)tq * 32 + h * 3 + 0];
        float* oc = (float*)(ws + OFF_HID + OV_OC) + (size_t)tq * D_NSA + h * 128 + 4 * g;
#pragma unroll
        for (int dt = 0; dt < 8; ++dt) *(f32x4*)(oc + 16 * dt) = st.o[dt] * g0; }
    for (int qi = 0; qi < 2; ++qi) {
        const int q = 2 * wave + qi, t = tw + q, cur = t >> 6;
        const LAS float* P = Psum + q * PP;
        float sc0, sc1;
        { const int jj = lane; float imp = 0.f;
#pragma unroll
          for (int n = 4 * jj - 1; n <= 4 * jj + 3; ++n) if (n >= 0 && n < NCMP) imp += P[n];
          const bool forced = (jj == 0) || (jj == cur) || (jj == cur - 1);
          sc0 = (jj <= cur) ? imp + (forced ? 1e4f : 0.f) : -1e30f; }
        { const int jj = lane + 64; float imp = 0.f;
#pragma unroll
          for (int n = 4 * jj - 1; n <= 4 * jj + 3; ++n) if (n >= 0 && n < NCMP) imp += P[n];
          const bool forced = (jj == cur) || (jj == cur - 1);
          sc1 = (jj <= cur) ? imp + (forced ? 1e4f : 0.f) : -1e30f; }
        unsigned long long mlo = 0ull, mhi = 0ull;
        for (int r = 0; r < 16; ++r) {
            const float mx = wave_max(fmaxf(sc0, sc1));
            if (!(mx > -1e29f)) break;
            const unsigned long long b0 = __ballot(sc0 == mx);
            if (b0) { const int idx = __builtin_ctzll(b0); mlo |= 1ull << idx; if (lane == idx) sc0 = -INFINITY; }
            else { const unsigned long long b1 = __ballot(sc1 == mx); const int idx = __builtin_ctzll(b1); mhi |= 1ull << idx; if (lane == idx) sc1 = -INFINITY; }
        }
        if (lane == 0) { u32x4 w; w.x = (unsigned)mlo; w.y = (unsigned)(mlo >> 32); w.z = (unsigned)mhi; w.w = (unsigned)(mhi >> 32);
            *(u32x4*)((unsigned*)(ws + OFF_HID + OV_SEL) + ((size_t)t * 2 + grp) * 4) = w; }
    }
}

struct WinF { int tq, tw;
    __device__ __forceinline__ bool relevant(int t) const { return 64 * t <= tw + 15 && 64 * t + 63 >= tw - 511; }
    __device__ __forceinline__ int dq(int t) const { return tq - 64 * t; }
    __device__ __forceinline__ unsigned W() const { return 512u; }
    __device__ __forceinline__ bool en(int) const { return true; } };
struct SlcF { int tq, tw; const LAS unsigned* selrow;
    __device__ __forceinline__ bool en(int t) const { return (selrow[t >> 5] >> (t & 31)) & 1u; }
    __device__ __forceinline__ bool relevant(int t) const { return 64 * t <= tw + 15 && __ballot(en(t)) != 0ull; }
    __device__ __forceinline__ int dq(int t) const { return tq - 64 * t; }
    __device__ __forceinline__ unsigned W() const { return W_CAUSAL; } };
__device__ __forceinline__ void slcwin_unit(const Params& p, LAS unsigned char* lds, int u) {
    const int tid = threadIdx.x, lane = tid & 63, wave = __builtin_amdgcn_readfirstlane(tid >> 6), c = lane & 15, g = lane >> 4;
    const int qb = 63 - u / NH_NSA, h = u % NH_NSA, grp = h / HG;
    unsigned char* ws = p.ws;
    const int tw = 128 * qb + 16 * wave, tq = tw + c;
    const float* GT = (const float*)(ws + OFF_GT) + (size_t)tq * 32 + h * 3;
    QState st; q_load(st, (const bf16_t*)(ws + OFF_QN) + (size_t)tq * D_NSA + h * 128, g);
    LAS unsigned* sel_lds = (LAS unsigned*)(lds + L_MISC);
    sel_lds[tid] = ((const unsigned*)(ws + OFF_HID + OV_SEL))[((size_t)(128 * qb + (tid >> 2)) * 2 + grp) * 4 + (tid & 3)];
    f32x4 res[8];
    { TileSrc src{(const char*)(ws + OFF_KW) + (size_t)grp * S * 256, (const char*)(ws + OFF_VW) + (size_t)grp * S * 256, 256, 256};
      WinF f{tq, tw};
      attn_pass<true>(lds, src, (2 * qb - 8) > 0 ? 2 * qb - 8 : 0, 2 * qb + 2, st, f, tid, c, g);
      const float sc = GT[2] / group_sum(st.l);
#pragma unroll
      for (int dt = 0; dt < 8; ++dt) res[dt] = st.o[dt] * sc; }
    q_reset(st);
    { TileSrc src{(const char*)(ws + OFF_KS) + (size_t)grp * S * 256, (const char*)(ws + OFF_VS) + (size_t)grp * S * 256, 256, 256};
      SlcF f{tq, tw, sel_lds + (16 * wave + c) * 4};
      attn_pass<true>(lds, src, 0, 2 * qb + 2, st, f, tid, c, g);
      const float sc = GT[1] / group_sum(st.l);
#pragma unroll
      for (int dt = 0; dt < 8; ++dt) res[dt] = res[dt] + st.o[dt] * sc; }
    const float* oc = (const float*)(ws + OFF_HID + OV_OC) + (size_t)tq * D_NSA + h * 128 + 4 * g;
    bf16_t* mx = (bf16_t*)(ws + OFF_XB) + (size_t)tq * DM + D_DIL + h * 128 + 4 * g;
#pragma unroll
    for (int dt = 0; dt < 8; ++dt) { const f32x4 o = res[dt] + *(const f32x4*)(oc + 16 * dt);
        u32x2 w; w.x = pg8::cvt_pk_bf16(o[0], o[1]); w.y = pg8::cvt_pk_bf16(o[2], o[3]); *(u32x2*)(mx + 16 * dt) = w; }
}
}


#ifndef NAIVE_COMPRESS
#define NAIVE_COMPRESS 0
#endif
#ifndef NAIVE_DIL
#define NAIVE_DIL 0
#endif
#ifndef NAIVE_NSA
#define NAIVE_NSA 0
#endif
__device__ __forceinline__ void phase_mix_a(const Params& p, LAS unsigned char* lds, int rep) {
#if NAIVE_COMPRESS
    compress_naive(p, lds);
#endif
#if NAIVE_DIL
    dilated_naive(p, lds);
#endif
#if !NAIVE_COMPRESS || !NAIVE_DIL
    unsigned* ctr = (unsigned*)(p.ws + OFF_CTL) + 0 + 4 * rep;
    constexpr int NC = NAIVE_COMPRESS ? 0 : 128, ND = NAIVE_DIL ? 0 : 1152;
    for (;;) { const int u = att::next_unit(ctr, lds); if (u >= NC + ND) break;
        if (u < NC) att::compress_unit(p, lds, u); else att::dil_unit(p, lds, u - NC); }
#endif
}
__device__ __forceinline__ void phase_mix_b(const Params& p, LAS unsigned char* lds, int rep) {
#if !NAIVE_NSA
    unsigned* ctr = (unsigned*)(p.ws + OFF_CTL) + 1 + 4 * rep;
    for (;;) { const int u = att::next_unit(ctr, lds); if (u >= 1024) break; att::cmp_unit(p, lds, u); }
#endif
#if !NAIVE_DIL
    att::dil_merge(p);
#endif
}
__device__ __forceinline__ void phase_mix_c(const Params& p, LAS unsigned char* lds, int rep) {
#if NAIVE_NSA
    nsa_naive(p, lds);
#else
    unsigned* ctr = (unsigned*)(p.ws + OFF_CTL) + 2 + 4 * rep;
    for (;;) { const int u = att::next_unit(ctr, lds); if (u >= 640) break; att::slcwin_unit(p, lds, u); }
#endif
}


#define XB_TMO      128
#define XB_XCNT(j)  (256  + 64 * (j))
#define XB_XSUB(j)  (1280 + 64 * (j))
#define XB_XGEN(j)  (2304 + 64 * (j))
#define XB_TOP      3328
#define XB_TOPGEN   3392
#define XCD_BAR_WORDS 3456
#define XB_SPIN_CAP (1u << 22)
constexpr int CW_BAR = 4096;
constexpr int L_BARST = 143376;
__device__ __forceinline__ unsigned xb_ld(unsigned* p)              { return __hip_atomic_load(p, __ATOMIC_RELAXED, __HIP_MEMORY_SCOPE_AGENT); }
__device__ __forceinline__ unsigned xb_add(unsigned* p, unsigned v) { return __hip_atomic_fetch_add(p, v, __ATOMIC_RELAXED, __HIP_MEMORY_SCOPE_AGENT); }
__device__ __forceinline__ unsigned xb_xcc_id() { return (unsigned)__builtin_amdgcn_s_getreg((3 << 11) | 20) & 0xFu; }
#define XB_SPIN(cond, bar) do { unsigned _sp = 0; while (cond) { __builtin_amdgcn_s_sleep(1); \
    if ((++_sp & 255u) == 0u) { if (xb_ld(&(bar)[XB_TMO])) break; if (_sp > XB_SPIN_CAP) { atomicAdd(&(bar)[XB_TMO], 1u); break; } } } } while (0)
struct XcdBarrier { unsigned* bar; unsigned x; volatile LAS unsigned* st; };
__device__ __forceinline__ XcdBarrier xcd_barrier_post(unsigned* bar, volatile LAS unsigned* st) {
    XcdBarrier b; b.bar = bar; b.x = xb_xcc_id(); b.st = st;
    if (threadIdx.x == 0) (void)xb_add(&bar[XB_XCNT(b.x)], 1u);
    return b;
}
__device__ __forceinline__ void xcd_barrier_complete(unsigned* bar, unsigned x, unsigned& nloc, unsigned& nx) {
    const unsigned G = gridDim.x * gridDim.y * gridDim.z;
    unsigned sum, cnt, mine, sp = 0u;
    for (;;) {
        sum = 0u; cnt = 0u; mine = 0u;
#pragma unroll
        for (unsigned j = 0; j < 16; ++j) { const unsigned c = xb_ld(&bar[XB_XCNT(j)]); sum += c; cnt += (c > 0u) ? 1u : 0u; mine = (j == x) ? c : mine; }
        if (sum == G) break;
        __builtin_amdgcn_s_sleep(1);
        if ((++sp & 255u) == 0u) { if (xb_ld(&bar[XB_TMO])) break; if (sp > XB_SPIN_CAP) { atomicAdd(&bar[XB_TMO], 1u); break; } }
    }
    nloc = mine > 0u ? mine : 1u; nx = cnt > 0u ? cnt : 1u;
}
__device__ __forceinline__ void xcd_barrier(const XcdBarrier& b) {
    asm volatile("s_waitcnt vmcnt(0)" ::: "memory");
    __syncthreads();
    if (threadIdx.x == 0) {
        unsigned* bar = b.bar;
        __builtin_amdgcn_s_waitcnt(0);
        unsigned nloc = b.st[0], nx = b.st[1];
        if (nloc == 0u) { xcd_barrier_complete(bar, b.x, nloc, nx); b.st[0] = nloc; b.st[1] = nx; }
        const unsigned old = xb_add(&bar[XB_XSUB(b.x)], 1u);
        const unsigned gen = old / nloc;
        if (old + 1u == (gen + 1u) * nloc) {
            __builtin_amdgcn_fence(__ATOMIC_RELEASE, "agent");
            asm volatile("s_waitcnt vmcnt(0)" ::: "memory");
            const unsigned og = xb_add(&bar[XB_TOP], 1u);
            const unsigned tg = og / nx;
            if (og + 1u == (tg + 1u) * nx) xb_add(&bar[XB_TOPGEN], 1u);
            else XB_SPIN(xb_ld(&bar[XB_TOPGEN]) == tg, bar);
            __builtin_amdgcn_fence(__ATOMIC_ACQUIRE, "agent");
            xb_add(&bar[XB_XGEN(b.x)], 1u);
            asm volatile("s_waitcnt vmcnt(0)" ::: "memory");
        } else {
            XB_SPIN(xb_ld(&bar[XB_XGEN(b.x)]) == gen, bar);
            __builtin_amdgcn_fence(__ATOMIC_ACQUIRE, "agent");
            asm volatile("s_waitcnt vmcnt(0)" ::: "memory");
        }
    }
    __syncthreads();
}

constexpr int N_PHASES = 13;
__global__ void __launch_bounds__(NTHREADS, 2) fwd_kernel(Params p) {
    extern __shared__ __attribute__((aligned(16))) unsigned char lds_raw[];
    LAS unsigned char* lds = (LAS unsigned char*)lds_raw;
    cg::grid_group grid = cg::this_grid();
    unsigned char* ws = p.ws;
    bf16_t* XB = (bf16_t*)(ws + OFF_XB); bf16_t* HID = (bf16_t*)(ws + OFF_HID);
    const int lo = p.ph_lo, hi = p.ph_hi;
    if (threadIdx.x < 2) ((volatile LAS unsigned*)(lds + L_BARST))[threadIdx.x] = 0u;
    __syncthreads();
    XcdBarrier bar; bar.bar = nullptr; bar.x = 0; bar.st = nullptr; bool bar_up = false;
#define IN(k) (lo <= (k) && (k) < hi)
#define REPS(k) for (int rep = 0; rep < 1 + ((PROBE_REP_MASK >> (k)) & 1); ++rep)
#define SEAM(k) do { if (IN(k) && IN((k) + 1)) { if (!bar_up) { grid.sync(); bar = xcd_barrier_post((unsigned*)(ws + OFF_CTL) + CW_BAR, (volatile LAS unsigned*)(lds + L_BARST)); bar_up = true; } else xcd_barrier(bar); } } while (0)
    if (IN(0)) { REPS(0) p0_prologue(p, lds); }
    SEAM(0);
    if (IN(1)) REPS(1) { pg8::Gemm g{XB, (const bf16_t*)(ws + OFF_W13A), S, 2 * DFF, DM}; pg8::StaticOrder so; so.init(S, 2 * DFF, gridDim.x, blockIdx.x);
        pg8::EpiSwiglu E{HID}; pg8::gemm_phase<pg8::EpiSwiglu, pg8::StaticOrder, true, true>(lds, g, so, E); }
    SEAM(1);
    if (IN(2)) REPS(2) { pg8::Gemm g{HID, (const bf16_t*)(ws + OFF_W2A), S, DM, DFF}; pg8::StaticOrder so; so.init(S, DM, gridDim.x, blockIdx.x);
        pg8::EpiResid E{p.x, p.out, ALPHA, 0.5f}; pg8::gemm_phase<pg8::EpiResid, pg8::StaticOrder, true, true>(lds, g, so, E); }
    SEAM(2);
    if (IN(3)) { ln_phase(p.out, p.out, XB, p.ln1g, p.ln1b); }
    SEAM(3);
    if (IN(4)) REPS(4) { pg8::Gemm g{XB, (const bf16_t*)(ws + OFF_WIN), S, IN_PAD, DM}; pg8::StaticOrder so; so.init(S, IN_PAD, gridDim.x, blockIdx.x);
        pg8::EpiInProj E{(bf16_t*)(ws + OFF_QA), (bf16_t*)(ws + OFF_KA), (bf16_t*)(ws + OFF_VA), (bf16_t*)(ws + OFF_QN), (bf16_t*)(ws + OFF_KS), (bf16_t*)(ws + OFF_VS),
                         (bf16_t*)(ws + OFF_KW), (bf16_t*)(ws + OFF_VW), (float*)(ws + OFF_KCT), (float*)(ws + OFF_VCT), (float*)(ws + OFF_GT),
                         (const float*)(ws + OFF_ROPE), (const float*)(ws + OFF_ROPE) + (size_t)S * 64, p.gateb};
        pg8::gemm_phase<pg8::EpiInProj, pg8::StaticOrder, true, true>(lds, g, so, E); }
    SEAM(4);
    if (IN(5)) { REPS(5) phase_mix_a(p, lds, rep); }
    SEAM(5);
    if (IN(6)) { REPS(6) phase_mix_b(p, lds, rep); }
    SEAM(6);
    if (IN(7)) { REPS(7) phase_mix_c(p, lds, rep); }
    SEAM(7);
    if (IN(8)) { pg8::Gemm g{XB, (const bf16_t*)(ws + OFF_WOUT), S, DM, DM}; pg8::StaticOrder so; so.init(S, DM, gridDim.x, blockIdx.x);
        pg8::EpiResid E{p.out, p.out, ALPHA, 1.0f}; pg8::gemm_phase<pg8::EpiResid, pg8::StaticOrder, true, true>(lds, g, so, E); }
    SEAM(8);
    if (IN(9)) { ln_phase(p.out, p.out, XB, p.ln2g, p.ln2b); }
    SEAM(9);
    if (IN(10)) { pg8::Gemm g{XB, (const bf16_t*)(ws + OFF_W13B), S, 2 * DFF, DM}; pg8::StaticOrder so; so.init(S, 2 * DFF, gridDim.x, blockIdx.x);
        pg8::EpiSwiglu E{HID}; pg8::gemm_phase<pg8::EpiSwiglu, pg8::StaticOrder, true, true>(lds, g, so, E); }
    SEAM(10);
    if (IN(11)) { pg8::Gemm g{HID, (const bf16_t*)(ws + OFF_W2B), S, DM, DFF}; pg8::StaticOrder so; so.init(S, DM, gridDim.x, blockIdx.x);
        pg8::EpiResid E{p.out, p.out, ALPHA, 0.5f}; pg8::gemm_phase<pg8::EpiResid, pg8::StaticOrder, true, true>(lds, g, so, E); }
    SEAM(11);
    if (IN(12)) { ln_phase(p.out, p.out, nullptr, p.ln3g, p.ln3b); }
#undef IN
#undef SEAM
}

extern "C" void kernel_launch(void* const* d_in, const int* in_sizes, int n_in, void* d_out, int out_size, void* d_ws, size_t ws_size, hipStream_t stream) {
    static int grid = 0;
    if (grid == 0) {
        if (n_in != 22 || in_sizes[0] != S * DM || out_size != S * DM || ws_size < WS_END) {
            fprintf(stderr, "kernel_launch: unexpected shapes: n_in %d in0 %d out %d ws %zu (need >= %zu)\n", n_in, n_in > 0 ? in_sizes[0] : -1, out_size, ws_size, (size_t)WS_END); grid = -1; return; }
        int dev = 0, cus = 0, per_cu = 0;
        if (hipGetDevice(&dev) != hipSuccess || hipDeviceGetAttribute(&cus, hipDeviceAttributeMultiprocessorCount, dev) != hipSuccess) { fprintf(stderr, "kernel_launch: device query failed\n"); grid = -1; return; }
        if (hipFuncSetAttribute((const void*)fwd_kernel, hipFuncAttributeMaxDynamicSharedMemorySize, LDS_BYTES) != hipSuccess) { fprintf(stderr, "kernel_launch: hipFuncSetAttribute failed\n"); grid = -1; return; }
        if (hipOccupancyMaxActiveBlocksPerMultiprocessor(&per_cu, (const void*)fwd_kernel, NTHREADS, LDS_BYTES) != hipSuccess || per_cu < 1) { fprintf(stderr, "kernel_launch: occupancy query gave %d\n", per_cu); per_cu = 1; }
        (void)hipGetLastError();
        grid = cus;
    }
    if (grid < 0) return;
    Params p{};
    p.x = (const float*)d_in[0]; p.pos = (const int*)d_in[1];
    p.ln1g = (const float*)d_in[2]; p.ln1b = (const float*)d_in[3]; p.f1w1 = (const float*)d_in[4]; p.f1w3 = (const float*)d_in[5]; p.f1w2 = (const float*)d_in[6];
    p.win = (const float*)d_in[7]; p.gateb = (const float*)d_in[8]; p.cpe = (const float*)d_in[9]; p.cw1 = (const float*)d_in[10]; p.cb1 = (const float*)d_in[11];
    p.cw2 = (const float*)d_in[12]; p.cb2 = (const float*)d_in[13]; p.wout = (const float*)d_in[14]; p.ln2g = (const float*)d_in[15]; p.ln2b = (const float*)d_in[16];
    p.f2w1 = (const float*)d_in[17]; p.f2w3 = (const float*)d_in[18]; p.f2w2 = (const float*)d_in[19]; p.ln3g = (const float*)d_in[20]; p.ln3b = (const float*)d_in[21];
    p.out = (float*)d_out; p.ws = (unsigned char*)d_ws;
#if N_LAUNCH_PER_PHASE
    for (int k = 0; k < N_PHASES; ++k) {
        p.ph_lo = k; p.ph_hi = k + 1;
        void* args[] = {&p};
        hipError_t e = hipLaunchCooperativeKernel((const void*)fwd_kernel, dim3(grid), dim3(NTHREADS), args, LDS_BYTES, stream);
        if (e != hipSuccess) { fprintf(stderr, "kernel_launch: launch of phase %d failed: %s\n", k, hipGetErrorString(e)); break; }
    }
#else
    p.ph_lo = 0; p.ph_hi = N_PHASES;
    void* args[] = {&p};
    hipError_t e = hipLaunchCooperativeKernel((const void*)fwd_kernel, dim3(grid), dim3(NTHREADS), args, LDS_BYTES, stream);
    if (e != hipSuccess) fprintf(stderr, "kernel_launch: cooperative launch failed: %s (grid %d)\n", hipGetErrorString(e), grid);
#endif
}
```

```cpp
#include <hip/hip_runtime.h>
#include <hip/hip_cooperative_groups.h>
#include <cstdio>
#include <cstdint>
namespace cg = cooperative_groups;

#ifndef PROBE_REP_MASK
#define PROBE_REP_MASK 0
#endif
#ifndef N_LAUNCH_PER_PHASE
#define N_LAUNCH_PER_PHASE 0
#endif

#define LAS __attribute__((address_space(3)))
typedef unsigned short bf16_t;
typedef short bf16x8 __attribute__((ext_vector_type(8)));
typedef float f32x4 __attribute__((ext_vector_type(4)));
typedef float f32x2 __attribute__((ext_vector_type(2)));
typedef unsigned u32x4 __attribute__((ext_vector_type(4)));
typedef unsigned u32x2 __attribute__((ext_vector_type(2)));

constexpr int S = 8192, DM = 2048, DFF = 5632, HD = 128;
constexpr int NH_DIL = 6, NH_NSA = 10, NG = 2, HG = 5;
constexpr int D_DIL = 768, D_NSA = 1280;
constexpr int IN_COLS = 5150, IN_PAD = 5376;
constexpr int NCMP = 511;
constexpr float LN_EPS = 1e-5f;
constexpr float ALPHA = 1.189207115002721f;
constexpr float QSCALE = 0.08838834764831845f * 1.4426950408889634f;
constexpr int NTHREADS = 512, NWAVES = 8;

constexpr size_t MiB = 1u << 20;
constexpr size_t OFF_CTL = 0;
constexpr size_t OFF_W13A = 1 * MiB, OFF_W2A = 45 * MiB, OFF_W13B = 67 * MiB, OFF_W2B = 111 * MiB;
constexpr size_t OFF_WIN = 133 * MiB, OFF_WOUT = 154 * MiB, OFF_CW1T = 162 * MiB, OFF_CW2T = 166 * MiB;
constexpr size_t OFF_ROPE = 167 * MiB;
constexpr size_t OFF_XB = 171 * MiB;
constexpr size_t OFF_HID = 203 * MiB;
constexpr size_t OFF_QA = 291 * MiB, OFF_KA = 303 * MiB, OFF_VA = 315 * MiB, OFF_QN = 327 * MiB;
constexpr size_t OFF_KCT = 347 * MiB, OFF_VCT = 355 * MiB;
constexpr size_t OFF_KS = 363 * MiB, OFF_VS = 367 * MiB, OFF_KW = 371 * MiB, OFF_VW = 375 * MiB;
constexpr size_t OFF_GT = 379 * MiB;
constexpr size_t OFF_KC = 380 * MiB;
constexpr size_t OFF_VC = OFF_KC + 256 * 1024;
constexpr size_t WS_END = 381 * MiB;

constexpr int LDS_BYTES = 147456;
constexpr int XCD_BAR_WORDS_C = 3456, CW_BAR_C = 4096;

__constant__ double INV_FREQ[64] = {
1.0, 0.8659643233600653, 0.7498942093324559, 0.6493816315762113,
0.5623413251903491, 0.4869675251658631, 0.4216965034285822, 0.3651741272548377,
0.31622776601683794, 0.27384196342643613, 0.23713737056616552, 0.2053525026457146,
0.1778279410038923, 0.1539926526059492, 0.1333521432163324, 0.11547819846894582,
0.1, 0.08659643233600653, 0.07498942093324558, 0.06493816315762113,
0.05623413251903491, 0.04869675251658631, 0.042169650342858224, 0.03651741272548377,
0.03162277660168379, 0.027384196342643614, 0.023713737056616554, 0.02053525026457146,
0.01778279410038923, 0.01539926526059492, 0.01333521432163324, 0.011547819846894581,
0.01, 0.008659643233600654, 0.007498942093324558, 0.006493816315762113,
0.005623413251903491, 0.004869675251658631, 0.004216965034285823, 0.003651741272548377,
0.0031622776601683794, 0.0027384196342643613, 0.0023713737056616554, 0.002053525026457146,
0.0017782794100389228, 0.001539926526059492, 0.001333521432163324, 0.0011547819846894581,
0.001, 0.0008659643233600654, 0.0007498942093324559, 0.0006493816315762113,
0.0005623413251903491, 0.0004869675251658631, 0.00042169650342858224, 0.0003651741272548377,
0.00031622776601683794, 0.0002738419634264361, 0.00023713737056616554, 0.0002053525026457146,
0.00017782794100389227, 0.0001539926526059492, 0.0001333521432163324, 0.00011547819846894582 };

__device__ __forceinline__ unsigned f2bf(float f) { unsigned u = __builtin_bit_cast(unsigned, f); return (u + 0x7fffu + ((u >> 16) & 1u)) >> 16; }
__device__ __forceinline__ unsigned pk2(float lo, float hi) { return f2bf(lo) | (f2bf(hi) << 16); }
__device__ __forceinline__ float bflo(unsigned u) { return __uint_as_float(u << 16); }
__device__ __forceinline__ float bfhi(unsigned u) { return __uint_as_float(u & 0xffff0000u); }
__device__ __forceinline__ float wave_sum(float v) {
#pragma unroll
    for (int o = 1; o < 64; o <<= 1) v += __shfl_xor(v, o);
    return v;
}
__device__ __forceinline__ float wave_max(float v) {
#pragma unroll
    for (int o = 1; o < 64; o <<= 1) v = fmaxf(v, __shfl_xor(v, o));
    return v;
}
__device__ __forceinline__ float fast_exp2(float x) { return __builtin_amdgcn_exp2f(x); }
__device__ __forceinline__ float fast_rcp(float x) { return __builtin_amdgcn_rcpf(x); }
__device__ __forceinline__ void rope_cs(double pos, int i, float& c, float& s) {
    const double rev = pos * INV_FREQ[i] * 0.15915494309189535;
    const double fr = rev - __builtin_rint(rev);
    const float f = (float)fr;
    c = __builtin_amdgcn_cosf(f); s = __builtin_amdgcn_sinf(f);
}

namespace pg8 {
constexpr int BM = 256, BK = 64, HALF = 128, HTB = HALF * BK * 2, STAGE_BYTES = 8 * HTB, NXCD = 8, WGM = 8;
__host__ __device__ __forceinline__ int lds_byte(int r, int c) { const int st = (r >> 4) * 2 + (c >> 5), rr = r & 15, cc = c & 31, ob = rr * 64 + cc * 2; return st * 1024 + (ob ^ (((ob >> 9) & 1) << 5)); }
__host__ __device__ __forceinline__ void stage_rc(int b, int& R, int& C) { const int st = b / 1024, sb = b % 1024, swz = sb ^ (((sb >> 9) & 1) << 5); R = (st >> 1) * 16 + swz / 64; C = (st & 1) * 32 + (swz % 64) / 2; }
__host__ __device__ __forceinline__ int perm32(int rho) { const int n = rho >> 4, i = rho & 15; return 8 * (i >> 2) + 4 * n + (i & 3); }
struct Unit { int pm, pn; };
struct Gemm { const bf16_t* A; const bf16_t* Bt; int M, N, K; };
struct StaticOrder {
    int nM, nN, nwg, G, c;
    __host__ __device__ void init(int M, int N, int G_, int c_) { nM = M / BM; nN = N / BM; nwg = nM * nN; G = G_; c = c_; }
    __host__ __device__ bool next(int i, Unit& u) const {
        const long L = (long)i * G + c; if (L >= nwg) return false;
        int wgid = (int)L; { const int q = nwg / NXCD, r = nwg % NXCD, xcd = wgid % NXCD, off = wgid / NXCD; wgid = (xcd < r ? xcd * (q + 1) : r * (q + 1) + (xcd - r) * q) + off; }
        const int nig = WGM * nN, gid = wgid / nig, fm = gid * WGM, gsz = (nM - fm) < WGM ? (nM - fm) : WGM;
        u.pm = fm + ((wgid % nig) % gsz); u.pn = (wgid % nig) / gsz; return true;
    }
    __device__ __forceinline__ void a_ready(const Unit&) const {}
    __device__ __forceinline__ void done(const Unit&) const {}
};
__device__ __forceinline__ unsigned cvt_pk_bf16(float lo, float hi) { unsigned r; asm volatile("v_cvt_pk_bf16_f32 %0, %1, %2" : "=v"(r) : "v"(lo), "v"(hi)); return r; }

template <class Epi, class Sched, bool ALIGN_EPI = false, bool SP2 = false>
__device__ __forceinline__ void gemm_phase(LAS unsigned char* lds, const Gemm g, const Sched& S, const Epi& E) {
    const int tid = threadIdx.x, wid = __builtin_amdgcn_readfirstlane(tid >> 6), lane = tid & 63, wr = wid >> 2, wc = wid & 3, fr = lane & 15, fq = lane >> 4;
    const int K = g.K, nt = K / BK;
    unsigned voffA[2], voffB[2];
#pragma unroll
    for (int i = 0; i < 2; ++i) { int R, C; stage_rc(tid * 16 + i * 8192, R, C); const int Rb = Epi::PERM ? ((R & ~31) + perm32(R & 31)) : R;
        voffA[i] = (unsigned)(R * K + C) * 2u; voffB[i] = (unsigned)(Rb * K + C) * 2u; }
    const size_t kstep = (size_t)(BK * 2);
    const size_t hstep = (size_t)HALF * K * 2;
    const size_t tstep = 2 * hstep;
    const unsigned ldsw = (unsigned)wid * 1024u;
    const int aoff = lds_byte(wr * 64 + fr, fq * 8), boff = lds_byte(wc * 32 + fr, fq * 8);
#define PG8_SA(b, h) (((b) * 2 + (h)) * HTB)
#define PG8_SB(b, h) ((4 + (b) * 2 + (h)) * HTB)
#define PG8_STAGE(bufoff, gbase, voff) do { _Pragma("unroll") for (int _i = 0; _i < 2; ++_i) \
        __builtin_amdgcn_global_load_lds((const unsigned*)((const char*)(gbase) + (voff)[_i]), (LAS unsigned*)(lds + (bufoff) + ldsw + _i * 8192), 16, 0, 0); } while (0)
#define PG8_LDA(dst, b, h) do { _Pragma("unroll") for (int m = 0; m < 4; ++m) _Pragma("unroll") for (int k = 0; k < 2; ++k) dst[m][k] = *(const LAS bf16x8*)(lds + PG8_SA(b, h) + aoff + m * 2048 + k * 1024); } while (0)
#define PG8_LDB(dst, b, h) do { _Pragma("unroll") for (int n = 0; n < 2; ++n) _Pragma("unroll") for (int k = 0; k < 2; ++k) dst[n][k] = *(const LAS bf16x8*)(lds + PG8_SB(b, h) + boff + n * 2048 + k * 1024); } while (0)
#define PG8_MMA(ai, bj, At, Bt) do { __builtin_amdgcn_s_setprio(1); _Pragma("unroll") for (int m = 0; m < 4; ++m) _Pragma("unroll") for (int n = 0; n < 2; ++n) _Pragma("unroll") for (int k = 0; k < 2; ++k) \
        acc[ai][bj][m][n] = __builtin_amdgcn_mfma_f32_16x16x32_bf16(Bt[n][k], At[m][k], acc[ai][bj][m][n], 0, 0, 0); __builtin_amdgcn_s_setprio(0); } while (0)
#define PG8_WAIT_V(n) asm volatile("s_waitcnt vmcnt(" #n ")" ::: "memory")
#define PG8_WAIT_L(n) asm volatile("s_waitcnt lgkmcnt(" #n ")" ::: "memory")
#define PG8_BAR __builtin_amdgcn_s_barrier()
#define PG8_SCHED __builtin_amdgcn_sched_barrier(0)
    Unit cur, nxt; int ui = 0;
    if (!S.next(0, cur)) return;
    f32x4 acc[2][2][4][2];
#pragma unroll
    for (int a = 0; a < 2; ++a)
#pragma unroll
        for (int b = 0; b < 2; ++b)
#pragma unroll
            for (int m = 0; m < 4; ++m)
#pragma unroll
                for (int n = 0; n < 2; ++n) acc[a][b][m][n] = (f32x4){0.f, 0.f, 0.f, 0.f};
    bf16x8 At[4][2], B0[2][2], B1[2][2];
    const char* cA = (const char*)g.A + (size_t)cur.pm * tstep; const char* cB = (const char*)g.Bt + (size_t)cur.pn * tstep;
    S.a_ready(cur);
    if constexpr (SP2) {
        PG8_STAGE(PG8_SB(0, 0), cB, voffB); PG8_STAGE(PG8_SB(0, 1), cB + hstep, voffB); PG8_STAGE(PG8_SA(0, 0), cA, voffA); PG8_STAGE(PG8_SA(0, 1), cA + hstep, voffA);
        if (wr == 1) PG8_BAR;
        PG8_WAIT_V(2); PG8_BAR;
        PG8_STAGE(PG8_SB(1, 0), cB + kstep, voffB); PG8_STAGE(PG8_SA(1, 0), cA + kstep, voffA); PG8_STAGE(PG8_SB(1, 1), cB + hstep + kstep, voffB);
        PG8_WAIT_V(6); PG8_BAR;
    } else {
        PG8_STAGE(PG8_SB(0, 0), cB, voffB); PG8_STAGE(PG8_SA(0, 0), cA, voffA); PG8_STAGE(PG8_SB(0, 1), cB + hstep, voffB); PG8_STAGE(PG8_SA(0, 1), cA + hstep, voffA);
        if (wr == 1) PG8_BAR;
        PG8_WAIT_V(4); PG8_BAR;
        PG8_STAGE(PG8_SB(1, 0), cB + kstep, voffB); PG8_STAGE(PG8_SA(1, 0), cA + kstep, voffA); PG8_STAGE(PG8_SB(1, 1), cB + hstep + kstep, voffB);
        PG8_WAIT_V(6); PG8_BAR;
    }
    for (;;) {
        const bool has_next = S.next(ui + 1, nxt);
        const char* nA = has_next ? (const char*)g.A + (size_t)nxt.pm * tstep : cA; const char* nB = has_next ? (const char*)g.Bt + (size_t)nxt.pn * tstep : cB;
        for (int t = 0; t < nt; t += 2) {
            const bool last = (t == nt - 2);
            const char* a1 = cA + (size_t)(t + 1) * kstep;
            const char* a2 = last ? nA : cA + (size_t)(t + 2) * kstep; const char* b2 = last ? nB : cB + (size_t)(t + 2) * kstep;
            const char* a3 = a2 + kstep; const char* b3 = b2 + kstep;
            if (last && has_next) S.a_ready(nxt);
            if constexpr (SP2) {
            PG8_LDB(B0, 0, 0); PG8_LDB(B1, 0, 1); PG8_SCHED; PG8_LDA(At, 0, 0); PG8_STAGE(PG8_SA(1, 1), a1 + hstep, voffA);
            PG8_WAIT_V(8); PG8_WAIT_L(0); PG8_BAR; PG8_MMA(0, 0, At, B0); PG8_MMA(0, 1, At, B1); PG8_BAR; PG8_SCHED;
            PG8_LDA(At, 0, 1); PG8_STAGE(PG8_SB(0, 0), b2, voffB); PG8_STAGE(PG8_SB(0, 1), b2 + hstep, voffB); PG8_STAGE(PG8_SA(0, 0), a2, voffA);
            PG8_WAIT_V(8); PG8_WAIT_L(0); PG8_BAR; PG8_MMA(1, 0, At, B0); PG8_MMA(1, 1, At, B1); PG8_BAR; PG8_SCHED;
            PG8_LDB(B0, 1, 0); PG8_LDB(B1, 1, 1); PG8_SCHED; PG8_LDA(At, 1, 0); PG8_STAGE(PG8_SA(0, 1), a2 + hstep, voffA);
            PG8_WAIT_V(8); PG8_WAIT_L(0); PG8_BAR; PG8_MMA(0, 0, At, B0); PG8_MMA(0, 1, At, B1); PG8_BAR; PG8_SCHED;
            PG8_LDA(At, 1, 1); PG8_STAGE(PG8_SB(1, 0), b3, voffB); PG8_STAGE(PG8_SB(1, 1), b3 + hstep, voffB); PG8_STAGE(PG8_SA(1, 0), a3, voffA);
            PG8_WAIT_V(8); PG8_WAIT_L(0); PG8_BAR; PG8_MMA(1, 0, At, B0); PG8_MMA(1, 1, At, B1); PG8_BAR; PG8_SCHED;
            } else {
            PG8_LDB(B0, 0, 0); PG8_SCHED; PG8_LDA(At, 0, 0); PG8_STAGE(PG8_SA(1, 1), a1 + hstep, voffA);
            PG8_WAIT_L(8); PG8_BAR; PG8_WAIT_L(0); PG8_MMA(0, 0, At, B0); PG8_BAR; PG8_SCHED;
            PG8_LDB(B1, 0, 1); PG8_STAGE(PG8_SB(0, 0), b2, voffB);
            PG8_BAR; PG8_WAIT_L(0); PG8_MMA(0, 1, At, B1); PG8_BAR;
            PG8_LDA(At, 0, 1); PG8_STAGE(PG8_SA(0, 0), a2, voffA);
            PG8_BAR; PG8_WAIT_L(0); PG8_MMA(1, 0, At, B0); PG8_BAR; PG8_SCHED;
            PG8_STAGE(PG8_SB(0, 1), b2 + hstep, voffB);
            PG8_WAIT_V(6); PG8_BAR; PG8_MMA(1, 1, At, B1); PG8_BAR;
            PG8_LDB(B0, 1, 0); PG8_SCHED; PG8_LDA(At, 1, 0); PG8_STAGE(PG8_SA(0, 1), a2 + hstep, voffA);
            PG8_WAIT_L(8); PG8_BAR; PG8_WAIT_L(0); PG8_MMA(0, 0, At, B0); PG8_BAR; PG8_SCHED;
            PG8_LDB(B1, 1, 1); PG8_STAGE(PG8_SB(1, 0), b3, voffB);
            PG8_BAR; PG8_WAIT_L(0); PG8_MMA(0, 1, At, B1); PG8_BAR;
            PG8_LDA(At, 1, 1); PG8_STAGE(PG8_SA(1, 0), a3, voffA);
            PG8_BAR; PG8_WAIT_L(0); PG8_MMA(1, 0, At, B0); PG8_BAR; PG8_SCHED;
            PG8_STAGE(PG8_SB(1, 1), b3 + hstep, voffB);
            PG8_WAIT_V(6); PG8_BAR; PG8_MMA(1, 1, At, B1); PG8_BAR;
            }
        }
        if constexpr (ALIGN_EPI) { if (wr == 0) PG8_BAR; }
        E(acc, cur, wr, wc, fr, fq);
        if (!has_next) break;
#pragma unroll
        for (int a = 0; a < 2; ++a)
#pragma unroll
            for (int b = 0; b < 2; ++b)
#pragma unroll
                for (int m = 0; m < 4; ++m)
#pragma unroll
                    for (int n = 0; n < 2; ++n) acc[a][b][m][n] = (f32x4){0.f, 0.f, 0.f, 0.f};
        cur = nxt; cA = nA; cB = nB; ++ui;
        if constexpr (ALIGN_EPI) { if (wr == 1) PG8_BAR; }
    }
    PG8_WAIT_V(0);
    if constexpr (!ALIGN_EPI) { if (wr == 0) PG8_BAR; }
    PG8_BAR;
#undef PG8_SA
#undef PG8_SB
#undef PG8_STAGE
#undef PG8_LDA
#undef PG8_LDB
#undef PG8_MMA
#undef PG8_WAIT_V
#undef PG8_WAIT_L
#undef PG8_BAR
#undef PG8_SCHED
}

struct EpiSwiglu {
    static constexpr bool PERM = true;
    bf16_t* H;
    __device__ __forceinline__ void operator()(const f32x4 (&acc)[2][2][4][2], const Unit& u, int wr, int wc, int fr, int fq) const {
        const int row0 = u.pm * BM + wr * 64 + fr, col0 = u.pn * HALF + wc * 32 + 8 * fq;
#pragma unroll
        for (int ai = 0; ai < 2; ++ai)
#pragma unroll
            for (int m = 0; m < 4; ++m) {
                bf16_t* rowp = H + (size_t)(row0 + ai * HALF + m * 16) * DFF + col0;
                float o[8];
#pragma unroll
                for (int n = 0; n < 2; ++n)
#pragma unroll
                    for (int j = 0; j < 4; ++j) { const float a = acc[ai][0][m][n][j], b = acc[ai][1][m][n][j];
                        const float sg = fast_rcp(1.0f + fast_exp2(-1.4426950408889634f * a)); o[n * 4 + j] = a * sg * b; }
                u32x4 w; w.x = cvt_pk_bf16(o[0], o[1]); w.y = cvt_pk_bf16(o[2], o[3]); w.z = cvt_pk_bf16(o[4], o[5]); w.w = cvt_pk_bf16(o[6], o[7]);
                *(u32x4*)rowp = w;
            }
    }
};
struct EpiResid {
    static constexpr bool PERM = false;
    const float* resid; float* out; float alpha, beta;
    __device__ __forceinline__ void operator()(const f32x4 (&acc)[2][2][4][2], const Unit& u, int wr, int wc, int fr, int fq) const {
        const int col0 = u.pn * BM + wc * 32 + 4 * fq;
#pragma unroll
        for (int ai = 0; ai < 2; ++ai)
#pragma unroll
            for (int m = 0; m < 4; ++m) { const size_t off = (size_t)(u.pm * BM + ai * HALF + wr * 64 + m * 16 + fr) * DM + col0;
#pragma unroll
                for (int bj = 0; bj < 2; ++bj)
#pragma unroll
                    for (int n = 0; n < 2; ++n) { const size_t c = off + bj * HALF + n * 16; const f32x4 r = *(const f32x4*)(resid + c);
                        *(f32x4*)(out + c) = r * alpha + acc[ai][bj][m][n] * beta; } }
    }
};
struct EpiInProj {
    static constexpr bool PERM = false;
    bf16_t *QA, *KA, *VA, *QN, *KS, *VS, *KW, *VW; float *KCT, *VCT, *GT; const float *cosT, *sinT, *gateb;
    __device__ __forceinline__ void operator()(const f32x4 (&acc)[2][2][4][2], const Unit& u, int wr, int wc, int fr, int fq) const {
        const int pn = u.pn;
        const int d0 = 16 * wc + 4 * fq;
        if (pn == 20) {
#pragma unroll
            for (int ai = 0; ai < 2; ++ai)
#pragma unroll
                for (int m = 0; m < 4; ++m) { const int row = u.pm * BM + ai * HALF + wr * 64 + m * 16 + fr;
#pragma unroll
                    for (int j = 0; j < 4; ++j) { const int gc = d0 + j; if (gc < 30) { const float v = acc[ai][0][m][0][j] + gateb[gc]; GT[(size_t)row * 32 + gc] = fast_rcp(1.0f + fast_exp2(-1.4426950408889634f * v)); } } }
            return;
        }
        bool rope = false, isf32 = false; float sc = 1.f; bf16_t* bb = nullptr; float* fb = nullptr; int pitch = 128; size_t bjs = (size_t)S * 128; int colbase = 0;
        if (pn < 3)       { rope = true; sc = QSCALE; bb = QA; pitch = D_DIL; bjs = 128; colbase = 256 * pn; }
        else if (pn < 6)  { rope = true; bb = KA; pitch = D_DIL; bjs = 128; colbase = 256 * (pn - 3); }
        else if (pn < 9)  { bb = VA; pitch = D_DIL; bjs = 128; colbase = 256 * (pn - 6); }
        else if (pn < 14) { rope = true; sc = QSCALE; bb = QN; pitch = D_NSA; bjs = 128; colbase = 256 * (pn - 9); }
        else if (pn == 14) { isf32 = true; fb = KCT; }
        else if (pn == 15) { isf32 = true; fb = VCT; }
        else if (pn == 16) { rope = true; bb = KS; }
        else if (pn == 17) { bb = VS; }
        else if (pn == 18) { rope = true; bb = KW; }
        else               { bb = VW; }
#pragma unroll
        for (int ai = 0; ai < 2; ++ai)
#pragma unroll
            for (int m = 0; m < 4; ++m) {
                const int row = u.pm * BM + ai * HALF + wr * 64 + m * 16 + fr;
                f32x4 cs = (f32x4){1.f, 1.f, 1.f, 1.f}, sn = (f32x4){0.f, 0.f, 0.f, 0.f};
                if (rope) { cs = *(const f32x4*)(cosT + (size_t)row * 64 + d0); sn = *(const f32x4*)(sinT + (size_t)row * 64 + d0); }
#pragma unroll
                for (int bj = 0; bj < 2; ++bj) {
                    const f32x4 x1 = acc[ai][bj][m][0], x2 = acc[ai][bj][m][1];
                    const f32x4 o1 = (x1 * cs - x2 * sn) * sc, o2 = (x2 * cs + x1 * sn) * sc;
                    const size_t off = (size_t)row * pitch + bj * bjs + colbase + d0;
                    if (isf32) { *(f32x4*)(fb + off) = o1; *(f32x4*)(fb + off + 64) = o2; }
                    else { u32x2 w1, w2; w1.x = cvt_pk_bf16(o1[0], o1[1]); w1.y = cvt_pk_bf16(o1[2], o1[3]); w2.x = cvt_pk_bf16(o2[0], o2[1]); w2.y = cvt_pk_bf16(o2[2], o2[3]);
                        *(u32x2*)(bb + off) = w1; *(u32x2*)(bb + off + 64) = w2; }
                }
            }
    }
};
}

struct Params {
    const float* x; const int* pos;
    const float *ln1g, *ln1b, *f1w1, *f1w3, *f1w2, *win, *gateb, *cpe, *cw1, *cb1, *cw2, *cb2, *wout, *ln2g, *ln2b, *f2w1, *f2w3, *f2w2, *ln3g, *ln3b;
    float* out; unsigned char* ws; int ph_lo, ph_hi;
};

template <class SrcFn>
__device__ __forceinline__ void tr_item64(int K, int k0, bf16_t* WT, int dr0, const SrcFn& src, LAS float* scr, int lane) {
    const int n4 = lane & 15, kr = lane >> 4;
    const float* sp = src(dr0 + 4 * n4) + (size_t)(k0 + kr) * src.pitch;
    const int nv = src.nvalid(dr0 + 4 * n4);
    const size_t rs = (size_t)4 * src.pitch;
    f32x4 v[16];
    if (nv == 4) {
#pragma unroll
        for (int i = 0; i < 16; ++i) v[i] = *(const f32x4*)(sp + i * rs);
    } else {
#pragma unroll
        for (int i = 0; i < 16; ++i) { v[i] = (f32x4){0.f, 0.f, 0.f, 0.f}; if (nv > 0) v[i][0] = sp[i * rs]; if (nv > 1) v[i][1] = sp[i * rs + 1]; if (nv > 2) v[i][2] = sp[i * rs + 2]; }
    }
#pragma unroll
    for (int i = 0; i < 16; ++i) { const int k = 4 * i + kr; *(LAS f32x4*)(scr + k * 64 + ((4 * n4 + 4 * (k >> 3)) & 63)) = v[i]; }
    asm volatile("s_waitcnt lgkmcnt(0)" ::: "memory");
    const int c = lane & 7;
#pragma unroll
    for (int j = 0; j < 8; ++j) { const int n = (lane >> 3) + 8 * j; const LAS float* s = scr + (8 * c) * 64 + ((n + 4 * c) & 63);
        u32x4 o; o.x = pg8::cvt_pk_bf16(s[0 * 64], s[1 * 64]); o.y = pg8::cvt_pk_bf16(s[2 * 64], s[3 * 64]); o.z = pg8::cvt_pk_bf16(s[4 * 64], s[5 * 64]); o.w = pg8::cvt_pk_bf16(s[6 * 64], s[7 * 64]);
        *(u32x4*)(WT + (size_t)(dr0 + n) * K + k0 + 8 * c) = o; }
    asm volatile("s_waitcnt lgkmcnt(0)" ::: "memory");
}
struct SrcPlain { const float* W; int pitch; __device__ __forceinline__ const float* operator()(int r) const { return W + r; } __device__ __forceinline__ int nvalid(int) const { return 4; } };
struct SrcW13 { const float* W; int pitch; __device__ __forceinline__ const float* operator()(int r) const { const int pn = r >> 8, i = r & 127; return W + 128 * pn + i; } __device__ __forceinline__ int nvalid(int) const { return 4; } };
struct SrcWin { const float* W; int pitch;
    __device__ __forceinline__ int col(int r) const { const int p = r & 127, wc = (p >> 5) & 3, n = (p >> 4) & 1, d = 64 * n + 16 * wc + (p & 15); return (r & ~127) + d; }
    __device__ __forceinline__ const float* operator()(int r) const { return W + col(r); }
    __device__ __forceinline__ int nvalid(int r) const { const int left = IN_COLS - col(r); return left >= 4 ? 4 : (left > 0 ? left : 0); } };

__device__ __forceinline__ void p0_prologue(const Params& p, LAS unsigned char* lds) {
    const int tid = threadIdx.x, lane = tid & 63, wave = __builtin_amdgcn_readfirstlane(tid >> 6);
    LAS float* scr = (LAS float*)(lds + wave * 16384);
    const int gw = blockIdx.x * NWAVES + wave, NGW = gridDim.x * NWAVES;
    unsigned char* ws = p.ws;
    constexpr int I13 = (DM / 64) * (2 * DFF / 64), I2 = (DFF / 64) * (DM / 64), IIN = (DM / 64) * (IN_PAD / 64), IOUT = (DM / 64) * (DM / 64);
    constexpr int ICW1 = (4096 / 64) * (256 / 64), ICW2 = (256 / 64) * (128 / 64);
    constexpr int NITEMS = 2 * I13 + 2 * I2 + IIN + IOUT + 2 * ICW1 + 2 * ICW2;
    if (blockIdx.x == 0) { if (tid < 16) ((unsigned*)(ws + OFF_CTL))[tid] = 0u;
        for (int i = tid; i < XCD_BAR_WORDS_C; i += NTHREADS) ((unsigned*)(ws + OFF_CTL))[CW_BAR_C + i] = 0u; }
    for (int it = gw; it < NITEMS; it += NGW) {
        int r = it;
        if (r < I13) { const int nb = 2 * DFF / 64; const int dr = 64 * (r % nb); const float* W = p.f1w1; if ((dr >> 7) & 1) W = p.f1w3; SrcW13 s{W, DFF}; tr_item64(DM, 64 * (r / nb), (bf16_t*)(ws + OFF_W13A), dr, s, scr, lane); continue; } r -= I13;
        if (r < I2)  { const int nb = DM / 64; SrcPlain s{p.f1w2, DM}; tr_item64(DFF, 64 * (r / nb), (bf16_t*)(ws + OFF_W2A), 64 * (r % nb), s, scr, lane); continue; } r -= I2;
        if (r < I13) { const int nb = 2 * DFF / 64; const int dr = 64 * (r % nb); const float* W = p.f2w1; if ((dr >> 7) & 1) W = p.f2w3; SrcW13 s{W, DFF}; tr_item64(DM, 64 * (r / nb), (bf16_t*)(ws + OFF_W13B), dr, s, scr, lane); continue; } r -= I13;
        if (r < I2)  { const int nb = DM / 64; SrcPlain s{p.f2w2, DM}; tr_item64(DFF, 64 * (r / nb), (bf16_t*)(ws + OFF_W2B), 64 * (r % nb), s, scr, lane); continue; } r -= I2;
        if (r < IIN) { const int nb = IN_PAD / 64; SrcWin s{p.win, IN_COLS}; tr_item64(DM, 64 * (r / nb), (bf16_t*)(ws + OFF_WIN), 64 * (r % nb), s, scr, lane); continue; } r -= IIN;
        if (r < IOUT) { const int nb = DM / 64; SrcPlain s{p.wout, DM}; tr_item64(DM, 64 * (r / nb), (bf16_t*)(ws + OFF_WOUT), 64 * (r % nb), s, scr, lane); continue; } r -= IOUT;
        if (r < 2 * ICW1) { const int j = r / ICW1, q = r % ICW1, nb = 256 / 64; SrcPlain s{p.cw1 + (size_t)j * 4096 * 256, 256}; tr_item64(4096, 64 * (q / nb), (bf16_t*)(ws + OFF_CW1T) + (size_t)j * 256 * 4096, 64 * (q % nb), s, scr, lane); continue; } r -= 2 * ICW1;
        { const int j = r / ICW2, q = r % ICW2, nb = 128 / 64; SrcPlain s{p.cw2 + (size_t)j * 256 * 128, 128}; tr_item64(256, 64 * (q / nb), (bf16_t*)(ws + OFF_CW2T) + (size_t)j * 128 * 256, 64 * (q % nb), s, scr, lane); }
    }
    {
        const size_t n8 = (size_t)S * DM / 8, gt = (size_t)blockIdx.x * NTHREADS + tid, GT_ = (size_t)gridDim.x * NTHREADS;
        bf16_t* XB = (bf16_t*)(ws + OFF_XB);
        for (size_t i = gt; i < n8; i += 4 * GT_) {
            f32x4 a[4], b[4];
#pragma unroll
            for (int e = 0; e < 4; ++e) { const size_t ii = i + e * GT_; if (ii < n8) { a[e] = *(const f32x4*)(p.x + ii * 8); b[e] = *(const f32x4*)(p.x + ii * 8 + 4); } }
#pragma unroll
            for (int e = 0; e < 4; ++e) { const size_t ii = i + e * GT_; if (ii < n8) { u32x4 o; o.x = pg8::cvt_pk_bf16(a[e][0], a[e][1]); o.y = pg8::cvt_pk_bf16(a[e][2], a[e][3]); o.z = pg8::cvt_pk_bf16(b[e][0], b[e][1]); o.w = pg8::cvt_pk_bf16(b[e][2], b[e][3]); *(u32x4*)(XB + ii * 8) = o; } }
        }
    }
    {
        float* cosT = (float*)(ws + OFF_ROPE); float* sinT = cosT + (size_t)S * 64;
        const int gt = blockIdx.x * NTHREADS + tid, GT_ = gridDim.x * NTHREADS;
        for (int i = gt; i < S * 64; i += GT_) { float c, s; rope_cs((double)p.pos[i >> 6], i & 63, c, s); cosT[i] = c; sinT[i] = s; }
    }
}

__device__ __forceinline__ void ln_phase(const float* in, float* outf, bf16_t* outb, const float* g, const float* b) {
    const int tid = threadIdx.x, lane = tid & 63, wave = __builtin_amdgcn_readfirstlane(tid >> 6);
    const int gw = blockIdx.x * NWAVES + wave, NGW = gridDim.x * NWAVES;
    for (int row = gw; row < S; row += NGW) {
        const f32x4* xr = (const f32x4*)(in + (size_t)row * DM) + lane;
        f32x4 v[8]; float s = 0.f;
#pragma unroll
        for (int j = 0; j < 8; ++j) { v[j] = xr[64 * j]; s += (v[j][0] + v[j][1]) + (v[j][2] + v[j][3]); }
        const float mean = wave_sum(s) * (1.f / DM); float s2 = 0.f;
#pragma unroll
        for (int j = 0; j < 8; ++j) { v[j] = v[j] - mean; s2 += (v[j][0] * v[j][0] + v[j][1] * v[j][1]) + (v[j][2] * v[j][2] + v[j][3] * v[j][3]); }
        const float rstd = 1.0f / sqrtf(wave_sum(s2) * (1.f / DM) + LN_EPS);
#pragma unroll
        for (int j = 0; j < 8; ++j) {
            const f32x4 gg = *((const f32x4*)g + lane + 64 * j), bb = *((const f32x4*)b + lane + 64 * j);
            const f32x4 o = v[j] * rstd * gg + bb;
            *((f32x4*)(outf + (size_t)row * DM) + lane + 64 * j) = o;
            if (outb) { u32x2 w; w.x = pk2(o[0], o[1]); w.y = pk2(o[2], o[3]); *((u32x2*)(outb + (size_t)row * DM) + lane + 64 * j) = w; }
        }
    }
}

__device__ __forceinline__ float dot128(const LAS bf16_t* q, const bf16_t* k) {
    float a0 = 0.f, a1 = 0.f;
#pragma unroll
    for (int c = 0; c < 16; ++c) { const u32x4 qv = *(const LAS u32x4*)(q + 8 * c); const u32x4 kv = *(const u32x4*)(k + 8 * c);
#pragma unroll
        for (int e = 0; e < 4; ++e) { a0 += bflo(qv[e]) * bflo(kv[e]); a1 += bfhi(qv[e]) * bfhi(kv[e]); } }
    return a0 + a1;
}
__device__ __forceinline__ float gelu_tanh(float x) {
    const float u = 0.7978845608028654f * (x + 0.044715f * x * x * x);
    const float e = __expf(2.f * u);
    const float th = 1.f - 2.f / (e + 1.f);
    return 0.5f * x * (1.f + th);
}

__device__ __forceinline__ void compress_naive(const Params& p, LAS unsigned char* lds) {
    const int tid = threadIdx.x;
    LAS float* A = (LAS float*)lds; LAS float* part = A + 4096; LAS float* hdn = part + 512; LAS float* outv = hdn + 256;
    unsigned char* ws = p.ws;
    bf16_t* KC = (bf16_t*)(ws + OFF_KC); bf16_t* VC = (bf16_t*)(ws + OFF_VC);
    for (int u = blockIdx.x; u < 2 * NG * 512; u += gridDim.x) {
        const int n = u & 511, g = (u >> 9) & 1, j = u >> 10;
        bf16_t* dst = (j ? VC : KC) + ((size_t)g * 512 + n) * 128;
        if (n >= NCMP) { if (tid < 128) dst[tid] = 0; continue; }
        const float* tok = (const float*)(ws + (j ? OFF_VCT : OFF_KCT)) + ((size_t)g * S + 16 * n) * 128;
        const float* pe = p.cpe + (size_t)j * 32 * 128;
        for (int i = tid; i < 4096; i += NTHREADS) A[i] = tok[i] + pe[i];
        __syncthreads();
        { const int h = tid & 255, half = tid >> 8; const float* w = p.cw1 + ((size_t)j * 4096 + 2048 * half) * 256 + h; const LAS float* a = A + 2048 * half;
          float acc = 0.f;
#pragma unroll 8
          for (int k = 0; k < 2048; ++k) acc += a[k] * w[(size_t)k * 256];
          part[tid] = acc; }
        __syncthreads();
        if (tid < 256) hdn[tid] = gelu_tanh(part[tid] + part[tid + 256] + p.cb1[j * 256 + tid]);
        __syncthreads();
        if (tid < 128) { const float* w = p.cw2 + (size_t)j * 256 * 128 + tid; float acc = p.cb2[j * 128 + tid];
#pragma unroll 8
            for (int h = 0; h < 256; ++h) acc += hdn[h] * w[(size_t)h * 128];
            outv[tid] = acc; }
        __syncthreads();
        if (j == 0) { if (tid < 64) { const double pc = 0.5 * ((double)p.pos[16 * n] + (double)p.pos[16 * n + 31]); float c, s; rope_cs(pc, tid, c, s);
                const float x1 = outv[tid], x2 = outv[tid + 64]; dst[tid] = (bf16_t)f2bf(x1 * c - x2 * s); dst[tid + 64] = (bf16_t)f2bf(x2 * c + x1 * s); } }
        else { if (tid < 128) dst[tid] = (bf16_t)f2bf(outv[tid]); }
        __syncthreads();
    }
}

__device__ __forceinline__ void dilated_naive(const Params& p, LAS unsigned char* lds) {
    const int tid = threadIdx.x, lane = tid & 63, wave = __builtin_amdgcn_readfirstlane(tid >> 6);
    LAS bf16_t* qs = (LAS bf16_t*)(lds + 32768) + wave * 128;
    unsigned char* ws = p.ws;
    const bf16_t* QA = (const bf16_t*)(ws + OFF_QA); const bf16_t* KA = (const bf16_t*)(ws + OFF_KA); const bf16_t* VA = (const bf16_t*)(ws + OFF_VA);
    bf16_t* MX = (bf16_t*)(ws + OFF_XB);
    const int gw = blockIdx.x * NWAVES + wave, NGW = gridDim.x * NWAVES;
    for (int u = gw; u < S * NH_DIL; u += NGW) {
        const int t = u / NH_DIL, h = u % NH_DIL;
        *(LAS unsigned*)(qs + 2 * lane) = *(const unsigned*)(QA + (size_t)t * D_DIL + h * 128 + 2 * lane);
        asm volatile("s_waitcnt lgkmcnt(0)" ::: "memory");
        float sc[3][3]; float m = -INFINITY;
#pragma unroll
        for (int c = 0; c < 3; ++c) { const int dil = c == 0 ? 1 : (c == 1 ? 4 : 16);
#pragma unroll
            for (int it = 0; it < 3; ++it) { const int k = lane + 64 * it; const int tk = t - dil * k; const bool valid = (k <= 128) && (tk >= 0);
                float s = -INFINITY; if (valid) s = dot128(qs, KA + (size_t)tk * D_DIL + h * 128); sc[c][it] = s; m = fmaxf(m, s); } }
        m = wave_max(m);
        float l = 0.f;
#pragma unroll
        for (int c = 0; c < 3; ++c)
#pragma unroll
            for (int it = 0; it < 3; ++it) { const float e = fast_exp2(sc[c][it] - m); sc[c][it] = e; l += e; }
        l = wave_sum(l);
        float o0 = 0.f, o1 = 0.f;
#pragma unroll
        for (int c = 0; c < 3; ++c) { const int dil = c == 0 ? 1 : (c == 1 ? 4 : 16);
#pragma unroll
            for (int it = 0; it < 3; ++it) { int cnt = 129 - 64 * it; cnt = cnt > 64 ? 64 : cnt; const int kmax = t / dil - 64 * it + 1; cnt = cnt < kmax ? cnt : kmax;
                for (int kk = 0; kk < cnt; ++kk) { const float pk = __uint_as_float(__builtin_amdgcn_readlane(__float_as_uint(sc[c][it]), kk));
                    const unsigned v = *(const unsigned*)(VA + (size_t)(t - dil * (kk + 64 * it)) * D_DIL + h * 128 + 2 * lane); o0 += pk * bflo(v); o1 += pk * bfhi(v); } } }
        const float inv = 1.f / l;
        *(unsigned*)(MX + (size_t)t * DM + h * 128 + 2 * lane) = pk2(o0 * inv, o1 * inv);
    }
}

__device__ __forceinline__ void nsa_naive(const Params& p, LAS unsigned char* lds) {
    const int tid = threadIdx.x, lane = tid & 63, wave = __builtin_amdgcn_readfirstlane(tid >> 6);
    LAS bf16_t* qsh = (LAS bf16_t*)lds;
    LAS float* Pc = (LAS float*)(lds + 2048);
    LAS int* sel = (LAS int*)(lds + 2048 + 10240);
    unsigned char* ws = p.ws;
    const bf16_t* QN = (const bf16_t*)(ws + OFF_QN);
    const bf16_t* KC = (const bf16_t*)(ws + OFF_KC); const bf16_t* VC = (const bf16_t*)(ws + OFF_VC);
    const bf16_t* KS = (const bf16_t*)(ws + OFF_KS); const bf16_t* VS = (const bf16_t*)(ws + OFF_VS);
    const bf16_t* KW = (const bf16_t*)(ws + OFF_KW); const bf16_t* VW = (const bf16_t*)(ws + OFF_VW);
    const float* GT = (const float*)(ws + OFF_GT);
    bf16_t* MX = (bf16_t*)(ws + OFF_XB);
    for (int u = blockIdx.x; u < S * NG; u += gridDim.x) {
        const int t = u >> 1, g = u & 1;
        const int h = HG * g + wave;
        LAS bf16_t* qs = qsh + wave * 128;
        float oc0 = 0.f, oc1 = 0.f;
        if (wave < HG) {
            *(LAS unsigned*)(qs + 2 * lane) = *(const unsigned*)(QN + (size_t)t * D_NSA + h * 128 + 2 * lane);
            asm volatile("s_waitcnt lgkmcnt(0)" ::: "memory");
            const int ncnt = (t >= 31) ? (t - 31) / 16 + 1 : 0;
            float s[8]; float m = -INFINITY;
#pragma unroll
            for (int it = 0; it < 8; ++it) { const int n = lane + 64 * it; float v = -INFINITY; if (n < ncnt) v = dot128(qs, KC + ((size_t)g * 512 + n) * 128); s[it] = v; m = fmaxf(m, v); }
            m = wave_max(m);
            float l = 0.f;
#pragma unroll
            for (int it = 0; it < 8; ++it) { const int n = lane + 64 * it; const float e = (n < ncnt) ? fast_exp2(s[it] - m) : 0.f; s[it] = e; l += e; }
            l = wave_sum(l);
            const float inv = l > 0.f ? 1.f / l : 0.f;
#pragma unroll
            for (int it = 0; it < 8; ++it) { s[it] *= inv; Pc[wave * 512 + lane + 64 * it] = s[it]; }
#pragma unroll
            for (int it = 0; it < 8; ++it) { int cnt = ncnt - 64 * it; cnt = cnt > 64 ? 64 : cnt;
                for (int kk = 0; kk < cnt; ++kk) { const float pk = __uint_as_float(__builtin_amdgcn_readlane(__float_as_uint(s[it]), kk));
                    const unsigned v = *(const unsigned*)(VC + ((size_t)g * 512 + 64 * it + kk) * 128 + 2 * lane); oc0 += pk * bflo(v); oc1 += pk * bfhi(v); } }
        }
        __syncthreads();
        if (wave == 0) {
            const int cur = t >> 6;
            float sc0, sc1;
            { const int jj = lane; float imp = 0.f;
              for (int n = 4 * jj - 1; n <= 4 * jj + 3; ++n) if (n >= 0 && n < NCMP) { for (int w = 0; w < HG; ++w) imp += Pc[w * 512 + n]; }
              const bool forced = (jj == 0) || (jj == cur) || (jj == cur - 1);
              sc0 = (jj <= cur) ? imp + (forced ? 1e4f : 0.f) : -1e30f; }
            { const int jj = lane + 64; float imp = 0.f;
              for (int n = 4 * jj - 1; n <= 4 * jj + 3; ++n) if (n >= 0 && n < NCMP) { for (int w = 0; w < HG; ++w) imp += Pc[w * 512 + n]; }
              const bool forced = (jj == 0) || (jj == cur) || (jj == cur - 1);
              sc1 = (jj <= cur) ? imp + (forced ? 1e4f : 0.f) : -1e30f; }
            for (int r = 0; r < 16; ++r) {
                const float mx = wave_max(fmaxf(sc0, sc1));
                const unsigned long long b0 = __ballot(sc0 == mx);
                int idx;
                if (b0) idx = __builtin_ctzll(b0); else { const unsigned long long b1 = __ballot(sc1 == mx); idx = 64 + __builtin_ctzll(b1); }
                if (lane == 0) sel[r] = (mx > -1e29f) ? idx : -1;
                if (idx < 64) { if (lane == idx) sc0 = -INFINITY; } else { if (lane == idx - 64) sc1 = -INFINITY; }
            }
        }
        __syncthreads();
        if (wave < HG) {
            float ss[16]; float m = -INFINITY;
#pragma unroll
            for (int r = 0; r < 16; ++r) { const int j = __builtin_amdgcn_readfirstlane(sel[r]); float v = -INFINITY;
                if (j >= 0) { const int kp = 64 * j + lane; if (kp <= t) v = dot128(qs, KS + ((size_t)g * S + kp) * 128); }
                ss[r] = v; m = fmaxf(m, v); }
            m = wave_max(m);
            float l = 0.f;
#pragma unroll
            for (int r = 0; r < 16; ++r) { const float e = fast_exp2(ss[r] - m); ss[r] = e; l += e; }
            l = wave_sum(l);
            float os0 = 0.f, os1 = 0.f;
#pragma unroll
            for (int r = 0; r < 16; ++r) { const int j = __builtin_amdgcn_readfirstlane(sel[r]); if (j >= 0) { int cnt = t - 64 * j + 1; cnt = cnt > 64 ? 64 : cnt;
                for (int kk = 0; kk < cnt; ++kk) { const float pk = __uint_as_float(__builtin_amdgcn_readlane(__float_as_uint(ss[r]), kk));
                    const unsigned v = *(const unsigned*)(VS + ((size_t)g * S + 64 * j + kk) * 128 + 2 * lane); os0 += pk * bflo(v); os1 += pk * bfhi(v); } } }
            const float invs = 1.f / l;
            float sw[8]; float mw = -INFINITY;
#pragma unroll
            for (int it = 0; it < 8; ++it) { const int kp = t - 511 + lane + 64 * it; float v = -INFINITY; if (kp >= 0) v = dot128(qs, KW + ((size_t)g * S + kp) * 128); sw[it] = v; mw = fmaxf(mw, v); }
            mw = wave_max(mw);
            float lw = 0.f;
#pragma unroll
            for (int it = 0; it < 8; ++it) { const float e = fast_exp2(sw[it] - mw); sw[it] = e; lw += e; }
            lw = wave_sum(lw);
            float ow0 = 0.f, ow1 = 0.f;
#pragma unroll
            for (int it = 0; it < 8; ++it) { const int kp0 = t - 511 + 64 * it; int k0 = kp0 < 0 ? -kp0 : 0; k0 = k0 > 64 ? 64 : k0;
                for (int kk = k0; kk < 64; ++kk) { const float pk = __uint_as_float(__builtin_amdgcn_readlane(__float_as_uint(sw[it]), kk));
                    const unsigned v = *(const unsigned*)(VW + ((size_t)g * S + kp0 + kk) * 128 + 2 * lane); ow0 += pk * bflo(v); ow1 += pk * bfhi(v); } }
            const float invw = 1.f / lw;
            const float g0 = GT[(size_t)t * 32 + h * 3 + 0], g1 = GT[(size_t)t * 32 + h * 3 + 1], g2 = GT[(size_t)t * 32 + h * 3 + 2];
            const float r0 = g0 * oc0 + g1 * os0 * invs + g2 * ow0 * invw, r1 = g0 * oc1 + g1 * os1 * invs + g2 * ow1 * invw;
            *(unsigned*)(MX + (size_t)t * DM + D_DIL + h * 128 + 2 * lane) = pk2(r0, r1);
        }
        __syncthreads();
    }
}

namespace att {
typedef short s16x4 __attribute__((ext_vector_type(4)));
constexpr int KP = 272, VP = 288;
constexpr int KT_BYTES = 64 * KP, VT_BYTES = 64 * VP;
constexpr int L_K0 = 0, L_K1 = KT_BYTES, L_V0 = 2 * KT_BYTES, L_V1 = 2 * KT_BYTES + VT_BYTES, L_V2 = 2 * KT_BYTES + 2 * VT_BYTES;
constexpr int L_MISC = 90112;
constexpr int L_SLOT = 143360;
constexpr unsigned W_CAUSAL = 0x80000000u;
constexpr size_t OV_OD = 0, OV_LSE = 40 * MiB, OV_OC = 41 * MiB, OV_SEL = 82 * MiB;

struct TileSrc { const char* K; const char* V; size_t kst, vst; };

__device__ __forceinline__ void tile_load(u32x4 (&r)[4], const TileSrc& s, int key0, int tid) {
    const int k = tid >> 4, cc = (tid & 15) * 16;
    const char* kp = s.K + (size_t)(key0 + k) * s.kst + cc; const char* vp = s.V + (size_t)(key0 + k) * s.vst + cc;
    r[0] = *(const u32x4*)kp; r[1] = *(const u32x4*)(kp + 32 * s.kst); r[2] = *(const u32x4*)vp; r[3] = *(const u32x4*)(vp + 32 * s.vst);
}
__device__ __forceinline__ int k_off(int kb) { return kb ? L_K1 : L_K0; }
__device__ __forceinline__ int v_off(int vb) { return vb == 0 ? L_V0 : (vb == 1 ? L_V1 : L_V2); }
__device__ __forceinline__ void tile_store(LAS unsigned char* lds, int kb, int vb, const u32x4 (&r)[4], int tid) {
    const int k = tid >> 4, cc = (tid & 15) * 16;
    const int lam = 16 * ((k >> 2) & 1) + 4 * ((k >> 3) & 3) + (k & 3);
    const int lv = (k & 16) + 8 * ((k >> 2) & 1) + 4 * ((k >> 3) & 1) + (k & 3);
    LAS unsigned char* Kt = lds + k_off(kb); LAS unsigned char* Vt = lds + v_off(vb);
    *(LAS u32x4*)(Kt + lam * KP + cc) = r[0]; *(LAS u32x4*)(Kt + (lam + 32) * KP + cc) = r[1];
    *(LAS u32x4*)(Vt + lv * VP + cc) = r[2]; *(LAS u32x4*)(Vt + (lv + 32) * VP + cc) = r[3];
}
struct QState { bf16x8 qf[4]; f32x4 o[8]; float m, l; };
__device__ __forceinline__ void q_reset(QState& st) {
#pragma unroll
    for (int i = 0; i < 8; ++i) st.o[i] = (f32x4){0.f, 0.f, 0.f, 0.f};
    st.m = -1e30f; st.l = 0.f;
}
__device__ __forceinline__ void q_load(QState& st, const bf16_t* qrow, int g) {
#pragma unroll
    for (int ds = 0; ds < 4; ++ds) st.qf[ds] = *(const bf16x8*)(qrow + 32 * ds + 8 * g);
    q_reset(st);
}
__device__ __forceinline__ void qk_tile(f32x4 (&s)[4], const LAS unsigned char* Kt, const QState& st, int c, int g) {
    const LAS unsigned char* kb = Kt + c * KP + g * 16;
#pragma unroll
    for (int T = 0; T < 4; ++T) { s[T] = (f32x4){0.f, 0.f, 0.f, 0.f};
#pragma unroll
        for (int ds = 0; ds < 4; ++ds) { const bf16x8 kf = *(const LAS bf16x8*)(kb + T * 16 * KP + ds * 64); s[T] = __builtin_amdgcn_mfma_f32_16x16x32_bf16(kf, st.qf[ds], s[T], 0, 0, 0); } }
}
__device__ __forceinline__ void mask_tile(f32x4 (&s)[4], int dq, unsigned W, int g) {
#pragma unroll
    for (int T = 0; T < 4; ++T)
#pragma unroll
        for (int r = 0; r < 4; ++r) { const int kt = 32 * (T >> 1) + 8 * g + 4 * (T & 1) + r; if (!((unsigned)(dq - kt) < W)) s[T][r] = -INFINITY; }
}
__device__ __forceinline__ float group_max(float x) {
    auto s = __builtin_amdgcn_permlane16_swap(__float_as_uint(x), __float_as_uint(x), false, false); x = fmaxf(__uint_as_float(s[0]), __uint_as_float(s[1]));
    auto t = __builtin_amdgcn_permlane32_swap(__float_as_uint(x), __float_as_uint(x), false, false); return fmaxf(__uint_as_float(t[0]), __uint_as_float(t[1]));
}
__device__ __forceinline__ float group_sum(float x) {
    auto s = __builtin_amdgcn_permlane16_swap(__float_as_uint(x), __float_as_uint(x), false, false); x = __uint_as_float(s[0]) + __uint_as_float(s[1]);
    auto t = __builtin_amdgcn_permlane32_swap(__float_as_uint(x), __float_as_uint(x), false, false); return __uint_as_float(t[0]) + __uint_as_float(t[1]);
}
template <bool PV, bool HAS_EN> __device__ __forceinline__ void softmax_online(f32x4 (&s)[4], QState& st, bool en) {
    float mx = fmaxf(fmaxf(s[0][0], s[0][1]), fmaxf(s[0][2], s[0][3]));
#pragma unroll
    for (int T = 1; T < 4; ++T) mx = fmaxf(mx, fmaxf(fmaxf(s[T][0], s[T][1]), fmaxf(s[T][2], s[T][3])));
    if (HAS_EN) mx = en ? mx : -INFINITY;
    mx = group_max(mx);
    const float mn = fmaxf(st.m, mx);
    if (__ballot(mn > st.m) != 0ull) {
        const float alpha = fast_exp2(st.m - mn); st.l *= alpha;
        if (PV) {
#pragma unroll
            for (int i = 0; i < 8; ++i) st.o[i] = st.o[i] * alpha;
        }
    }
    st.m = mn;
    const float mnl = HAS_EN ? (en ? mn : INFINITY) : mn;
    float sum = 0.f;
#pragma unroll
    for (int T = 0; T < 4; ++T)
#pragma unroll
        for (int r = 0; r < 4; ++r) { const float e = fast_exp2(s[T][r] - mnl); s[T][r] = e; sum += e; }
    st.l += sum;
}
__device__ __forceinline__ s16x4 tr_read(const LAS unsigned char* p) { return __builtin_bit_cast(s16x4, __builtin_amdgcn_ds_read_tr16_b64_v4i16((LAS s16x4*)p)); }
__device__ __forceinline__ void pv_tile(const f32x4 (&s)[4], const LAS unsigned char* Vt, QState& st, int c, int g) {
    const LAS unsigned char* vb = Vt + (16 * (g >> 1) + 4 * (g & 1) + (c >> 2)) * VP + (c & 3) * 8;
#pragma unroll
    for (int ch = 0; ch < 2; ++ch) {
        u32x4 pw; pw.x = pg8::cvt_pk_bf16(s[2 * ch][0], s[2 * ch][1]); pw.y = pg8::cvt_pk_bf16(s[2 * ch][2], s[2 * ch][3]);
        pw.z = pg8::cvt_pk_bf16(s[2 * ch + 1][0], s[2 * ch + 1][1]); pw.w = pg8::cvt_pk_bf16(s[2 * ch + 1][2], s[2 * ch + 1][3]);
        const bf16x8 pf = __builtin_bit_cast(bf16x8, pw);
#pragma unroll
        for (int dt = 0; dt < 8; ++dt) {
            const s16x4 lo = tr_read(vb + ch * 32 * VP + dt * 32), hi = tr_read(vb + ch * 32 * VP + 8 * VP + dt * 32);
            const bf16x8 vf = (bf16x8){lo[0], lo[1], lo[2], lo[3], hi[0], hi[1], hi[2], hi[3]};
            st.o[dt] = __builtin_amdgcn_mfma_f32_16x16x32_bf16(vf, pf, st.o[dt], 0, 0, 0);
        }
    }
}
#define ATT_STEP(RST, RLD) do { \
        if (t + 3 < t1) tile_load(RLD, src, 64 * (t + 3), tid); \
        const int relmn = (t + 1 < t1) ? f.mode(t + 1) : 0; const bool reln = relmn != 0; \
        if (reln) qk_tile(sn, lds + k_off(kb ^ 1), st, c, g); \
        if (rel) { if (relm == 2) mask_tile(sc, f.dq(t), f.W(), g); softmax_online<PV, F::HAS_EN>(sc, st, f.en(t)); if (PV) pv_tile(sc, lds + v_off(vb), st, c, g); } \
        const int vb2 = vb == 0 ? 2 : vb - 1; \
        if (t + 2 < t1) tile_store(lds, kb, vb2, RST, tid); \
        __syncthreads(); \
        _Pragma("unroll") for (int T = 0; T < 4; ++T) sc[T] = sn[T]; \
        rel = reln; relm = relmn; kb ^= 1; vb = vb == 2 ? 0 : vb + 1; ++t; } while (0)
template <bool PV, class F>
__device__ __forceinline__ void attn_pass(LAS unsigned char* lds, const TileSrc& src, int t0, int t1, QState& st, const F& f, int tid, int c, int g) {
    if (t0 >= t1) return;
    u32x4 ra[4], rb[4];
    tile_load(ra, src, 64 * t0, tid);
    if (t0 + 1 < t1) tile_load(rb, src, 64 * (t0 + 1), tid);
    tile_store(lds, 0, 0, ra, tid);
    if (t0 + 2 < t1) tile_load(ra, src, 64 * (t0 + 2), tid);
    if (t0 + 1 < t1) tile_store(lds, 1, 1, rb, tid);
    __syncthreads();
    f32x4 sc[4], sn[4];
#pragma unroll
    for (int T = 0; T < 4; ++T) { sc[T] = (f32x4){0.f, 0.f, 0.f, 0.f}; sn[T] = sc[T]; }
    int relm = f.mode(t0); bool rel = relm != 0;
    if (rel) qk_tile(sc, lds + L_K0, st, c, g);
    __syncthreads();
    int kb = 0, vb = 0, t = t0;
    while (t < t1) {
        ATT_STEP(ra, rb);
        if (t >= t1) break;
        ATT_STEP(rb, ra);
    }
}
#undef ATT_STEP
__device__ __forceinline__ int next_unit(unsigned* ctr, LAS unsigned char* lds) {
    LAS int* slot = (LAS int*)(lds + L_SLOT);
    __syncthreads();
    if (threadIdx.x == 0) *slot = (int)atomicAdd(ctr, 1u);
    __syncthreads();
    return *slot;
}

struct DilF { int iq, iw; static constexpr bool HAS_EN = false;
    __device__ __forceinline__ int mode(int t) const { if (!(64 * t <= iw + 15 && 64 * t + 63 >= iw - 128)) return 0; return (64 * t >= iw + 15 - 128 && 64 * t + 63 <= iw) ? 1 : 2; }
    __device__ __forceinline__ int dq(int t) const { return iq - 64 * t; }
    __device__ __forceinline__ unsigned W() const { return 129u; }
    __device__ __forceinline__ bool en(int) const { return true; } };
__device__ __forceinline__ void dil_unit(const Params& p, LAS unsigned char* lds, int u) {
    const int tid = threadIdx.x, lane = tid & 63, wave = __builtin_amdgcn_readfirstlane(tid >> 6), c = lane & 15, g = lane >> 4;
    const int cfg = u / 384, v = u % 384, h = v % NH_DIL, rb = v / NH_DIL;
    const int dil = cfg == 0 ? 1 : (cfg == 1 ? 4 : 16), nb = (S / dil) / 128, r = rb / nb, b = rb % nb;
    unsigned char* ws = p.ws;
    const int iw = 128 * b + 16 * wave, iq = iw + c, tok = dil * iq + r;
    QState st; q_load(st, (const bf16_t*)(ws + OFF_QA) + (size_t)tok * D_DIL + h * 128, g);
    TileSrc src{(const char*)(ws + OFF_KA) + ((size_t)r * D_DIL + h * 128) * 2, (const char*)(ws + OFF_VA) + ((size_t)r * D_DIL + h * 128) * 2, (size_t)dil * D_DIL * 2, (size_t)dil * D_DIL * 2};
    DilF f{iq, iw};
    attn_pass<true>(lds, src, b == 0 ? 0 : 2 * (b - 1), 2 * b + 2, st, f, tid, c, g);
    const float lt = group_sum(st.l), inv = 1.f / lt;
    bf16_t* od = (bf16_t*)(ws + OFF_HID + OV_OD) + ((size_t)cfg * S + tok) * D_DIL + h * 128 + 4 * g;
#pragma unroll
    for (int dt = 0; dt < 8; ++dt) { u32x2 w; w.x = pg8::cvt_pk_bf16(st.o[dt][0] * inv, st.o[dt][1] * inv); w.y = pg8::cvt_pk_bf16(st.o[dt][2] * inv, st.o[dt][3] * inv); *(u32x2*)(od + 16 * dt) = w; }
    if (g == 0) ((float*)(ws + OFF_HID + OV_LSE))[((size_t)cfg * S + tok) * 8 + h] = st.m + __log2f(lt);
}
__device__ __forceinline__ void dil_merge(const Params& p) {
    unsigned char* ws = p.ws;
    const bf16_t* OD = (const bf16_t*)(ws + OFF_HID + OV_OD); const float* LSE = (const float*)(ws + OFF_HID + OV_LSE); bf16_t* MX = (bf16_t*)(ws + OFF_XB);
    const int gt = blockIdx.x * NTHREADS + threadIdx.x, GT_ = gridDim.x * NTHREADS;
    for (int i = gt; i < S * NH_DIL * 16; i += GT_) {
        const int ch = i & 15, th = i >> 4, h = th % NH_DIL, t = th / NH_DIL;
        const float l0 = LSE[((size_t)0 * S + t) * 8 + h], l1 = LSE[((size_t)1 * S + t) * 8 + h], l2 = LSE[((size_t)2 * S + t) * 8 + h];
        const float mx = fmaxf(l0, fmaxf(l1, l2)); float w0 = fast_exp2(l0 - mx), w1 = fast_exp2(l1 - mx), w2 = fast_exp2(l2 - mx);
        const float inv = 1.f / (w0 + w1 + w2); w0 *= inv; w1 *= inv; w2 *= inv;
        const size_t off = (size_t)t * D_DIL + h * 128 + 8 * ch;
        const u32x4 a = *(const u32x4*)(OD + off), b = *(const u32x4*)(OD + (size_t)S * D_DIL + off), cc = *(const u32x4*)(OD + (size_t)2 * S * D_DIL + off);
        u32x4 o;
#pragma unroll
        for (int e = 0; e < 4; ++e) o[e] = pk2(w0 * bflo(a[e]) + w1 * bflo(b[e]) + w2 * bflo(cc[e]), w0 * bfhi(a[e]) + w1 * bfhi(b[e]) + w2 * bfhi(cc[e]));
        *(u32x4*)(MX + (size_t)t * DM + h * 128 + 8 * ch) = o;
    }
}

__device__ __forceinline__ void compress_unit(const Params& p, LAS unsigned char* lds, int u) {
    const int tid = threadIdx.x, lane = tid & 63, wave = __builtin_amdgcn_readfirstlane(tid >> 6), c = lane & 15, g4 = lane >> 4;
    const int nb = u & 31, grp = (u >> 5) & 1, j = u >> 6, n0 = 16 * nb;
    unsigned char* ws = p.ws;
    constexpr int AP = 1040, HP = 528, OP = 132;
    LAS unsigned char* Ach = lds; LAS unsigned char* HDl = lds + 16 * AP; LAS float* OUTF = (LAS float*)(lds + 16 * AP + 16 * HP);
    const float* TOK = (const float*)(ws + (j ? OFF_VCT : OFF_KCT)) + ((size_t)grp * S + n0 * 16) * 128;
    const float* pe = p.cpe + (size_t)j * 32 * 128;
    const bf16_t* W1T = (const bf16_t*)(ws + OFF_CW1T) + (size_t)j * 256 * 4096; const bf16_t* W2T = (const bf16_t*)(ws + OFF_CW2T) + (size_t)j * 128 * 256;
    f32x4 acc[2]; acc[0] = (f32x4){0.f, 0.f, 0.f, 0.f}; acc[1] = acc[0];
    for (int kc = 0; kc < 8; ++kc) {
        { const int n = tid >> 5, kl = (tid & 31) * 16, l = 4 * kc + (kl >> 7), d = kl & 127;
          const float* sp = TOK + ((size_t)(16 * n + l)) * 128 + d; const float* pp = pe + l * 128 + d;
          f32x4 a[4];
#pragma unroll
          for (int e = 0; e < 4; ++e) a[e] = *(const f32x4*)(sp + 4 * e) + *(const f32x4*)(pp + 4 * e);
          u32x4 w0, w1; w0.x = pk2(a[0][0], a[0][1]); w0.y = pk2(a[0][2], a[0][3]); w0.z = pk2(a[1][0], a[1][1]); w0.w = pk2(a[1][2], a[1][3]);
          w1.x = pk2(a[2][0], a[2][1]); w1.y = pk2(a[2][2], a[2][3]); w1.z = pk2(a[3][0], a[3][1]); w1.w = pk2(a[3][2], a[3][3]);
          *(LAS u32x4*)(Ach + n * AP + kl * 2) = w0; *(LAS u32x4*)(Ach + n * AP + kl * 2 + 16) = w1; }
        __syncthreads();
#pragma unroll 4
        for (int ks = 0; ks < 16; ++ks) {
            const bf16x8 bfr = *(const LAS bf16x8*)(Ach + c * AP + (32 * ks + 8 * g4) * 2);
#pragma unroll
            for (int nn = 0; nn < 2; ++nn) { const bf16x8 afr = *(const bf16x8*)(W1T + (size_t)(32 * wave + 16 * nn + c) * 4096 + 512 * kc + 32 * ks + 8 * g4);
                acc[nn] = __builtin_amdgcn_mfma_f32_16x16x32_bf16(afr, bfr, acc[nn], 0, 0, 0); }
        }
        __syncthreads();
    }
#pragma unroll
    for (int nn = 0; nn < 2; ++nn) { const int hb = 32 * wave + 16 * nn + 4 * g4; const f32x4 bb = *(const f32x4*)(p.cb1 + j * 256 + hb);
        u32x2 w; w.x = pk2(gelu_tanh(acc[nn][0] + bb[0]), gelu_tanh(acc[nn][1] + bb[1])); w.y = pk2(gelu_tanh(acc[nn][2] + bb[2]), gelu_tanh(acc[nn][3] + bb[3]));
        *(LAS u32x2*)(HDl + c * HP + hb * 2) = w; }
    __syncthreads();
    { f32x4 a2 = (f32x4){0.f, 0.f, 0.f, 0.f};
#pragma unroll
      for (int ks = 0; ks < 8; ++ks) { const bf16x8 afr = *(const bf16x8*)(W2T + (size_t)(16 * wave + c) * 256 + 32 * ks + 8 * g4); const bf16x8 bfr = *(const LAS bf16x8*)(HDl + c * HP + (32 * ks + 8 * g4) * 2);
          a2 = __builtin_amdgcn_mfma_f32_16x16x32_bf16(afr, bfr, a2, 0, 0, 0); }
      const int d = 16 * wave + 4 * g4; const f32x4 bb = *(const f32x4*)(p.cb2 + j * 128 + d);
      *(LAS f32x4*)(OUTF + c * OP + d) = a2 + bb; }
    __syncthreads();
    if (j == 0) {
        bf16_t* KC = (bf16_t*)(ws + OFF_KC) + ((size_t)grp * 512 + n0) * 128;
#pragma unroll
        for (int e = 0; e < 2; ++e) { const int idx = tid + 512 * e, n = idx >> 6, d = idx & 63;
            if (n0 + n >= NCMP) { KC[n * 128 + d] = 0; KC[n * 128 + d + 64] = 0; }
            else { const int nn = n0 + n; const double pc = 0.5 * ((double)p.pos[16 * nn] + (double)p.pos[16 * nn + 31]); float cs, sn; rope_cs(pc, d, cs, sn);
                const float x1 = OUTF[n * OP + d], x2 = OUTF[n * OP + d + 64]; KC[n * 128 + d] = (bf16_t)f2bf(x1 * cs - x2 * sn); KC[n * 128 + d + 64] = (bf16_t)f2bf(x2 * cs + x1 * sn); } }
    } else {
        bf16_t* VC = (bf16_t*)(ws + OFF_VC) + ((size_t)grp * 512 + n0) * 128;
#pragma unroll
        for (int e = 0; e < 4; ++e) { const int idx = tid + 512 * e, n = idx >> 7, d = idx & 127; VC[n * 128 + d] = (n0 + n >= NCMP) ? (bf16_t)0 : (bf16_t)f2bf(OUTF[n * OP + d]); }
    }
}

__device__ __forceinline__ void cmp_unit(const Params& p, LAS unsigned char* lds, int u) {
    const int tid = threadIdx.x, lane = tid & 63, wave = __builtin_amdgcn_readfirstlane(tid >> 6), c = lane & 15, g = lane >> 4;
    const int qb = 127 - (u >> 1), grp = u & 1;
    const int qg = wave & 3, hs = wave >> 2;
    unsigned char* ws = p.ws;
    constexpr int IP = 130;
    LAS float* IMP0 = (LAS float*)(lds + L_V1 + VT_BYTES);
    LAS float* IMPW = IMP0 + wave * 16 * IP;
    for (int i = lane; i < 16 * IP; i += 64) IMPW[i] = 0.f;
    const int tw = 64 * qb + 16 * qg, tq = tw + c;
    const int ncq = tq >= 31 ? (tq - 31) / 16 + 1 : 0;
    const int ncw0 = tw >= 31 ? (tw - 31) / 16 + 1 : 0;
    const int ncb = (64 * qb + 63 - 31) / 16 + 1;
    const int nt = (ncb + 63) >> 6;
    TileSrc src{(const char*)(ws + OFF_KC) + (size_t)grp * 512 * 256, (const char*)(ws + OFF_VC) + (size_t)grp * 512 * 256, 256, 256};
    for (int hr = 0; hr < 3; ++hr) {
        const bool act = (hs == 0) || (hr < 2);
        const int h = HG * grp + (hs == 0 ? hr : (hr < 2 ? 3 + hr : 4));
        QState st; q_load(st, (const bf16_t*)(ws + OFF_QN) + (size_t)tq * D_NSA + h * 128, g);
        u32x4 r[4];
        tile_load(r, src, 0, tid); tile_store(lds, 0, 0, r, tid); __syncthreads();
        for (int t = 0; t < nt; ++t) {
            const int buf = t & 1;
            if (t + 1 < nt) tile_load(r, src, 64 * (t + 1), tid);
            if (act) { f32x4 s[4]; qk_tile(s, lds + k_off(buf), st, c, g); if (64 * t + 63 > ncw0 - 1) mask_tile(s, ncq - 1 - 64 * t, W_CAUSAL, g); softmax_online<false, false>(s, st, true); }
            if (t + 1 < nt) tile_store(lds, buf ^ 1, buf ^ 1, r, tid);
            __syncthreads();
        }
        const float mfin = st.m, lt = group_sum(st.l), invl = lt > 0.f ? 1.f / lt : 0.f;
        float carry = 0.f;
        tile_load(r, src, 0, tid); tile_store(lds, 0, 0, r, tid); __syncthreads();
        for (int t = 0; t < nt; ++t) {
            const int buf = t & 1;
            if (t + 1 < nt) tile_load(r, src, 64 * (t + 1), tid);
            if (act) {
                f32x4 s[4]; qk_tile(s, lds + k_off(buf), st, c, g); if (64 * t + 63 > ncw0 - 1) mask_tile(s, ncq - 1 - 64 * t, W_CAUSAL, g);
#pragma unroll
                for (int T = 0; T < 4; ++T)
#pragma unroll
                    for (int rr = 0; rr < 4; ++rr) s[T][rr] = fast_exp2(s[T][rr] - mfin) * invl;
                const float R0 = __shfl(s[1][3], (lane + 48) & 63), R1 = __shfl(s[3][3], (lane + 48) & 63);
                const float lp0 = g > 0 ? R0 : carry, lp1 = g > 0 ? R1 : R0; carry = R1;
                LAS float* ip = IMPW + c * IP + 16 * t + 2 * g;
                f32x2 a = *(LAS f32x2*)ip, b = *(LAS f32x2*)(ip + 8);
                a.x += (s[0][0] + s[0][1]) + (s[0][2] + s[0][3]) + lp0; a.y += (s[1][0] + s[1][1]) + (s[1][2] + s[1][3]) + s[0][3];
                b.x += (s[2][0] + s[2][1]) + (s[2][2] + s[2][3]) + lp1; b.y += (s[3][0] + s[3][1]) + (s[3][2] + s[3][3]) + s[2][3];
                *(LAS f32x2*)ip = a; *(LAS f32x2*)(ip + 8) = b;
                pv_tile(s, lds + v_off(buf), st, c, g);
            }
            if (t + 1 < nt) tile_store(lds, buf ^ 1, buf ^ 1, r, tid);
            __syncthreads();
        }
        if (act) { const float g0 = ((const float*)(ws + OFF_GT))[(size_t)tq * 32 + h * 3 + 0];
            float* oc = (float*)(ws + OFF_HID + OV_OC) + (size_t)tq * D_NSA + h * 128 + 4 * g;
#pragma unroll
            for (int dt = 0; dt < 8; ++dt) *(f32x4*)(oc + 16 * dt) = st.o[dt] * g0; }
    }
    __syncthreads();
    for (int i = 0; i < 8; ++i) {
        const int qq = 8 * wave + i, t = 64 * qb + qq, cur = t >> 6;
        const LAS float* A = IMP0 + ((qq >> 4) * 16 + (qq & 15)) * IP; const LAS float* B = A + 4 * 16 * IP;
        const float i0 = A[lane] + B[lane], i1 = A[lane + 64] + B[lane + 64];
        const float sc0 = (lane <= cur) ? i0 + (((lane == 0) || (lane == cur) || (lane == cur - 1)) ? 1e4f : 0.f) : -1e30f;
        const float sc1 = (lane + 64 <= cur) ? i1 + (((lane + 64 == cur) || (lane + 64 == cur - 1)) ? 1e4f : 0.f) : -1e30f;
        unsigned long long mlo, mhi;
        if (cur < 16) { mlo = (2ull << cur) - 1ull; mhi = 0ull; }
        else {
            const unsigned u0 = __float_as_uint(sc0), u1 = __float_as_uint(sc1);
            const unsigned k0 = (u0 & 0x80000000u) ? ~u0 : (u0 | 0x80000000u), k1 = (u1 & 0x80000000u) ? ~u1 : (u1 | 0x80000000u);
            unsigned prefix = 0u;
            for (int bit = 31; bit >= 0; --bit) { const unsigned cand = prefix | (1u << bit);
                const int cnt = __popcll(__ballot(k0 >= cand)) + __popcll(__ballot(k1 >= cand)); if (cnt >= 16) prefix = cand; }
            mlo = __ballot(k0 > prefix); mhi = __ballot(k1 > prefix);
            unsigned long long e0 = __ballot(k0 == prefix), e1 = __ballot(k1 == prefix);
            int need = 16 - __popcll(mlo) - __popcll(mhi);
            while (need > 0 && e0) { const unsigned long long low = e0 & (~e0 + 1ull); mlo |= low; e0 ^= low; --need; }
            while (need > 0 && e1) { const unsigned long long low = e1 & (~e1 + 1ull); mhi |= low; e1 ^= low; --need; }
        }
        if (lane == 0) { u32x4 w; w.x = (unsigned)mlo; w.y = (unsigned)(mlo >> 32); w.z = (unsigned)mhi; w.w = (unsigned)(mhi >> 32);
            *(u32x4*)((unsigned*)(ws + OFF_HID + OV_SEL) + ((size_t)t * 2 + grp) * 4) = w; }
    }
}

struct WinF { int tq, tw; static constexpr bool HAS_EN = false;
    __device__ __forceinline__ int mode(int t) const { if (!(64 * t <= tw + 15 && 64 * t + 63 >= tw - 511)) return 0; return (64 * t >= tw + 15 - 511 && 64 * t + 63 <= tw) ? 1 : 2; }
    __device__ __forceinline__ int dq(int t) const { return tq - 64 * t; }
    __device__ __forceinline__ unsigned W() const { return 512u; }
    __device__ __forceinline__ bool en(int) const { return true; } };
struct SlcF { int tq, tw; const LAS unsigned* selrow; static constexpr bool HAS_EN = true;
    __device__ __forceinline__ bool en(int t) const { return (selrow[t >> 5] >> (t & 31)) & 1u; }
    __device__ __forceinline__ int mode(int t) const { if (!(64 * t <= tw + 15 && __ballot(en(t)) != 0ull)) return 0; return (64 * t + 63 <= tw) ? 1 : 2; }
    __device__ __forceinline__ int dq(int t) const { return tq - 64 * t; }
    __device__ __forceinline__ unsigned W() const { return W_CAUSAL; } };
__device__ __forceinline__ void slcwin_unit(const Params& p, LAS unsigned char* lds, int u) {
    const int tid = threadIdx.x, lane = tid & 63, wave = __builtin_amdgcn_readfirstlane(tid >> 6), c = lane & 15, g = lane >> 4;
    const int qb = 63 - u / NH_NSA, h = u % NH_NSA, grp = h / HG;
    unsigned char* ws = p.ws;
    const int tw = 128 * qb + 16 * wave, tq = tw + c;
    const float* GT = (const float*)(ws + OFF_GT) + (size_t)tq * 32 + h * 3;
    QState st; q_load(st, (const bf16_t*)(ws + OFF_QN) + (size_t)tq * D_NSA + h * 128, g);
    LAS unsigned* sel_lds = (LAS unsigned*)(lds + L_MISC);
    sel_lds[tid] = ((const unsigned*)(ws + OFF_HID + OV_SEL))[((size_t)(128 * qb + (tid >> 2)) * 2 + grp) * 4 + (tid & 3)];
    f32x4 res[8];
    { TileSrc src{(const char*)(ws + OFF_KW) + (size_t)grp * S * 256, (const char*)(ws + OFF_VW) + (size_t)grp * S * 256, 256, 256};
      WinF f{tq, tw};
      attn_pass<true>(lds, src, (2 * qb - 8) > 0 ? 2 * qb - 8 : 0, 2 * qb + 2, st, f, tid, c, g);
      const float sc = GT[2] / group_sum(st.l);
#pragma unroll
      for (int dt = 0; dt < 8; ++dt) res[dt] = st.o[dt] * sc; }
    q_reset(st);
    { TileSrc src{(const char*)(ws + OFF_KS) + (size_t)grp * S * 256, (const char*)(ws + OFF_VS) + (size_t)grp * S * 256, 256, 256};
      SlcF f{tq, tw, sel_lds + (16 * wave + c) * 4};
      attn_pass<true>(lds, src, 0, 2 * qb + 2, st, f, tid, c, g);
      const float sc = GT[1] / group_sum(st.l);
#pragma unroll
      for (int dt = 0; dt < 8; ++dt) res[dt] = res[dt] + st.o[dt] * sc; }
    const float* oc = (const float*)(ws + OFF_HID + OV_OC) + (size_t)tq * D_NSA + h * 128 + 4 * g;
    bf16_t* mx = (bf16_t*)(ws + OFF_XB) + (size_t)tq * DM + D_DIL + h * 128 + 4 * g;
#pragma unroll
    for (int dt = 0; dt < 8; ++dt) { const f32x4 o = res[dt] + *(const f32x4*)(oc + 16 * dt);
        u32x2 w; w.x = pg8::cvt_pk_bf16(o[0], o[1]); w.y = pg8::cvt_pk_bf16(o[2], o[3]); *(u32x2*)(mx + 16 * dt) = w; }
}
}


#ifndef NAIVE_COMPRESS
#define NAIVE_COMPRESS 0
#endif
#ifndef NAIVE_DIL
#define NAIVE_DIL 0
#endif
#ifndef NAIVE_NSA
#define NAIVE_NSA 0
#endif
__device__ __forceinline__ void phase_mix_a(const Params& p, LAS unsigned char* lds, int rep) {
#if NAIVE_COMPRESS
    compress_naive(p, lds);
#endif
#if NAIVE_DIL
    dilated_naive(p, lds);
#endif
#if !NAIVE_COMPRESS || !NAIVE_DIL
    unsigned* ctr = (unsigned*)(p.ws + OFF_CTL) + 0 + 4 * rep;
    constexpr int NC = NAIVE_COMPRESS ? 0 : 128, ND = NAIVE_DIL ? 0 : 1152;
    for (;;) { const int u = att::next_unit(ctr, lds); if (u >= NC + ND) break;
        if (u < NC) att::compress_unit(p, lds, u); else att::dil_unit(p, lds, u - NC); }
#endif
}
__device__ __forceinline__ void phase_mix_b(const Params& p, LAS unsigned char* lds, int rep) {
#if !NAIVE_NSA
    unsigned* ctr = (unsigned*)(p.ws + OFF_CTL) + 1 + 4 * rep;
    for (;;) { const int u = att::next_unit(ctr, lds); if (u >= 256) break; att::cmp_unit(p, lds, u); }
#endif
#if !NAIVE_DIL
    att::dil_merge(p);
#endif
}
__device__ __forceinline__ void phase_mix_c(const Params& p, LAS unsigned char* lds, int rep) {
#if NAIVE_NSA
    nsa_naive(p, lds);
#else
    unsigned* ctr = (unsigned*)(p.ws + OFF_CTL) + 2 + 4 * rep;
    for (;;) { const int u = att::next_unit(ctr, lds); if (u >= 640) break; att::slcwin_unit(p, lds, u); }
#endif
}


#define XB_TMO      128
#define XB_XCNT(j)  (256  + 64 * (j))
#define XB_XSUB(j)  (1280 + 64 * (j))
#define XB_XGEN(j)  (2304 + 64 * (j))
#define XB_TOP      3328
#define XB_TOPGEN   3392
#define XCD_BAR_WORDS 3456
#define XB_SPIN_CAP (1u << 22)
constexpr int CW_BAR = 4096;
constexpr int L_BARST = 143376;
__device__ __forceinline__ unsigned xb_ld(unsigned* p)              { return __hip_atomic_load(p, __ATOMIC_RELAXED, __HIP_MEMORY_SCOPE_AGENT); }
__device__ __forceinline__ unsigned xb_add(unsigned* p, unsigned v) { return __hip_atomic_fetch_add(p, v, __ATOMIC_RELAXED, __HIP_MEMORY_SCOPE_AGENT); }
__device__ __forceinline__ unsigned xb_xcc_id() { return (unsigned)__builtin_amdgcn_s_getreg((3 << 11) | 20) & 0xFu; }
#define XB_SPIN(cond, bar) do { unsigned _sp = 0; while (cond) { __builtin_amdgcn_s_sleep(1); \
    if ((++_sp & 255u) == 0u) { if (xb_ld(&(bar)[XB_TMO])) break; if (_sp > XB_SPIN_CAP) { atomicAdd(&(bar)[XB_TMO], 1u); break; } } } } while (0)
struct XcdBarrier { unsigned* bar; unsigned x; volatile LAS unsigned* st; };
__device__ __forceinline__ XcdBarrier xcd_barrier_post(unsigned* bar, volatile LAS unsigned* st) {
    XcdBarrier b; b.bar = bar; b.x = xb_xcc_id(); b.st = st;
    if (threadIdx.x == 0) (void)xb_add(&bar[XB_XCNT(b.x)], 1u);
    return b;
}
__device__ __forceinline__ void xcd_barrier_complete(unsigned* bar, unsigned x, unsigned& nloc, unsigned& nx) {
    const unsigned G = gridDim.x * gridDim.y * gridDim.z;
    unsigned sum, cnt, mine, sp = 0u;
    for (;;) {
        sum = 0u; cnt = 0u; mine = 0u;
#pragma unroll
        for (unsigned j = 0; j < 16; ++j) { const unsigned c = xb_ld(&bar[XB_XCNT(j)]); sum += c; cnt += (c > 0u) ? 1u : 0u; mine = (j == x) ? c : mine; }
        if (sum == G) break;
        __builtin_amdgcn_s_sleep(1);
        if ((++sp & 255u) == 0u) { if (xb_ld(&bar[XB_TMO])) break; if (sp > XB_SPIN_CAP) { atomicAdd(&bar[XB_TMO], 1u); break; } }
    }
    nloc = mine > 0u ? mine : 1u; nx = cnt > 0u ? cnt : 1u;
}
__device__ __forceinline__ void xcd_barrier(const XcdBarrier& b) {
    asm volatile("s_waitcnt vmcnt(0)" ::: "memory");
    __syncthreads();
    if (threadIdx.x == 0) {
        unsigned* bar = b.bar;
        __builtin_amdgcn_s_waitcnt(0);
        unsigned nloc = b.st[0], nx = b.st[1];
        if (nloc == 0u) { xcd_barrier_complete(bar, b.x, nloc, nx); b.st[0] = nloc; b.st[1] = nx; }
        const unsigned old = xb_add(&bar[XB_XSUB(b.x)], 1u);
        const unsigned gen = old / nloc;
        if (old + 1u == (gen + 1u) * nloc) {
            __builtin_amdgcn_fence(__ATOMIC_RELEASE, "agent");
            asm volatile("s_waitcnt vmcnt(0)" ::: "memory");
            const unsigned og = xb_add(&bar[XB_TOP], 1u);
            const unsigned tg = og / nx;
            if (og + 1u == (tg + 1u) * nx) xb_add(&bar[XB_TOPGEN], 1u);
            else XB_SPIN(xb_ld(&bar[XB_TOPGEN]) == tg, bar);
            __builtin_amdgcn_fence(__ATOMIC_ACQUIRE, "agent");
            xb_add(&bar[XB_XGEN(b.x)], 1u);
            asm volatile("s_waitcnt vmcnt(0)" ::: "memory");
        } else {
            XB_SPIN(xb_ld(&bar[XB_XGEN(b.x)]) == gen, bar);
            __builtin_amdgcn_fence(__ATOMIC_ACQUIRE, "agent");
            asm volatile("s_waitcnt vmcnt(0)" ::: "memory");
        }
    }
    __syncthreads();
}

constexpr int N_PHASES = 13;
__global__ void __launch_bounds__(NTHREADS, 2) fwd_kernel(Params p) {
    extern __shared__ __attribute__((aligned(16))) unsigned char lds_raw[];
    LAS unsigned char* lds = (LAS unsigned char*)lds_raw;
    cg::grid_group grid = cg::this_grid();
    unsigned char* ws = p.ws;
    bf16_t* XB = (bf16_t*)(ws + OFF_XB); bf16_t* HID = (bf16_t*)(ws + OFF_HID);
    const int lo = p.ph_lo, hi = p.ph_hi;
    if (threadIdx.x < 2) ((volatile LAS unsigned*)(lds + L_BARST))[threadIdx.x] = 0u;
    __syncthreads();
    XcdBarrier bar; bar.bar = nullptr; bar.x = 0; bar.st = nullptr; bool bar_up = false;
#define IN(k) (lo <= (k) && (k) < hi)
#define REPS(k) for (int rep = 0; rep < 1 + ((PROBE_REP_MASK >> (k)) & 1); ++rep)
#define SEAM(k) do { if (IN(k) && IN((k) + 1)) { if (!bar_up) { grid.sync(); bar = xcd_barrier_post((unsigned*)(ws + OFF_CTL) + CW_BAR, (volatile LAS unsigned*)(lds + L_BARST)); bar_up = true; } else xcd_barrier(bar); } } while (0)
    if (IN(0)) { REPS(0) p0_prologue(p, lds); }
    SEAM(0);
    if (IN(1)) REPS(1) { pg8::Gemm g{XB, (const bf16_t*)(ws + OFF_W13A), S, 2 * DFF, DM}; pg8::StaticOrder so; so.init(S, 2 * DFF, gridDim.x, blockIdx.x);
        pg8::EpiSwiglu E{HID}; pg8::gemm_phase<pg8::EpiSwiglu, pg8::StaticOrder, true, true>(lds, g, so, E); }
    SEAM(1);
    if (IN(2)) REPS(2) { pg8::Gemm g{HID, (const bf16_t*)(ws + OFF_W2A), S, DM, DFF}; pg8::StaticOrder so; so.init(S, DM, gridDim.x, blockIdx.x);
        pg8::EpiResid E{p.x, p.out, ALPHA, 0.5f}; pg8::gemm_phase<pg8::EpiResid, pg8::StaticOrder, true, true>(lds, g, so, E); }
    SEAM(2);
    if (IN(3)) { ln_phase(p.out, p.out, XB, p.ln1g, p.ln1b); }
    SEAM(3);
    if (IN(4)) REPS(4) { pg8::Gemm g{XB, (const bf16_t*)(ws + OFF_WIN), S, IN_PAD, DM}; pg8::StaticOrder so; so.init(S, IN_PAD, gridDim.x, blockIdx.x);
        pg8::EpiInProj E{(bf16_t*)(ws + OFF_QA), (bf16_t*)(ws + OFF_KA), (bf16_t*)(ws + OFF_VA), (bf16_t*)(ws + OFF_QN), (bf16_t*)(ws + OFF_KS), (bf16_t*)(ws + OFF_VS),
                         (bf16_t*)(ws + OFF_KW), (bf16_t*)(ws + OFF_VW), (float*)(ws + OFF_KCT), (float*)(ws + OFF_VCT), (float*)(ws + OFF_GT),
                         (const float*)(ws + OFF_ROPE), (const float*)(ws + OFF_ROPE) + (size_t)S * 64, p.gateb};
        pg8::gemm_phase<pg8::EpiInProj, pg8::StaticOrder, true, true>(lds, g, so, E); }
    SEAM(4);
    if (IN(5)) { REPS(5) phase_mix_a(p, lds, rep); }
    SEAM(5);
    if (IN(6)) { REPS(6) phase_mix_b(p, lds, rep); }
    SEAM(6);
    if (IN(7)) { REPS(7) phase_mix_c(p, lds, rep); }
    SEAM(7);
    if (IN(8)) { pg8::Gemm g{XB, (const bf16_t*)(ws + OFF_WOUT), S, DM, DM}; pg8::StaticOrder so; so.init(S, DM, gridDim.x, blockIdx.x);
        pg8::EpiResid E{p.out, p.out, ALPHA, 1.0f}; pg8::gemm_phase<pg8::EpiResid, pg8::StaticOrder, true, true>(lds, g, so, E); }
    SEAM(8);
    if (IN(9)) { ln_phase(p.out, p.out, XB, p.ln2g, p.ln2b); }
    SEAM(9);
    if (IN(10)) { pg8::Gemm g{XB, (const bf16_t*)(ws + OFF_W13B), S, 2 * DFF, DM}; pg8::StaticOrder so; so.init(S, 2 * DFF, gridDim.x, blockIdx.x);
        pg8::EpiSwiglu E{HID}; pg8::gemm_phase<pg8::EpiSwiglu, pg8::StaticOrder, true, true>(lds, g, so, E); }
    SEAM(10);
    if (IN(11)) { pg8::Gemm g{HID, (const bf16_t*)(ws + OFF_W2B), S, DM, DFF}; pg8::StaticOrder so; so.init(S, DM, gridDim.x, blockIdx.x);
        pg8::EpiResid E{p.out, p.out, ALPHA, 0.5f}; pg8::gemm_phase<pg8::EpiResid, pg8::StaticOrder, true, true>(lds, g, so, E); }
    SEAM(11);
    if (IN(12)) { ln_phase(p.out, p.out, nullptr, p.ln3g, p.ln3b); }
#undef IN
#undef SEAM
}

extern "C" void kernel_launch(void* const* d_in, const int* in_sizes, int n_in, void* d_out, int out_size, void* d_ws, size_t ws_size, hipStream_t stream) {
    static int grid = 0;
    if (grid == 0) {
        if (n_in != 22 || in_sizes[0] != S * DM || out_size != S * DM || ws_size < WS_END) {
            fprintf(stderr, "kernel_launch: unexpected shapes: n_in %d in0 %d out %d ws %zu (need >= %zu)\n", n_in, n_in > 0 ? in_sizes[0] : -1, out_size, ws_size, (size_t)WS_END); grid = -1; return; }
        int dev = 0, cus = 0, per_cu = 0;
        if (hipGetDevice(&dev) != hipSuccess || hipDeviceGetAttribute(&cus, hipDeviceAttributeMultiprocessorCount, dev) != hipSuccess) { fprintf(stderr, "kernel_launch: device query failed\n"); grid = -1; return; }
        if (hipFuncSetAttribute((const void*)fwd_kernel, hipFuncAttributeMaxDynamicSharedMemorySize, LDS_BYTES) != hipSuccess) { fprintf(stderr, "kernel_launch: hipFuncSetAttribute failed\n"); grid = -1; return; }
        if (hipOccupancyMaxActiveBlocksPerMultiprocessor(&per_cu, (const void*)fwd_kernel, NTHREADS, LDS_BYTES) != hipSuccess || per_cu < 1) { fprintf(stderr, "kernel_launch: occupancy query gave %d\n", per_cu); per_cu = 1; }
        (void)hipGetLastError();
        grid = cus;
    }
    if (grid < 0) return;
    Params p{};
    p.x = (const float*)d_in[0]; p.pos = (const int*)d_in[1];
    p.ln1g = (const float*)d_in[2]; p.ln1b = (const float*)d_in[3]; p.f1w1 = (const float*)d_in[4]; p.f1w3 = (const float*)d_in[5]; p.f1w2 = (const float*)d_in[6];
    p.win = (const float*)d_in[7]; p.gateb = (const float*)d_in[8]; p.cpe = (const float*)d_in[9]; p.cw1 = (const float*)d_in[10]; p.cb1 = (const float*)d_in[11];
    p.cw2 = (const float*)d_in[12]; p.cb2 = (const float*)d_in[13]; p.wout = (const float*)d_in[14]; p.ln2g = (const float*)d_in[15]; p.ln2b = (const float*)d_in[16];
    p.f2w1 = (const float*)d_in[17]; p.f2w3 = (const float*)d_in[18]; p.f2w2 = (const float*)d_in[19]; p.ln3g = (const float*)d_in[20]; p.ln3b = (const float*)d_in[21];
    p.out = (float*)d_out; p.ws = (unsigned char*)d_ws;
#if N_LAUNCH_PER_PHASE
    for (int k = 0; k < N_PHASES; ++k) {
        p.ph_lo = k; p.ph_hi = k + 1;
        void* args[] = {&p};
        hipError_t e = hipLaunchCooperativeKernel((const void*)fwd_kernel, dim3(grid), dim3(NTHREADS), args, LDS_BYTES, stream);
        if (e != hipSuccess) { fprintf(stderr, "kernel_launch: launch of phase %d failed: %s\n", k, hipGetErrorString(e)); break; }
    }
#else
    p.ph_lo = 0; p.ph_hi = N_PHASES;
    void* args[] = {&p};
    hipError_t e = hipLaunchCooperativeKernel((const void*)fwd_kernel, dim3(grid), dim3(NTHREADS), args, LDS_BYTES, stream);
    if (e != hipSuccess) fprintf(stderr, "kernel_launch: cooperative launch failed: %s (grid %d)\n", hipGetErrorString(e), grid);
#endif
}
```
